# Optimizing an MI355X kernel written in HIP

```python
import jax, jax.numpy as jnp
from jax import lax
import numpy as np

D_MODEL = 2048
BATCH = 1
SEQ = 8192
DEPTH = 1

D_CONV = D_MODEL // 2
CONV_WIDTH = 31
HEAD_DIM = 128
HEADS_PER_GROUP = 4
ATTN_PATTERNS = ((128, 1), (512, 4), (2048, 16))
N_GROUPS = len(ATTN_PATTERNS)
N_HEADS = N_GROUPS * HEADS_PER_GROUP
ATTN_WIDTH = N_HEADS * HEAD_DIM
ATTN_OUT_WIDTH = HEADS_PER_GROUP * HEAD_DIM
ATTN_BLOCK = 128
N_BRANCHES = 2
D_IN = 2 * D_CONV + 3 * ATTN_WIDTH + N_BRANCHES * D_MODEL
N_EXPERTS = 32
TOP_K = 4
D_EXPERT = D_MODEL
SWIGLU_LIMIT = 7.0
SWIGLU_ALPHA = 1.702
MOE_BLOCK = 256
NORM_EPS = 1e-5

kernel_name = "hybrid_conv_dilated_attn_moe"


def rmsnorm(x, g):
    xf = x.astype(jnp.float32)
    y = xf * lax.rsqrt(jnp.mean(xf * xf, axis=-1, keepdims=True) + NORM_EPS)
    return (y * g.astype(jnp.float32)).astype(x.dtype)


def layernorm(x, g, b):
    xf = x.astype(jnp.float32)
    mu = jnp.mean(xf, axis=-1, keepdims=True)
    var = jnp.mean(jnp.square(xf - mu), axis=-1, keepdims=True)
    y = (xf - mu) * lax.rsqrt(var + NORM_EPS)
    return (y * g.astype(jnp.float32) + b.astype(jnp.float32)).astype(x.dtype)


def causal_depthwise_conv(u, w, b):
    k_w, c = w.shape
    y = lax.conv_general_dilated(
        u, w[:, None, :], window_strides=(1,), padding=[(k_w - 1, 0)],
        dimension_numbers=("NWC", "WIO", "NWC"), feature_group_count=c)
    return y + b


def dilated_window_attention(q, k, v, window, dilation):
    b_sz, s_len, n_h, d_h = q.shape
    m_len = s_len // dilation
    n_blk = -(-m_len // ATTN_BLOCK)
    m_pad = n_blk * ATTN_BLOCK

    def to_blocks(t):
        t = t.reshape(b_sz, m_len, dilation, n_h, d_h)
        t = jnp.pad(t, ((0, 0), (0, m_pad - m_len), (0, 0), (0, 0), (0, 0)))
        return t.reshape(b_sz, n_blk, ATTN_BLOCK, dilation, n_h, d_h)

    def with_prev(t):
        prev = jnp.pad(t[:, :-1], ((0, 0), (1, 0), (0, 0), (0, 0), (0, 0), (0, 0)))
        return jnp.concatenate([prev, t], axis=2)

    qb = to_blocks(q)
    kk = with_prev(to_blocks(k))
    vv = with_prev(to_blocks(v))
    scale = HEAD_DIM ** -0.5
    s = jnp.einsum("bnqrhc,bnkrhc->bnrhqk", qb, kk).astype(jnp.float32) * scale
    qi = jnp.arange(ATTN_BLOCK)
    ki = jnp.arange(2 * ATTN_BLOCK)
    steps = qi[:, None] + ATTN_BLOCK - ki[None, :]
    band = (steps >= 0) & (steps <= window // dilation)
    key_m = (jnp.arange(n_blk)[:, None] - 1) * ATTN_BLOCK + ki[None, :]
    mask = band[None] & (key_m >= 0)[:, None, :]
    s = jnp.where(mask[None, :, None, None], s, -jnp.inf)
    lse = jax.nn.logsumexp(s, axis=-1)
    p = jnp.exp(s - lse[..., None])
    o = jnp.einsum("bnrhqk,bnkrhc->bnqrhc", p.astype(vv.dtype), vv)
    o = o.reshape(b_sz, m_pad, dilation, n_h, d_h)[:, :m_len].reshape(b_sz, s_len, n_h, d_h)
    lse = jnp.transpose(lse, (0, 1, 4, 2, 3)).reshape(b_sz, m_pad, dilation, n_h)
    lse = lse[:, :m_len].reshape(b_sz, s_len, n_h)
    return o, lse


def hybrid_mixer(h, w_in, b_gate, conv_w, conv_b, conv_ln_g, conv_ln_b,
                 w_conv_out, b_conv_out, w_attn_out, w_out):
    b_sz, s_len, _ = h.shape
    proj = h @ w_in
    o1 = 2 * D_CONV
    o2 = o1 + ATTN_WIDTH
    o3 = o2 + ATTN_WIDTH
    o4 = o3 + ATTN_WIDTH
    conv_in, q, k, v, gate_logits = (proj[..., :o1], proj[..., o1:o2], proj[..., o2:o3],
                                     proj[..., o3:o4], proj[..., o4:])

    a, g = conv_in[..., :D_CONV], conv_in[..., D_CONV:]
    u = a * jax.nn.sigmoid(g)
    u = causal_depthwise_conv(u, conv_w, conv_b)
    u = jax.nn.silu(layernorm(u, conv_ln_g, conv_ln_b))
    y_conv = u @ w_conv_out + b_conv_out

    q = q.reshape(b_sz, s_len, N_HEADS, HEAD_DIM)
    k = k.reshape(b_sz, s_len, N_HEADS, HEAD_DIM)
    v = v.reshape(b_sz, s_len, N_HEADS, HEAD_DIM)
    outs, lses = [], []
    for gi, (window, dilation) in enumerate(ATTN_PATTERNS):
        hs = slice(gi * HEADS_PER_GROUP, (gi + 1) * HEADS_PER_GROUP)
        o_g, lse_g = dilated_window_attention(q[:, :, hs], k[:, :, hs], v[:, :, hs], window, dilation)
        outs.append(o_g)
        lses.append(lse_g)
    mix_w = jax.nn.softmax(jnp.stack(lses, axis=0), axis=0)
    o = jnp.sum(mix_w[..., None] * jnp.stack(outs, axis=0).astype(jnp.float32), axis=0)
    o = o.astype(h.dtype).reshape(b_sz, s_len, ATTN_OUT_WIDTH)
    y_attn = o @ w_attn_out

    gates = jax.nn.sigmoid(gate_logits + b_gate)
    g_conv, g_attn = gates[..., :D_MODEL], gates[..., D_MODEL:]
    return (g_conv * y_conv + g_attn * y_attn) @ w_out


def moe_ffn(h, w_router, b_router, w_exp_in, b_exp_in, w_exp_out, b_exp_out):
    b_sz, s_len, d = h.shape
    n_tok = b_sz * s_len
    n_assign = n_tok * TOP_K
    ht = h.reshape(n_tok, d)
    logits = (ht @ w_router + b_router).astype(jnp.float32)
    top_val, top_idx = lax.top_k(logits, TOP_K)
    gate = jax.nn.softmax(top_val, axis=-1)

    flat_e = top_idx.reshape(-1)
    flat_tok = jnp.arange(n_assign, dtype=jnp.int32) // TOP_K
    flat_gate = gate.reshape(-1)
    order = jnp.argsort(flat_e)
    sorted_e = flat_e[order]
    counts = jnp.zeros((N_EXPERTS,), jnp.int32).at[flat_e].add(1)
    padded = (counts + MOE_BLOCK - 1) // MOE_BLOCK * MOE_BLOCK
    start = jnp.cumsum(counts) - counts
    pad_end = jnp.cumsum(padded)
    pad_start = pad_end - padded
    dest = pad_start[sorted_e] + (jnp.arange(n_assign, dtype=jnp.int32) - start[sorted_e])
    n_blocks = -(-(n_assign + N_EXPERTS * (MOE_BLOCK - 1)) // MOE_BLOCK)
    n_rows = n_blocks * MOE_BLOCK
    row_tok = jnp.full((n_rows,), n_tok, jnp.int32).at[dest].set(flat_tok[order])
    row_gate = jnp.zeros((n_rows,), jnp.float32).at[dest].set(flat_gate[order])
    block_e = jnp.searchsorted(pad_end, jnp.arange(n_blocks, dtype=jnp.int32) * MOE_BLOCK, side="right")
    block_e = jnp.minimum(block_e, N_EXPERTS - 1).astype(jnp.int32)

    h_pad = jnp.concatenate([ht, jnp.zeros((1, d), ht.dtype)], axis=0)
    xs = h_pad[row_tok].reshape(n_blocks, MOE_BLOCK, d)

    def expert_block(args):
        xb, e = args
        gu = xb @ w_exp_in[e] + b_exp_in[e]
        g, u = gu[:, :D_EXPERT], gu[:, D_EXPERT:]
        g = jnp.minimum(g, SWIGLU_LIMIT)
        u = jnp.clip(u, -SWIGLU_LIMIT, SWIGLU_LIMIT)
        act = (u + 1.0) * (g * jax.nn.sigmoid(SWIGLU_ALPHA * g))
        return act @ w_exp_out[e] + b_exp_out[e]

    ys = lax.map(expert_block, (xs, block_e)).reshape(n_rows, d)
    out = jnp.zeros((n_tok + 1, d), ys.dtype).at[row_tok].add(ys * row_gate[:, None].astype(ys.dtype))
    return out[:n_tok].reshape(b_sz, s_len, d)


def setup_inputs(seed: int = 0) -> dict:
    key = jax.random.key(seed)
    ks = jax.random.split(key, 20)
    L = DEPTH

    def nrm(k, shape, scale):
        return jax.random.normal(k, shape, jnp.float32) * scale

    return {
        "x": nrm(ks[0], (BATCH, SEQ, D_MODEL), 1.0),
        "norm1_g": 1.0 + nrm(ks[1], (L, D_MODEL), 0.02),
        "w_in": nrm(ks[2], (L, D_MODEL, D_IN), D_MODEL ** -0.5),
        "b_gate": nrm(ks[3], (L, N_BRANCHES * D_MODEL), 0.02),
        "conv_w": nrm(ks[4], (L, CONV_WIDTH, D_CONV), CONV_WIDTH ** -0.5),
        "conv_b": nrm(ks[5], (L, D_CONV), 0.02),
        "conv_ln_g": 1.0 + nrm(ks[6], (L, D_CONV), 0.02),
        "conv_ln_b": nrm(ks[7], (L, D_CONV), 0.02),
        "w_conv_out": nrm(ks[8], (L, D_CONV, D_MODEL), D_CONV ** -0.5),
        "b_conv_out": nrm(ks[9], (L, D_MODEL), 0.02),
        "w_attn_out": nrm(ks[10], (L, ATTN_OUT_WIDTH, D_MODEL), ATTN_OUT_WIDTH ** -0.5),
        "w_out": nrm(ks[11], (L, D_MODEL, D_MODEL), D_MODEL ** -0.5),
        "norm2_g": 1.0 + nrm(ks[12], (L, D_MODEL), 0.02),
        "w_router": nrm(ks[13], (L, D_MODEL, N_EXPERTS), D_MODEL ** -0.5),
        "b_router": nrm(ks[14], (L, N_EXPERTS), 0.01),
        "w_exp_in": nrm(ks[15], (L, N_EXPERTS, D_MODEL, 2 * D_EXPERT), D_MODEL ** -0.5),
        "b_exp_in": nrm(ks[16], (L, N_EXPERTS, 2 * D_EXPERT), 0.02),
        "w_exp_out": nrm(ks[17], (L, N_EXPERTS, D_EXPERT, D_MODEL), D_EXPERT ** -0.5),
        "b_exp_out": nrm(ks[18], (L, N_EXPERTS, D_MODEL), 0.02),
        "norm_f_g": 1.0 + nrm(ks[19], (D_MODEL,), 0.02),
    }


def reference(x, norm1_g, w_in, b_gate, conv_w, conv_b, conv_ln_g, conv_ln_b,
              w_conv_out, b_conv_out, w_attn_out, w_out, norm2_g, w_router, b_router,
              w_exp_in, b_exp_in, w_exp_out, b_exp_out, norm_f_g):
    for l in range(DEPTH):
        h = rmsnorm(x, norm1_g[l])
        x = x + hybrid_mixer(h, w_in[l], b_gate[l], conv_w[l], conv_b[l], conv_ln_g[l],
                             conv_ln_b[l], w_conv_out[l], b_conv_out[l], w_attn_out[l], w_out[l])
        h = rmsnorm(x, norm2_g[l])
        x = x + moe_ffn(h, w_router[l], b_router[l], w_exp_in[l], b_exp_in[l],
                        w_exp_out[l], b_exp_out[l])
    return rmsnorm(x, norm_f_g)
```

```cpp
#include <hip/hip_runtime.h>
#include <stdint.h>

namespace nv {
constexpr int T = 8192, D = 2048, DIN = 10752, DC = 1024, NH = 12, HD = 128, AO = 512, NE = 32, DE = 2048, TOPK = 4;
constexpr int O_Q = 2048, O_K = 3584, O_V = 5120, O_G = 6656;
constexpr int PADM = 128;
constexpr int NRMAX = 36864;
constexpr float EPS = 1e-5f;
typedef float f32x16 __attribute__((ext_vector_type(16)));

__device__ __forceinline__ float wave_sum(float v) {
#pragma unroll
    for (int o = 1; o < 64; o <<= 1) v += __shfl_xor(v, o);
    return v;
}
__device__ __forceinline__ float wave_max(float v) {
#pragma unroll
    for (int o = 1; o < 64; o <<= 1) v = fmaxf(v, __shfl_xor(v, o));
    return v;
}
__device__ __forceinline__ float sigmoidf_(float x) { return 1.0f / (1.0f + __expf(-x)); }

template <class AL, class BL, class EP>
__global__ __launch_bounds__(256) void ngemm(long K, AL al, BL bl, EP ep) {
    __shared__ float As[128][17];
    __shared__ __attribute__((aligned(16))) float Bs[16][132];
    const int m0 = blockIdx.y * 128, n0 = blockIdx.x * 128;
    if (!al.active(m0)) return;
    const int tid = threadIdx.x, wave = tid >> 6, lane = tid & 63;
    const int wm = (wave >> 1) * 64, wn = (wave & 1) * 64;
    f32x16 acc[2][2];
#pragma unroll
    for (int i = 0; i < 2; ++i)
#pragma unroll
        for (int j = 0; j < 2; ++j)
#pragma unroll
            for (int r = 0; r < 16; ++r) acc[i][j][r] = 0.f;
    for (int k0 = 0; k0 < (int)K; k0 += 16) {
#pragma unroll
        for (int i = 0; i < 2; ++i) {
            const int idx = tid + i * 256, r = idx >> 2, kq = (idx & 3) * 4;
            const float4 v = al(m0 + r, k0 + kq);
            As[r][kq] = v.x; As[r][kq + 1] = v.y; As[r][kq + 2] = v.z; As[r][kq + 3] = v.w;
        }
#pragma unroll
        for (int i = 0; i < 2; ++i) {
            const int idx = tid + i * 256, kk = idx >> 5, nq = (idx & 31) * 4;
            const float4 v = bl(m0, k0 + kk, n0 + nq);
            *(float4*)&Bs[kk][nq] = v;
        }
        __syncthreads();
#pragma unroll
        for (int kk = 0; kk < 16; kk += 2) {
            float a[2], b[2];
#pragma unroll
            for (int i = 0; i < 2; ++i) a[i] = As[wm + i * 32 + (lane & 31)][kk + (lane >> 5)];
#pragma unroll
            for (int j = 0; j < 2; ++j) b[j] = Bs[kk + (lane >> 5)][wn + j * 32 + (lane & 31)];
#pragma unroll
            for (int i = 0; i < 2; ++i)
#pragma unroll
                for (int j = 0; j < 2; ++j) acc[i][j] = __builtin_amdgcn_mfma_f32_32x32x2f32(a[i], b[j], acc[i][j], 0, 0, 0);
        }
        __syncthreads();
    }
#pragma unroll
    for (int i = 0; i < 2; ++i)
#pragma unroll
        for (int j = 0; j < 2; ++j)
#pragma unroll
            for (int r = 0; r < 16; ++r) {
                const int row = m0 + wm + i * 32 + (r & 3) + 8 * (r >> 2) + 4 * (lane >> 5);
                const int col = n0 + wn + j * 32 + (lane & 31);
                ep(row, col, acc[i][j][r]);
            }
}

struct ALPlain { const float* A; int lda; int pad; __device__ bool active(int) const { return true; } __device__ float4 operator()(int r, int k) const { return *(const float4*)(A + (size_t)r * lda + k); } };
struct BLPlain { const float* B; int ldb; int pad; __device__ float4 operator()(int, int k, int n) const { return *(const float4*)(B + (size_t)k * ldb + n); } };
struct EPStore { float* C; int ldc; int pad; __device__ void operator()(int r, int c, float v) const { C[(size_t)r * ldc + c] = v; } };

__global__ __launch_bounds__(256) void k_rmsnorm(const float* x, const float* g, float* out) {
    const int row = blockIdx.x * 4 + (threadIdx.x >> 6), lane = threadIdx.x & 63;
    const float4* xr = (const float4*)(x + (size_t)row * D);
    float4 v[8]; float ss = 0.f;
#pragma unroll
    for (int j = 0; j < 8; ++j) { v[j] = xr[lane + 64 * j]; ss += v[j].x * v[j].x + v[j].y * v[j].y + v[j].z * v[j].z + v[j].w * v[j].w; }
    const float rs = rsqrtf(wave_sum(ss) * (1.0f / D) + EPS);
    float4* o = (float4*)(out + (size_t)row * D);
#pragma unroll
    for (int j = 0; j < 8; ++j) { const float4 gg = ((const float4*)g)[lane + 64 * j]; float4 w; w.x = v[j].x * rs * gg.x; w.y = v[j].y * rs * gg.y; w.z = v[j].z * rs * gg.z; w.w = v[j].w * rs * gg.w; o[lane + 64 * j] = w; }
}

__global__ __launch_bounds__(256) void k_conv(const float* proj, const float* cw, const float* cb, const float* lg, const float* lb, float* uc) {
    __shared__ float red[8];
    const int t = blockIdx.x, tid = threadIdx.x;
    float val[4];
#pragma unroll
    for (int i = 0; i < 4; ++i) {
        const int c = tid + 256 * i; float acc = cb[c];
        for (int k = 0; k < 31; ++k) { const int tt = t - 30 + k; if (tt < 0) continue;
            const float a = proj[(size_t)tt * DIN + c], g = proj[(size_t)tt * DIN + DC + c];
            acc += cw[k * DC + c] * (a * sigmoidf_(g)); }
        val[i] = acc;
    }
    float s = val[0] + val[1] + val[2] + val[3];
    s = wave_sum(s); if ((tid & 63) == 0) red[tid >> 6] = s; __syncthreads();
    const float mu = (red[0] + red[1] + red[2] + red[3]) * (1.0f / DC);
    float q = 0.f;
#pragma unroll
    for (int i = 0; i < 4; ++i) { const float d = val[i] - mu; q += d * d; }
    q = wave_sum(q); if ((tid & 63) == 0) red[4 + (tid >> 6)] = q; __syncthreads();
    const float rstd = rsqrtf((red[4] + red[5] + red[6] + red[7]) * (1.0f / DC) + EPS);
#pragma unroll
    for (int i = 0; i < 4; ++i) { const int c = tid + 256 * i; const float y = (val[i] - mu) * rstd * lg[c] + lb[c]; uc[(size_t)t * DC + c] = y * sigmoidf_(y); }
}

__global__ __launch_bounds__(256) void k_attn(const float* proj, float* og, float* lse) {
    __shared__ float qs[4][128];
    __shared__ float ps[4][132];
    const int w = threadIdx.x >> 6, lane = threadIdx.x & 63;
    const int gid = blockIdx.x * 4 + w;
    const int t = gid / NH, h = gid % NH, g = h >> 2;
    const int dil = (g == 0) ? 1 : (g == 1 ? 4 : 16);
    const float* qrow = proj + (size_t)t * DIN + O_Q + h * HD;
    qs[w][lane] = qrow[lane]; qs[w][lane + 64] = qrow[lane + 64];
    __syncthreads();
    const float scale = 0.08838834764831845f;
    float sc[3];
#pragma unroll
    for (int i = 0; i < 3; ++i) {
        const int j = lane + 64 * i; const int tt = t - j * dil;
        float s = -INFINITY;
        if (j <= 128 && tt >= 0) {
            const float4* kr = (const float4*)(proj + (size_t)tt * DIN + O_K + h * HD);
            float a = 0.f;
            for (int c = 0; c < 32; ++c) { const float4 kv = kr[c]; a += qs[w][4 * c] * kv.x + qs[w][4 * c + 1] * kv.y + qs[w][4 * c + 2] * kv.z + qs[w][4 * c + 3] * kv.w; }
            s = a * scale;
        }
        sc[i] = s;
    }
    const float m = wave_max(fmaxf(sc[0], fmaxf(sc[1], sc[2])));
    float p[3], l = 0.f;
#pragma unroll
    for (int i = 0; i < 3; ++i) { p[i] = (sc[i] == -INFINITY) ? 0.f : __expf(sc[i] - m); l += p[i]; }
    l = wave_sum(l);
    const float inv = 1.0f / l;
#pragma unroll
    for (int i = 0; i < 3; ++i) { const int j = lane + 64 * i; if (j <= 128) ps[w][j] = p[i] * inv; }
    __syncthreads();
    float o0 = 0.f, o1 = 0.f;
    for (int j = 0; j <= 128; ++j) { const int tt = t - j * dil; if (tt < 0) break;
        const float2 vv = *(const float2*)(proj + (size_t)tt * DIN + O_V + h * HD + 2 * lane);
        const float pj = ps[w][j]; o0 += pj * vv.x; o1 += pj * vv.y; }
    *(float2*)(og + ((size_t)t * NH + h) * HD + 2 * lane) = make_float2(o0, o1);
    if (lane == 0) lse[(size_t)t * NH + h] = m + __logf(l);
}
__global__ __launch_bounds__(256) void k_attn_combine(const float* og, const float* lse, float* o) {
    const int idx = blockIdx.x * 256 + threadIdx.x;
    const int t = idx >> 9, c = idx & 511, hg = c >> 7, d = c & 127;
    const float l0 = lse[(size_t)t * NH + hg], l1 = lse[(size_t)t * NH + 4 + hg], l2 = lse[(size_t)t * NH + 8 + hg];
    const float m = fmaxf(l0, fmaxf(l1, l2));
    const float w0 = __expf(l0 - m), w1 = __expf(l1 - m), w2 = __expf(l2 - m), inv = 1.0f / (w0 + w1 + w2);
    o[idx] = (w0 * og[((size_t)t * NH + hg) * HD + d] + w1 * og[((size_t)t * NH + 4 + hg) * HD + d] + w2 * og[((size_t)t * NH + 8 + hg) * HD + d]) * inv;
}

struct EPConvOut { float* merged; const float* proj; const float* bgate; const float* bco;
    __device__ void operator()(int r, int c, float v) const { const float gt = sigmoidf_(proj[(size_t)r * DIN + O_G + c] + bgate[c]); merged[(size_t)r * D + c] = gt * (v + bco[c]); } };
struct EPAttnOut { float* merged; const float* proj; const float* bgate;
    __device__ void operator()(int r, int c, float v) const { const float gt = sigmoidf_(proj[(size_t)r * DIN + O_G + D + c] + bgate[D + c]); merged[(size_t)r * D + c] += gt * v; } };
struct EPResid { float* out; const float* x; __device__ void operator()(int r, int c, float v) const { out[(size_t)r * D + c] = x[(size_t)r * D + c] + v; } };

__global__ __launch_bounds__(256) void k_router(const float* x1, const float* g2, const float* wr, const float* br, float* h2, int* a_e, int* a_pos, float* a_gate, int* cnt) {
    const int t = blockIdx.x * 4 + (threadIdx.x >> 6), lane = threadIdx.x & 63;
    const float4* xr = (const float4*)(x1 + (size_t)t * D);
    float4 v[8]; float ss = 0.f;
#pragma unroll
    for (int j = 0; j < 8; ++j) { v[j] = xr[lane + 64 * j]; ss += v[j].x * v[j].x + v[j].y * v[j].y + v[j].z * v[j].z + v[j].w * v[j].w; }
    const float rs = rsqrtf(wave_sum(ss) * (1.0f / D) + EPS);
    float4* o = (float4*)(h2 + (size_t)t * D);
#pragma unroll
    for (int j = 0; j < 8; ++j) { const float4 gg = ((const float4*)g2)[lane + 64 * j]; v[j].x *= rs * gg.x; v[j].y *= rs * gg.y; v[j].z *= rs * gg.z; v[j].w *= rs * gg.w; o[lane + 64 * j] = v[j]; }
    float mylogit = 0.f;
    for (int e4 = 0; e4 < 8; ++e4) {
        float p0 = 0.f, p1 = 0.f, p2 = 0.f, p3 = 0.f;
#pragma unroll
        for (int j = 0; j < 8; ++j) {
            const int i0 = 4 * (lane + 64 * j);
            const float xv[4] = {v[j].x, v[j].y, v[j].z, v[j].w};
#pragma unroll
            for (int q = 0; q < 4; ++q) { const float4 wv = *(const float4*)(wr + (size_t)(i0 + q) * NE + 4 * e4); p0 += xv[q] * wv.x; p1 += xv[q] * wv.y; p2 += xv[q] * wv.z; p3 += xv[q] * wv.w; }
        }
        p0 = wave_sum(p0); p1 = wave_sum(p1); p2 = wave_sum(p2); p3 = wave_sum(p3);
        if (lane == 4 * e4) mylogit = p0; if (lane == 4 * e4 + 1) mylogit = p1; if (lane == 4 * e4 + 2) mylogit = p2; if (lane == 4 * e4 + 3) mylogit = p3;
    }
    float lg = (lane < NE) ? mylogit + br[lane] : -INFINITY;
    int sel_e[4]; float sel_v[4];
#pragma unroll
    for (int k = 0; k < 4; ++k) {
        const float m = wave_max(lg);
        const unsigned long long b = __ballot(lg == m);
        const int e = __ffsll((long long)b) - 1;
        sel_e[k] = e; sel_v[k] = m;
        if (lane == e) lg = -INFINITY;
    }
    const float e0 = 1.0f, e1 = __expf(sel_v[1] - sel_v[0]), e2 = __expf(sel_v[2] - sel_v[0]), e3 = __expf(sel_v[3] - sel_v[0]);
    const float inv = 1.0f / (e0 + e1 + e2 + e3);
    if (lane < 4) {
        const int e = lane == 0 ? sel_e[0] : lane == 1 ? sel_e[1] : lane == 2 ? sel_e[2] : sel_e[3];
        const float gt = (lane == 0 ? e0 : lane == 1 ? e1 : lane == 2 ? e2 : e3) * inv;
        const int pos = atomicAdd(&cnt[e], 1);
        a_e[t * 4 + lane] = e; a_pos[t * 4 + lane] = pos; a_gate[t * 4 + lane] = gt;
    }
}
__global__ void k_offsets(const int* cnt, int* off, int* tile_e) {
    const int lane = threadIdx.x;
    __shared__ int so[NE + 1];
    if (lane == 0) { int a = 0; for (int e = 0; e < NE; ++e) { so[e] = a; a += (cnt[e] + PADM - 1) / PADM * PADM; } so[NE] = a; }
    __syncthreads();
    if (lane <= NE) off[lane] = so[lane];
    for (int tl = lane; tl < NRMAX / PADM; tl += 64) { const int r = tl * PADM; int e = -1; for (int q = 0; q < NE; ++q) if (r >= so[q] && r < so[q + 1]) e = q; tile_e[tl] = e; }
}
__global__ __launch_bounds__(256) void k_scatter(const int* a_e, const int* a_pos, const int* off, int* slot_tok, int* a_slot) {
    const int a = blockIdx.x * 256 + threadIdx.x;
    const int s = off[a_e[a]] + a_pos[a]; a_slot[a] = s; slot_tok[s] = a >> 2;
}
struct ALGather { const float* h2; const int* slot_tok; const int* tile_e;
    __device__ bool active(int m0) const { return tile_e[m0 / PADM] >= 0; }
    __device__ float4 operator()(int r, int k) const { return *(const float4*)(h2 + (size_t)slot_tok[r] * D + k); } };
struct BLExpert { const float* W; const int* tile_e; size_t estride; int ldb; int pad;
    __device__ float4 operator()(int m0, int k, int n) const { return *(const float4*)(W + (size_t)tile_e[m0 / PADM] * estride + (size_t)k * ldb + n); } };
struct EPBiasE { float* C; const float* bias; const int* tile_e; int ldc; int pad;
    __device__ void operator()(int r, int c, float v) const { C[(size_t)r * ldc + c] = v + bias[(size_t)tile_e[r / PADM] * ldc + c]; } };
struct ALAct { const float* gu; const int* tile_e;
    __device__ bool active(int m0) const { return tile_e[m0 / PADM] >= 0; }
    __device__ float4 operator()(int r, int k) const {
        const float4 g = *(const float4*)(gu + (size_t)r * (2 * DE) + k), u = *(const float4*)(gu + (size_t)r * (2 * DE) + DE + k);
        float4 o; const float gv[4] = {g.x, g.y, g.z, g.w}, uv[4] = {u.x, u.y, u.z, u.w}; float ov[4];
#pragma unroll
        for (int i = 0; i < 4; ++i) { const float gg = fminf(gv[i], 7.0f), uu = fminf(fmaxf(uv[i], -7.0f), 7.0f); ov[i] = (uu + 1.0f) * (gg * sigmoidf_(1.702f * gg)); }
        o.x = ov[0]; o.y = ov[1]; o.z = ov[2]; o.w = ov[3]; return o; } };
__global__ __launch_bounds__(256) void k_final(const float* x1, const float* y, const int* a_slot, const float* a_gate, const float* gf, float* out) {
    const int t = blockIdx.x * 4 + (threadIdx.x >> 6), lane = threadIdx.x & 63;
    float4 v[8];
#pragma unroll
    for (int j = 0; j < 8; ++j) v[j] = ((const float4*)(x1 + (size_t)t * D))[lane + 64 * j];
#pragma unroll
    for (int k = 0; k < 4; ++k) { const int s = a_slot[t * 4 + k]; const float gt = a_gate[t * 4 + k]; const float4* yr = (const float4*)(y + (size_t)s * D);
#pragma unroll
        for (int j = 0; j < 8; ++j) { const float4 yv = yr[lane + 64 * j]; v[j].x += gt * yv.x; v[j].y += gt * yv.y; v[j].z += gt * yv.z; v[j].w += gt * yv.w; } }
    float ss = 0.f;
#pragma unroll
    for (int j = 0; j < 8; ++j) ss += v[j].x * v[j].x + v[j].y * v[j].y + v[j].z * v[j].z + v[j].w * v[j].w;
    const float rs = rsqrtf(wave_sum(ss) * (1.0f / D) + EPS);
    float4* o = (float4*)(out + (size_t)t * D);
#pragma unroll
    for (int j = 0; j < 8; ++j) { const float4 gg = ((const float4*)gf)[lane + 64 * j]; float4 w; w.x = v[j].x * rs * gg.x; w.y = v[j].y * rs * gg.y; w.z = v[j].z * rs * gg.z; w.w = v[j].w * rs * gg.w; o[lane + 64 * j] = w; }
}

constexpr size_t MiB = 1u << 20;
constexpr size_t W_CTL = 0;
constexpr size_t W_H = 1 * MiB;
constexpr size_t W_PROJ = 65 * MiB;
constexpr size_t W_UC = 401 * MiB;
constexpr size_t W_OG = 433 * MiB;
constexpr size_t W_LSE = 481 * MiB;
constexpr size_t W_O = 482 * MiB;
constexpr size_t W_MERGED = 498 * MiB;
constexpr size_t W_X1 = 562 * MiB;
constexpr size_t W_AE = 626 * MiB, W_APOS = 627 * MiB, W_AGATE = 628 * MiB, W_ASLOT = 629 * MiB, W_SLOTTOK = 630 * MiB, W_TILEE = 631 * MiB;
constexpr size_t W_GU = 632 * MiB;
constexpr size_t W_Y = 1208 * MiB;
constexpr size_t W_END = 1496 * MiB;

static void run(void* const* d_in, float* out, unsigned char* ws, hipStream_t st) {
    const float* x = (const float*)d_in[0]; const float* n1g = (const float*)d_in[1]; const float* w_in = (const float*)d_in[2]; const float* b_gate = (const float*)d_in[3];
    const float* conv_w = (const float*)d_in[4]; const float* conv_b = (const float*)d_in[5]; const float* ln_g = (const float*)d_in[6]; const float* ln_b = (const float*)d_in[7];
    const float* w_co = (const float*)d_in[8]; const float* b_co = (const float*)d_in[9]; const float* w_ao = (const float*)d_in[10]; const float* w_out = (const float*)d_in[11];
    const float* n2g = (const float*)d_in[12]; const float* w_r = (const float*)d_in[13]; const float* b_r = (const float*)d_in[14];
    const float* w_ei = (const float*)d_in[15]; const float* b_ei = (const float*)d_in[16]; const float* w_eo = (const float*)d_in[17]; const float* b_eo = (const float*)d_in[18]; const float* nfg = (const float*)d_in[19];
    int* cnt = (int*)(ws + W_CTL); int* off = cnt + 64;
    float* h = (float*)(ws + W_H); float* proj = (float*)(ws + W_PROJ); float* uc = (float*)(ws + W_UC); float* og = (float*)(ws + W_OG); float* lse = (float*)(ws + W_LSE);
    float* o = (float*)(ws + W_O); float* merged = (float*)(ws + W_MERGED); float* x1 = (float*)(ws + W_X1);
    int* a_e = (int*)(ws + W_AE); int* a_pos = (int*)(ws + W_APOS); float* a_gate = (float*)(ws + W_AGATE); int* a_slot = (int*)(ws + W_ASLOT); int* slot_tok = (int*)(ws + W_SLOTTOK); int* tile_e = (int*)(ws + W_TILEE);
    float* gu = (float*)(ws + W_GU); float* y = (float*)(ws + W_Y);
    (void)hipMemsetAsync(ws + W_CTL, 0, 4096, st);
    (void)hipMemsetAsync(slot_tok, 0, NRMAX * 4, st);
    k_rmsnorm<<<T / 4, 256, 0, st>>>(x, n1g, h);
    ngemm<<<dim3(DIN / 128, T / 128), 256, 0, st>>>((long)D, ALPlain{h, D, 0}, BLPlain{w_in, DIN, 0}, EPStore{proj, DIN, 0});
    k_conv<<<T, 256, 0, st>>>(proj, conv_w, conv_b, ln_g, ln_b, uc);
    k_attn<<<T * NH / 4, 256, 0, st>>>(proj, og, lse);
    k_attn_combine<<<T * AO / 256, 256, 0, st>>>(og, lse, o);
    ngemm<<<dim3(D / 128, T / 128), 256, 0, st>>>((long)DC, ALPlain{uc, DC, 0}, BLPlain{w_co, D, 0}, EPConvOut{merged, proj, b_gate, b_co});
    ngemm<<<dim3(D / 128, T / 128), 256, 0, st>>>((long)AO, ALPlain{o, AO, 0}, BLPlain{w_ao, D, 0}, EPAttnOut{merged, proj, b_gate});
    ngemm<<<dim3(D / 128, T / 128), 256, 0, st>>>((long)D, ALPlain{merged, D, 0}, BLPlain{w_out, D, 0}, EPResid{x1, x});
    k_router<<<T / 4, 256, 0, st>>>(x1, n2g, w_r, b_r, h, a_e, a_pos, a_gate, cnt);
    k_offsets<<<1, 64, 0, st>>>(cnt, off, tile_e);
    k_scatter<<<T * TOPK / 256, 256, 0, st>>>(a_e, a_pos, off, slot_tok, a_slot);
    ngemm<<<dim3(2 * DE / 128, NRMAX / 128), 256, 0, st>>>((long)D, ALGather{h, slot_tok, tile_e}, BLExpert{w_ei, tile_e, (size_t)D * 2 * DE, 2 * DE, 0}, EPBiasE{gu, b_ei, tile_e, 2 * DE, 0});
    ngemm<<<dim3(D / 128, NRMAX / 128), 256, 0, st>>>((long)DE, ALAct{gu, tile_e}, BLExpert{w_eo, tile_e, (size_t)DE * D, D, 0}, EPBiasE{y, b_eo, tile_e, D, 0});
    k_final<<<T / 4, 256, 0, st>>>(x1, y, a_slot, a_gate, nfg, out);
}
}

extern "C" void kernel_launch(void* const* d_in, const int* in_sizes, int n_in, void* d_out, int out_size, void* d_ws, size_t ws_size, hipStream_t stream) {
    nv::run(d_in, (float*)d_out, (unsigned char*)d_ws, stream);
}
```

```cpp
#include <hip/hip_runtime.h>
#include <cstdio>
#include <cstdint>
namespace pg8 {
#define PG8_LAS __attribute__((address_space(3)))
typedef unsigned short bf16_t;
typedef short bf16x8 __attribute__((ext_vector_type(8)));
typedef float f32x4 __attribute__((ext_vector_type(4)));
typedef unsigned u32x4 __attribute__((ext_vector_type(4)));
constexpr int BM = 256, BK = 64, HALF = 128, HTB = HALF * BK * 2  , STAGE_BYTES = 8 * HTB, NXCD = 8, WGM = 8;

__host__ __device__ __forceinline__ int lds_byte(int r, int c) { const int st = (r >> 4) * 2 + (c >> 5), rr = r & 15, cc = c & 31, ob = rr * 64 + cc * 2; return st * 1024 + (ob ^ (((ob >> 9) & 1) << 5)); }
__host__ __device__ __forceinline__ void stage_rc(int b, int& R, int& C) { const int st = b / 1024, sb = b % 1024, swz = sb ^ (((sb >> 9) & 1) << 5); R = (st >> 1) * 16 + swz / 64; C = (st & 1) * 32 + (swz % 64) / 2; }
__host__ __device__ __forceinline__ int perm32(int rho) { const int n = rho >> 4, i = rho & 15; return 8 * (i >> 2) + 4 * n + (i & 3); }

struct Unit { int pm, pn; };
struct Gemm { const bf16_t* A; const bf16_t* Bt; int M, N, K; };

struct StaticOrder {
    int nM, nN, nwg, G, c;
    __host__ __device__ void init(int M, int N, int G_, int c_) { nM = M / BM; nN = N / BM; nwg = nM * nN; G = G_; c = c_; }
    __host__ __device__ bool next(int i, Unit& u) const {
        const long L = (long)i * G + c; if (L >= nwg) return false;
        int wgid = (int)L; { const int q = nwg / NXCD, r = nwg % NXCD, xcd = wgid % NXCD, off = wgid / NXCD; wgid = (xcd < r ? xcd * (q + 1) : r * (q + 1) + (xcd - r) * q) + off; }
        const int nig = WGM * nN, gid = wgid / nig, fm = gid * WGM, gsz = (nM - fm) < WGM ? (nM - fm) : WGM;
        u.pm = fm + ((wgid % nig) % gsz); u.pn = (wgid % nig) / gsz; return true;
    }
    __device__ __forceinline__ void a_ready(const Unit&) const {}
    __device__ __forceinline__ void done(const Unit&) const {}
};

__device__ __forceinline__ unsigned cvt_pk_bf16(float lo, float hi) { unsigned r; asm volatile("v_cvt_pk_bf16_f32 %0, %1, %2" : "=v"(r) : "v"(lo), "v"(hi)); return r; }
template <class Epi, class Sched, bool ALIGN_EPI = false, bool SP2 = false>
__device__ __forceinline__ void gemm_phase(PG8_LAS unsigned char* lds, const Gemm g, const Sched& S, const Epi& E) {
    const int tid = threadIdx.x, wid = __builtin_amdgcn_readfirstlane(tid >> 6), lane = tid & 63, wr = wid >> 2, wc = wid & 3, fr = lane & 15, fq = lane >> 4;
    const int K = g.K, nt = K / BK;
    unsigned voffA[2], voffB[2];
#pragma unroll
    for (int i = 0; i < 2; ++i) { int R, C; stage_rc(tid * 16 + i * 8192, R, C); const int Rb = Epi::PERM ? ((R & ~31) + perm32(R & 31)) : R;
        voffA[i] = (unsigned)(R * K + C) * 2u; voffB[i] = (unsigned)(Rb * K + C) * 2u; }
    const size_t kstep = (size_t)(BK * 2);
    const size_t hstep = (size_t)HALF * K * 2;
    const size_t tstep = 2 * hstep;
    const unsigned ldsw = (unsigned)wid * 1024u;
    const int aoff = lds_byte(wr * 64 + fr, fq * 8), boff = lds_byte(wc * 32 + fr, fq * 8);
#define PG8_SA(b, h) (((b) * 2 + (h)) * HTB)
#define PG8_SB(b, h) ((4 + (b) * 2 + (h)) * HTB)
#define PG8_STAGE(bufoff, gbase, voff) do { _Pragma("unroll") for (int _i = 0; _i < 2; ++_i) \
        __builtin_amdgcn_global_load_lds((const unsigned*)((const char*)(gbase) + (voff)[_i]), (PG8_LAS unsigned*)(lds + (bufoff) + ldsw + _i * 8192), 16, 0, 0); } while (0)
#define PG8_LDA(dst, b, h) do { _Pragma("unroll") for (int m = 0; m < 4; ++m) _Pragma("unroll") for (int k = 0; k < 2; ++k) dst[m][k] = *(const PG8_LAS bf16x8*)(lds + PG8_SA(b, h) + aoff + m * 2048 + k * 1024); } while (0)
#define PG8_LDB(dst, b, h) do { _Pragma("unroll") for (int n = 0; n < 2; ++n) _Pragma("unroll") for (int k = 0; k < 2; ++k) dst[n][k] = *(const PG8_LAS bf16x8*)(lds + PG8_SB(b, h) + boff + n * 2048 + k * 1024); } while (0)
#define PG8_MMA(ai, bj, At, Bt) do { __builtin_amdgcn_s_setprio(1); _Pragma("unroll") for (int m = 0; m < 4; ++m) _Pragma("unroll") for (int n = 0; n < 2; ++n) _Pragma("unroll") for (int k = 0; k < 2; ++k) \
        acc[ai][bj][m][n] = __builtin_amdgcn_mfma_f32_16x16x32_bf16(Bt[n][k], At[m][k], acc[ai][bj][m][n], 0, 0, 0); __builtin_amdgcn_s_setprio(0); } while (0)
#define PG8_WAIT_V(n) asm volatile("s_waitcnt vmcnt(" #n ")" ::: "memory")
#define PG8_WAIT_L(n) asm volatile("s_waitcnt lgkmcnt(" #n ")" ::: "memory")
#define PG8_BAR __builtin_amdgcn_s_barrier()
#define PG8_SCHED __builtin_amdgcn_sched_barrier(0)
    Unit cur, nxt; int ui = 0;
    if (!S.next(0, cur)) return;
    f32x4 acc[2][2][4][2];
#pragma unroll
    for (int a = 0; a < 2; ++a)
#pragma unroll
        for (int b = 0; b < 2; ++b)
#pragma unroll
            for (int m = 0; m < 4; ++m)
#pragma unroll
                for (int n = 0; n < 2; ++n) acc[a][b][m][n] = (f32x4){0.f, 0.f, 0.f, 0.f};
    bf16x8 At[4][2], B0[2][2], B1[2][2];
    const char* cA = (const char*)g.A + (size_t)cur.pm * tstep; const char* cB = (const char*)g.Bt + (size_t)cur.pn * tstep;
    S.a_ready(cur);
    if constexpr (SP2) {
        PG8_STAGE(PG8_SB(0, 0), cB, voffB); PG8_STAGE(PG8_SB(0, 1), cB + hstep, voffB); PG8_STAGE(PG8_SA(0, 0), cA, voffA); PG8_STAGE(PG8_SA(0, 1), cA + hstep, voffA);
        if (wr == 1) PG8_BAR;
        PG8_WAIT_V(2); PG8_BAR;
        PG8_STAGE(PG8_SB(1, 0), cB + kstep, voffB); PG8_STAGE(PG8_SA(1, 0), cA + kstep, voffA); PG8_STAGE(PG8_SB(1, 1), cB + hstep + kstep, voffB);
        PG8_WAIT_V(6); PG8_BAR;
    } else {
        PG8_STAGE(PG8_SB(0, 0), cB, voffB); PG8_STAGE(PG8_SA(0, 0), cA, voffA); PG8_STAGE(PG8_SB(0, 1), cB + hstep, voffB); PG8_STAGE(PG8_SA(0, 1), cA + hstep, voffA);
        if (wr == 1) PG8_BAR;
        PG8_WAIT_V(4); PG8_BAR;
        PG8_STAGE(PG8_SB(1, 0), cB + kstep, voffB); PG8_STAGE(PG8_SA(1, 0), cA + kstep, voffA); PG8_STAGE(PG8_SB(1, 1), cB + hstep + kstep, voffB);
        PG8_WAIT_V(6); PG8_BAR;
    }
    for (;;) {
        const bool has_next = S.next(ui + 1, nxt);
        const char* nA = has_next ? (const char*)g.A + (size_t)nxt.pm * tstep : cA; const char* nB = has_next ? (const char*)g.Bt + (size_t)nxt.pn * tstep : cB;
        for (int t = 0; t < nt; t += 2) {
            const bool last = (t == nt - 2);
            const char* a1 = cA + (size_t)(t + 1) * kstep;
            const char* a2 = last ? nA : cA + (size_t)(t + 2) * kstep; const char* b2 = last ? nB : cB + (size_t)(t + 2) * kstep;
            const char* a3 = a2 + kstep; const char* b3 = b2 + kstep;
            if (last && has_next) S.a_ready(nxt);
            if constexpr (SP2) {
            PG8_LDB(B0, 0, 0); PG8_LDB(B1, 0, 1); PG8_SCHED; PG8_LDA(At, 0, 0); PG8_STAGE(PG8_SA(1, 1), a1 + hstep, voffA);
            PG8_WAIT_V(8); PG8_WAIT_L(0); PG8_BAR; PG8_MMA(0, 0, At, B0); PG8_MMA(0, 1, At, B1); PG8_BAR; PG8_SCHED;
            PG8_LDA(At, 0, 1); PG8_STAGE(PG8_SB(0, 0), b2, voffB); PG8_STAGE(PG8_SB(0, 1), b2 + hstep, voffB); PG8_STAGE(PG8_SA(0, 0), a2, voffA);
            PG8_WAIT_V(8); PG8_WAIT_L(0); PG8_BAR; PG8_MMA(1, 0, At, B0); PG8_MMA(1, 1, At, B1); PG8_BAR; PG8_SCHED;
            PG8_LDB(B0, 1, 0); PG8_LDB(B1, 1, 1); PG8_SCHED; PG8_LDA(At, 1, 0); PG8_STAGE(PG8_SA(0, 1), a2 + hstep, voffA);
            PG8_WAIT_V(8); PG8_WAIT_L(0); PG8_BAR; PG8_MMA(0, 0, At, B0); PG8_MMA(0, 1, At, B1); PG8_BAR; PG8_SCHED;
            PG8_LDA(At, 1, 1); PG8_STAGE(PG8_SB(1, 0), b3, voffB); PG8_STAGE(PG8_SB(1, 1), b3 + hstep, voffB); PG8_STAGE(PG8_SA(1, 0), a3, voffA);
            PG8_WAIT_V(8); PG8_WAIT_L(0); PG8_BAR; PG8_MMA(1, 0, At, B0); PG8_MMA(1, 1, At, B1); PG8_BAR; PG8_SCHED;
            } else {
            PG8_LDB(B0, 0, 0); PG8_SCHED; PG8_LDA(At, 0, 0); PG8_STAGE(PG8_SA(1, 1), a1 + hstep, voffA);
            PG8_WAIT_L(8); PG8_BAR; PG8_WAIT_L(0); PG8_MMA(0, 0, At, B0); PG8_BAR; PG8_SCHED;
            PG8_LDB(B1, 0, 1); PG8_STAGE(PG8_SB(0, 0), b2, voffB);
            PG8_BAR; PG8_WAIT_L(0); PG8_MMA(0, 1, At, B1); PG8_BAR;
            PG8_LDA(At, 0, 1); PG8_STAGE(PG8_SA(0, 0), a2, voffA);
            PG8_BAR; PG8_WAIT_L(0); PG8_MMA(1, 0, At, B0); PG8_BAR; PG8_SCHED;
            PG8_STAGE(PG8_SB(0, 1), b2 + hstep, voffB);
            PG8_WAIT_V(6); PG8_BAR; PG8_MMA(1, 1, At, B1); PG8_BAR;
            PG8_LDB(B0, 1, 0); PG8_SCHED; PG8_LDA(At, 1, 0); PG8_STAGE(PG8_SA(0, 1), a2 + hstep, voffA);
            PG8_WAIT_L(8); PG8_BAR; PG8_WAIT_L(0); PG8_MMA(0, 0, At, B0); PG8_BAR; PG8_SCHED;
            PG8_LDB(B1, 1, 1); PG8_STAGE(PG8_SB(1, 0), b3, voffB);
            PG8_BAR; PG8_WAIT_L(0); PG8_MMA(0, 1, At, B1); PG8_BAR;
            PG8_LDA(At, 1, 1); PG8_STAGE(PG8_SA(1, 0), a3, voffA);
            PG8_BAR; PG8_WAIT_L(0); PG8_MMA(1, 0, At, B0); PG8_BAR; PG8_SCHED;
            PG8_STAGE(PG8_SB(1, 1), b3 + hstep, voffB);
            PG8_WAIT_V(6); PG8_BAR; PG8_MMA(1, 1, At, B1); PG8_BAR;
            }
        }
        if constexpr (ALIGN_EPI) { if (wr == 0) PG8_BAR; }
        if constexpr (!Epi::AFTER_DRAIN) { E(acc, cur, wr, wc, fr, fq); S.done(cur); }
        if (!has_next) break;
#pragma unroll
        for (int a = 0; a < 2; ++a)
#pragma unroll
            for (int b = 0; b < 2; ++b)
#pragma unroll
                for (int m = 0; m < 4; ++m)
#pragma unroll
                    for (int n = 0; n < 2; ++n) acc[a][b][m][n] = (f32x4){0.f, 0.f, 0.f, 0.f};
        cur = nxt; cA = nA; cB = nB; ++ui;
        if constexpr (ALIGN_EPI) { if (wr == 1) PG8_BAR; }
    }
    PG8_WAIT_V(0);
    if constexpr (!ALIGN_EPI) { if (wr == 0) PG8_BAR; }
    PG8_BAR;
    if constexpr (Epi::AFTER_DRAIN) { E.fused(acc, cur, wr, wc, fr, fq, lds, wid, lane); S.done(cur); }
#undef PG8_SA
#undef PG8_SB
#undef PG8_STAGE
#undef PG8_LDA
#undef PG8_LDB
#undef PG8_MMA
#undef PG8_WAIT_V
#undef PG8_WAIT_L
#undef PG8_BAR
#undef PG8_SCHED
}
}
#define GAS __attribute__((address_space(1)))
#define LAS __attribute__((address_space(3)))
namespace mk {
using pg8::bf16_t; using pg8::bf16x8; using pg8::f32x4; using pg8::u32x4; using pg8::Unit; using pg8::cvt_pk_bf16;
typedef float f32x16 __attribute__((ext_vector_type(16)));
typedef float f32x2 __attribute__((ext_vector_type(2)));
typedef unsigned u32x2 __attribute__((ext_vector_type(2)));
typedef GAS unsigned gu32;
typedef __bf16 bf16x2_t __attribute__((ext_vector_type(2)));
__device__ __forceinline__ unsigned cvt_pk(float lo, float hi) { f32x2 v = {lo, hi}; bf16x2_t b = __builtin_convertvector(v, bf16x2_t); return __builtin_bit_cast(unsigned, b); }
#define RLX_AGENT __ATOMIC_RELAXED, __HIP_MEMORY_SCOPE_AGENT
#define LDS_WAIT() asm volatile("s_waitcnt lgkmcnt(0)" ::: "memory")
#define VM_WAIT() asm volatile("s_waitcnt vmcnt(0)" ::: "memory")

constexpr int T = 8192, D = 2048, DIN = 10752, DC = 1024, NH = 12, HD = 128, AW = 1536, AO = 512, NE = 32, DE = 2048, TOPK = 4;
constexpr float EPS = 1e-5f;
constexpr float QSCALE = 0.12751743082459868f;
constexpr float LN2 = 0.6931471805599453f;
constexpr int MAXRT = 160, NROWS = MAXRT * 256;
constexpr int NWAVES = 8;

constexpr size_t MiB = 1u << 20;
constexpr size_t WS_CTL = 0, CTL_ZERO_BYTES = 64 * 1024;
constexpr size_t WS_WIN = 1 * MiB;
constexpr size_t WS_WCO = 43 * MiB;
constexpr size_t WS_WAO = 47 * MiB;
constexpr size_t WS_WOUT = 49 * MiB;
constexpr size_t WS_WE1 = 57 * MiB;
constexpr size_t WS_WE2 = 569 * MiB;
constexpr size_t WS_H = 825 * MiB;
constexpr size_t WS_U = 857 * MiB;
constexpr size_t WS_Q = 873 * MiB, WS_K = 897 * MiB, WS_V = 921 * MiB;
constexpr size_t WS_GATE = 945 * MiB;
constexpr size_t WS_UC = 1009 * MiB;
constexpr size_t WS_OG = 1025 * MiB;
constexpr size_t WS_LSE = 1073 * MiB;
constexpr size_t WS_OC = 1074 * MiB;
constexpr size_t WS_M1 = 1082 * MiB;
constexpr size_t WS_MG = 1146 * MiB;
constexpr size_t WS_X1 = 1178 * MiB;
constexpr size_t WS_H2 = 1242 * MiB;
constexpr size_t WS_AE = 1274 * MiB, WS_APOS = 1275 * MiB, WS_AGATE = 1276 * MiB, WS_ASLOT = 1277 * MiB;
constexpr size_t WS_XG = 1278 * MiB;
constexpr size_t WS_ACT = 1438 * MiB;
constexpr size_t WS_Y = 1598 * MiB;
constexpr size_t WS_END = 1758 * MiB;
constexpr int CW_CNT = 64;
constexpr int CW_BAR = 4096;

constexpr int RING_BYTES = 131072;
constexpr int LDSCTL_OFF = RING_BYTES, MISC_OFF = LDSCTL_OFF + 320, TAB_OFF = LDSCTL_OFF + 1024;
constexpr int LDS_BYTES = 147456;

__device__ __forceinline__ unsigned f2bf(float f) { unsigned u = __builtin_bit_cast(unsigned, f); return (u + 0x7fffu + ((u >> 16) & 1u)) >> 16; }
__device__ __forceinline__ unsigned pk2(float lo, float hi) { return f2bf(lo) | (f2bf(hi) << 16); }
__device__ __forceinline__ float bflo(unsigned w) { return __builtin_bit_cast(float, w << 16); }
__device__ __forceinline__ float bfhi(unsigned w) { return __builtin_bit_cast(float, w & 0xffff0000u); }
__device__ __forceinline__ float sigm(float x) { return __builtin_amdgcn_rcpf(1.0f + __expf(-x)); }
__device__ __forceinline__ float wave_sum(float v) {
#pragma unroll
    for (int o = 1; o < 64; o <<= 1) v += __shfl_xor(v, o);
    return v;
}
__device__ __forceinline__ float wave_max(float v) {
#pragma unroll
    for (int o = 1; o < 64; o <<= 1) v = fmaxf(v, __shfl_xor(v, o));
    return v;
}

struct EpiProj {
    static constexpr bool PERM = true, AFTER_DRAIN = false;
    bf16_t *U, *Q, *G; const float* bgate;
    __device__ __forceinline__ void operator()(const f32x4 (&acc)[2][2][4][2], const Unit& u, int wr, int wc, int fr, int fq) const {
        const int row0 = u.pm * 256 + wr * 64 + fr, cl = wc * 32 + 8 * fq;
        if (u.pn < 8) {
#pragma unroll
            for (int ai = 0; ai < 2; ++ai)
#pragma unroll
                for (int m = 0; m < 4; ++m) {
                    const f32x4 a0 = acc[ai][0][m][0], a1 = acc[ai][0][m][1], g0 = acc[ai][1][m][0], g1 = acc[ai][1][m][1];
                    u32x4 w; w.x = cvt_pk(a0[0] * sigm(g0[0]), a0[1] * sigm(g0[1])); w.y = cvt_pk(a0[2] * sigm(g0[2]), a0[3] * sigm(g0[3]));
                    w.z = cvt_pk(a1[0] * sigm(g1[0]), a1[1] * sigm(g1[1])); w.w = cvt_pk(a1[2] * sigm(g1[2]), a1[3] * sigm(g1[3]));
                    *(u32x4*)(U + (size_t)(row0 + ai * 128 + m * 16) * DC + u.pn * 128 + cl) = w; }
        } else if (u.pn < 26) {
            const int s = (u.pn - 8) / 6, pl = (u.pn - 8) % 6; bf16_t* base = Q + (size_t)s * ((WS_K - WS_Q) / 2); const float sc = (s == 0) ? QSCALE : 1.0f;
#pragma unroll
            for (int ai = 0; ai < 2; ++ai)
#pragma unroll
                for (int m = 0; m < 4; ++m) { bf16_t* rowp = base + (size_t)(row0 + ai * 128 + m * 16) * AW + pl * 256 + cl;
#pragma unroll
                    for (int bj = 0; bj < 2; ++bj) { const f32x4 v0 = acc[ai][bj][m][0] * sc, v1 = acc[ai][bj][m][1] * sc;
                        u32x4 w; w.x = cvt_pk(v0[0], v0[1]); w.y = cvt_pk(v0[2], v0[3]); w.z = cvt_pk(v1[0], v1[1]); w.w = cvt_pk(v1[2], v1[3]);
                        *(u32x4*)(rowp + bj * 128) = w; } }
        } else {
            const int c0 = (u.pn - 26) * 256 + cl;
            f32x4 bv[2][2];
#pragma unroll
            for (int bj = 0; bj < 2; ++bj)
#pragma unroll
                for (int n = 0; n < 2; ++n) bv[bj][n] = *(const f32x4*)(bgate + c0 + bj * 128 + 4 * n);
#pragma unroll
            for (int ai = 0; ai < 2; ++ai)
#pragma unroll
                for (int m = 0; m < 4; ++m) { bf16_t* rowp = G + (size_t)(row0 + ai * 128 + m * 16) * (2 * D) + c0;
#pragma unroll
                    for (int bj = 0; bj < 2; ++bj) { const f32x4 v0 = acc[ai][bj][m][0] + bv[bj][0], v1 = acc[ai][bj][m][1] + bv[bj][1];
                        u32x4 w; w.x = cvt_pk(sigm(v0[0]), sigm(v0[1])); w.y = cvt_pk(sigm(v0[2]), sigm(v0[3])); w.z = cvt_pk(sigm(v1[0]), sigm(v1[1])); w.w = cvt_pk(sigm(v1[2]), sigm(v1[3]));
                        *(u32x4*)(rowp + bj * 128) = w; } }
        }
    }
};
struct EpiConvOut {
    static constexpr bool PERM = false, AFTER_DRAIN = false;
    float* M1; const bf16_t* G; const float* bco;
    __device__ __forceinline__ void operator()(const f32x4 (&acc)[2][2][4][2], const Unit& u, int wr, int wc, int fr, int fq) const {
        const int row0 = u.pm * 256 + wr * 64 + fr, col0 = u.pn * 256 + wc * 32 + 4 * fq;
        f32x4 bv[2][2];
#pragma unroll
        for (int bj = 0; bj < 2; ++bj)
#pragma unroll
            for (int n = 0; n < 2; ++n) bv[bj][n] = *(const f32x4*)(bco + col0 + bj * 128 + n * 16);
#pragma unroll
        for (int ai = 0; ai < 2; ++ai)
#pragma unroll
            for (int m = 0; m < 4; ++m) { const size_t row = (size_t)(row0 + ai * 128 + m * 16);
#pragma unroll
                for (int bj = 0; bj < 2; ++bj)
#pragma unroll
                    for (int n = 0; n < 2; ++n) { const int col = col0 + bj * 128 + n * 16;
                        const u32x2 gw = *(const u32x2*)(G + row * (2 * D) + col); const f32x4 v = acc[ai][bj][m][n] + bv[bj][n];
                        f32x4 o; o[0] = bflo(gw.x) * v[0]; o[1] = bfhi(gw.x) * v[1]; o[2] = bflo(gw.y) * v[2]; o[3] = bfhi(gw.y) * v[3];
                        *(f32x4*)(M1 + row * D + col) = o; } }
    }
};
struct EpiAttnOut {
    static constexpr bool PERM = false, AFTER_DRAIN = false;
    const float* M1; const bf16_t* G; bf16_t* MG;
    __device__ __forceinline__ void operator()(const f32x4 (&acc)[2][2][4][2], const Unit& u, int wr, int wc, int fr, int fq) const {
        const int row0 = u.pm * 256 + wr * 64 + fr, col0 = u.pn * 256 + wc * 32 + 4 * fq;
#pragma unroll
        for (int ai = 0; ai < 2; ++ai)
#pragma unroll
            for (int m = 0; m < 4; ++m) { const size_t row = (size_t)(row0 + ai * 128 + m * 16);
#pragma unroll
                for (int bj = 0; bj < 2; ++bj)
#pragma unroll
                    for (int n = 0; n < 2; ++n) { const int col = col0 + bj * 128 + n * 16;
                        const u32x2 gw = *(const u32x2*)(G + row * (2 * D) + D + col); const f32x4 v = acc[ai][bj][m][n]; const f32x4 m1 = *(const f32x4*)(M1 + row * D + col);
                        u32x2 w; w.x = cvt_pk(m1[0] + bflo(gw.x) * v[0], m1[1] + bfhi(gw.x) * v[1]); w.y = cvt_pk(m1[2] + bflo(gw.y) * v[2], m1[3] + bfhi(gw.y) * v[3]);
                        *(u32x2*)(MG + row * D + col) = w; } }
    }
};
struct EpiResid {
    static constexpr bool PERM = false, AFTER_DRAIN = false;
    const float* X; float* X1;
    __device__ __forceinline__ void operator()(const f32x4 (&acc)[2][2][4][2], const Unit& u, int wr, int wc, int fr, int fq) const {
        const int row0 = u.pm * 256 + wr * 64 + fr, col0 = u.pn * 256 + wc * 32 + 4 * fq;
#pragma unroll
        for (int ai = 0; ai < 2; ++ai)
#pragma unroll
            for (int m = 0; m < 4; ++m) { const size_t off = (size_t)(row0 + ai * 128 + m * 16) * D + col0;
#pragma unroll
                for (int bj = 0; bj < 2; ++bj)
#pragma unroll
                    for (int n = 0; n < 2; ++n) { const f32x4 xv = *(const f32x4*)(X + off + bj * 128 + n * 16); *(f32x4*)(X1 + off + bj * 128 + n * 16) = xv + acc[ai][bj][m][n]; } }
    }
};
struct EpiSwiGLU {
    static constexpr bool PERM = true, AFTER_DRAIN = false;
    bf16_t* ACT; const float* bin;
    __device__ __forceinline__ void operator()(const f32x4 (&acc)[2][2][4][2], const Unit& u, int wr, int wc, int fr, int fq) const {
        const int e = u.pn >> 4, pl = u.pn & 15;
        const int row0 = u.pm * 256 + wr * 64 + fr, cl = pl * 128 + wc * 32 + 8 * fq;
        f32x4 bg[2], bu[2];
#pragma unroll
        for (int n = 0; n < 2; ++n) { bg[n] = *(const f32x4*)(bin + (size_t)e * (2 * DE) + cl + 4 * n); bu[n] = *(const f32x4*)(bin + (size_t)e * (2 * DE) + DE + cl + 4 * n); }
#pragma unroll
        for (int ai = 0; ai < 2; ++ai)
#pragma unroll
            for (int m = 0; m < 4; ++m) {
                float o[8];
#pragma unroll
                for (int n = 0; n < 2; ++n) { const f32x4 gv = acc[ai][0][m][n] + bg[n], uv = acc[ai][1][m][n] + bu[n];
#pragma unroll
                    for (int q = 0; q < 4; ++q) { const float gg = fminf(gv[q], 7.0f), uu = fminf(fmaxf(uv[q], -7.0f), 7.0f); o[4 * n + q] = (uu + 1.0f) * (gg * sigm(1.702f * gg)); } }
                u32x4 w; w.x = cvt_pk(o[0], o[1]); w.y = cvt_pk(o[2], o[3]); w.z = cvt_pk(o[4], o[5]); w.w = cvt_pk(o[6], o[7]);
                *(u32x4*)(ACT + (size_t)(row0 + ai * 128 + m * 16) * DE + cl) = w; }
    }
};
struct EpiExpOut {
    static constexpr bool PERM = true, AFTER_DRAIN = false;
    bf16_t* Y; const float* bout;
    __device__ __forceinline__ void operator()(const f32x4 (&acc)[2][2][4][2], const Unit& u, int wr, int wc, int fr, int fq) const {
        const int e = u.pn >> 3, pl = u.pn & 7;
        const int row0 = u.pm * 256 + wr * 64 + fr, c0 = pl * 256 + wc * 32 + 8 * fq;
        f32x4 bv[2][2];
#pragma unroll
        for (int bj = 0; bj < 2; ++bj)
#pragma unroll
            for (int n = 0; n < 2; ++n) bv[bj][n] = *(const f32x4*)(bout + (size_t)e * D + c0 + bj * 128 + 4 * n);
#pragma unroll
        for (int ai = 0; ai < 2; ++ai)
#pragma unroll
            for (int m = 0; m < 4; ++m) { bf16_t* rowp = Y + (size_t)(row0 + ai * 128 + m * 16) * D + c0;
#pragma unroll
                for (int bj = 0; bj < 2; ++bj) { const f32x4 v0 = acc[ai][bj][m][0] + bv[bj][0], v1 = acc[ai][bj][m][1] + bv[bj][1];
                    u32x4 w; w.x = cvt_pk(v0[0], v0[1]); w.y = cvt_pk(v0[2], v0[3]); w.z = cvt_pk(v1[0], v1[1]); w.w = cvt_pk(v1[2], v1[3]);
                    *(u32x4*)(rowp + bj * 128) = w; } }
    }
};
struct MoeOrder {
    const LAS int* rt0; int NT, G, c;
    __device__ __forceinline__ bool next(int i, Unit& u) const {
        const int L = i * G + c; const int total = rt0[NE] * NT; if (L >= total) return false;
        int e = 0;
#pragma unroll 1
        for (int q = 1; q < NE; ++q) if (L >= rt0[q] * NT) e = q;
        const int b = rt0[e], mt = rt0[e + 1] - b, idx = L - b * NT;
        u.pn = __builtin_amdgcn_readfirstlane(e * NT + idx / mt); u.pm = __builtin_amdgcn_readfirstlane(b + idx % mt); return true;
    }
    __device__ __forceinline__ void a_ready(const Unit&) const {}
    __device__ __forceinline__ void done(const Unit&) const {}
};

#define XB_TMO      128
#define XB_XCNT(j)  (256  + 64 * (j))
#define XB_XSUB(j)  (1280 + 64 * (j))
#define XB_XGEN(j)  (2304 + 64 * (j))
#define XB_TOP      3328
#define XB_TOPGEN   3392
#define XCD_BAR_WORDS 3456
#define XB_SPIN_CAP (1u << 18)

__device__ __forceinline__ unsigned xb_ld(unsigned* p)              { return __hip_atomic_load(p, __ATOMIC_RELAXED, __HIP_MEMORY_SCOPE_AGENT); }
__device__ __forceinline__ unsigned xb_add(unsigned* p, unsigned v) { return __hip_atomic_fetch_add(p, v, __ATOMIC_RELAXED, __HIP_MEMORY_SCOPE_AGENT); }
__device__ __forceinline__ unsigned xb_xcc_id() { return (unsigned)__builtin_amdgcn_s_getreg((3 << 11) | 20) & 0xFu; }
#define XB_SPIN(cond, bar) do { unsigned _sp = 0; while (cond) { __builtin_amdgcn_s_sleep(1); \
    if ((++_sp & 255u) == 0u) { if (xb_ld(&(bar)[XB_TMO])) break; if (_sp > XB_SPIN_CAP) { atomicAdd(&(bar)[XB_TMO], 1u); break; } } } } while (0)

struct XcdBarrier {
    unsigned* bar; unsigned x;
    volatile LAS unsigned* st;
};

__device__ __forceinline__ XcdBarrier xcd_barrier_post(unsigned* bar, volatile LAS unsigned* st) {
    XcdBarrier b; b.bar = bar; b.x = xb_xcc_id(); b.st = st;
    if (threadIdx.x == 0) (void)xb_add(&bar[XB_XCNT(b.x)], 1u);
    return b;
}
__device__ __forceinline__ void xcd_barrier_complete(unsigned* bar, unsigned x, unsigned& nloc, unsigned& nx) {
    const unsigned G = gridDim.x * gridDim.y * gridDim.z;
    unsigned sum, cnt, mine, sp = 0u;
    for (;;) {
        sum = 0u; cnt = 0u; mine = 0u;
#pragma unroll
        for (unsigned j = 0; j < 16; ++j) { const unsigned c = xb_ld(&bar[XB_XCNT(j)]); sum += c; cnt += (c > 0u) ? 1u : 0u; mine = (j == x) ? c : mine; }
        if (sum == G) break;
        __builtin_amdgcn_s_sleep(1);
        if ((++sp & 255u) == 0u) { if (xb_ld(&bar[XB_TMO])) break; if (sp > XB_SPIN_CAP) { atomicAdd(&bar[XB_TMO], 1u); break; } }
    }
    nloc = mine > 0u ? mine : 1u; nx = cnt > 0u ? cnt : 1u;
}

__device__ __forceinline__ void xcd_barrier(const XcdBarrier& b) {
    asm volatile("s_waitcnt vmcnt(0)" ::: "memory");
    __syncthreads();
    if (threadIdx.x == 0) {
        unsigned* bar = b.bar;
        __builtin_amdgcn_s_waitcnt(0);
        unsigned nloc = b.st[0], nx = b.st[1];
        if (nloc == 0u) { xcd_barrier_complete(bar, b.x, nloc, nx); b.st[0] = nloc; b.st[1] = nx; }
        const unsigned old = xb_add(&bar[XB_XSUB(b.x)], 1u);
        const unsigned gen = old / nloc;
        if (old + 1u == (gen + 1u) * nloc) {
            __builtin_amdgcn_fence(__ATOMIC_RELEASE, "agent");
            asm volatile("s_waitcnt vmcnt(0)" ::: "memory");
            const unsigned og = xb_add(&bar[XB_TOP], 1u);
            const unsigned tg = og / nx;
            if (og + 1u == (tg + 1u) * nx) xb_add(&bar[XB_TOPGEN], 1u);
            else XB_SPIN(xb_ld(&bar[XB_TOPGEN]) == tg, bar);
            __builtin_amdgcn_fence(__ATOMIC_ACQUIRE, "agent");
            xb_add(&bar[XB_XGEN(b.x)], 1u);
            asm volatile("s_waitcnt vmcnt(0)" ::: "memory");
        } else {
            XB_SPIN(xb_ld(&bar[XB_XGEN(b.x)]) == gen, bar);
            __builtin_amdgcn_fence(__ATOMIC_ACQUIRE, "agent");
            asm volatile("s_waitcnt vmcnt(0)" ::: "memory");
        }
    }
    __syncthreads();
}

struct Frame {
    LAS unsigned char* lds; volatile LAS unsigned* MISC; gu32* ctl;
    int tid, lane, wave, vcu, G;
};
struct Args { const float* in[20]; float* out; unsigned char* ws; int ph_lo, ph_hi, li, pad; };

__device__ __forceinline__ void p0_transpose_item(const float* W, int K, int N, bf16_t* WT, int k0, int n0, int drow0, LAS float* scr, int lane) {
#pragma unroll 8
    for (int i = 0; i < 32; ++i) { const int kk = 2 * i + (lane >> 5); scr[kk * 33 + (lane & 31)] = W[(size_t)(k0 + kk) * N + n0 + (lane & 31)]; }
    LDS_WAIT(); asm volatile("" ::: "memory");
    const int c = lane & 7;
#pragma unroll
    for (int j = 0; j < 4; ++j) { const int n = (lane >> 3) + 8 * j; const LAS float* s = scr + (8 * c) * 33 + n;
        u32x4 o; o.x = pk2(s[0 * 33], s[1 * 33]); o.y = pk2(s[2 * 33], s[3 * 33]); o.z = pk2(s[4 * 33], s[5 * 33]); o.w = pk2(s[6 * 33], s[7 * 33]);
        *(GAS u32x4*)(WT + (size_t)(drow0 + n) * K + k0 + 8 * c) = o; }
    LDS_WAIT(); asm volatile("" ::: "memory");
}
__device__ __forceinline__ int paired_row(int n0, int halfN) { return (n0 < halfN) ? ((n0 >> 7) * 256 + (n0 & 127)) : (((n0 - halfN) >> 7) * 256 + 128 + ((n0 - halfN) & 127)); }

__device__ __forceinline__ void rms_row_to_bf16(const float* xrow, const float* g, bf16_t* orow, int lane) {
    const GAS f32x4* xr = (const GAS f32x4*)xrow + lane;
    f32x4 v[8]; float ss = 0.f;
#pragma unroll
    for (int j = 0; j < 8; ++j) { v[j] = xr[64 * j]; ss += (v[j][0] * v[j][0] + v[j][1] * v[j][1]) + (v[j][2] * v[j][2] + v[j][3] * v[j][3]); }
    const float rs = rsqrtf(wave_sum(ss) * (1.0f / D) + EPS);
    GAS u32x2* o8 = (GAS u32x2*)orow + lane;
#pragma unroll
    for (int j = 0; j < 8; ++j) { const f32x4 gg = ((const GAS f32x4*)g)[lane + 64 * j]; u32x2 w; w.x = pk2(v[j][0] * rs * gg[0], v[j][1] * rs * gg[1]); w.y = pk2(v[j][2] * rs * gg[2], v[j][3] * rs * gg[3]); o8[64 * j] = w; }
}

__device__ __forceinline__ void conv_tile(Frame& F, int tile, const bf16_t* U, const float* cw, const float* cb, const float* lg, const float* lb, bf16_t* UC) {
    const int t0 = tile * 32, c = 2 * F.tid;
    LAS float* ys = (LAS float*)F.lds;
    f32x2 w[31];
#pragma unroll
    for (int k = 0; k < 31; ++k) w[k] = *(const f32x2*)(cw + k * DC + c);
    const f32x2 bias = *(const f32x2*)(cb + c);
    f32x2 win[31];
#pragma unroll
    for (int p = 0; p < 30; ++p) { const int tt = t0 - 30 + p; unsigned v = 0u; if (tt >= 0) v = *(const unsigned*)(U + (size_t)tt * DC + c); win[p] = (f32x2){bflo(v), bfhi(v)}; }
    win[30] = (f32x2){0.f, 0.f};
#pragma unroll 1
    for (int jb = 0; jb < 32; jb += 31) {
#pragma unroll
        for (int p = 0; p < 31; ++p) {
            const int j = jb + p;
            if (j < 32) {
                const unsigned v = *(const unsigned*)(U + (size_t)(t0 + j) * DC + c);
                win[(30 + p) % 31] = (f32x2){bflo(v), bfhi(v)};
                f32x2 a = bias;
#pragma unroll
                for (int k = 0; k < 31; ++k) a += w[k] * win[(p + k) % 31];
                *(LAS f32x2*)(ys + j * DC + c) = a;
            }
        }
    }
    __syncthreads();
#pragma unroll 1
    for (int jj = 0; jj < 4; ++jj) {
        const int j = F.wave * 4 + jj;
        f32x4 v[4]; float s = 0.f;
#pragma unroll
        for (int q = 0; q < 4; ++q) { v[q] = *(const LAS f32x4*)(ys + j * DC + 4 * F.lane + 256 * q); s += (v[q][0] + v[q][1]) + (v[q][2] + v[q][3]); }
        const float mu = wave_sum(s) * (1.0f / DC); float qq = 0.f;
#pragma unroll
        for (int q = 0; q < 4; ++q) { v[q] = v[q] - mu; qq += (v[q][0] * v[q][0] + v[q][1] * v[q][1]) + (v[q][2] * v[q][2] + v[q][3] * v[q][3]); }
        const float rstd = rsqrtf(wave_sum(qq) * (1.0f / DC) + EPS);
#pragma unroll
        for (int q = 0; q < 4; ++q) { const int cc = 4 * F.lane + 256 * q; const f32x4 g4 = *(const f32x4*)(lg + cc), b4 = *(const f32x4*)(lb + cc);
            float y[4];
#pragma unroll
            for (int z = 0; z < 4; ++z) { const float t = v[q][z] * rstd * g4[z] + b4[z]; y[z] = t * sigm(t); }
            u32x2 o; o.x = cvt_pk(y[0], y[1]); o.y = cvt_pk(y[2], y[3]);
            *(u32x2*)(UC + (size_t)(t0 + j) * DC + cc) = o; }
    }
    __syncthreads();
}

__device__ __forceinline__ void attn_task(const bf16_t* __restrict__ Q, const bf16_t* __restrict__ Kb, const bf16_t* __restrict__ Vb, float* OG, float* LSE, int task, int lane) {
    const int h = task >> 8, rem = task & 255;
    const int dsh = 2 * (h >> 2), dil = 1 << dsh;
    const int r = rem & (dil - 1), mc = rem >> dsh;
    const int i = lane & 31, hh = lane >> 5;
    const int m0 = mc * 32;
    const int tq = ((m0 + i) << dsh) + r;
    bf16x8 qf[8];
    { const bf16_t* qp = Q + (size_t)tq * AW + h * HD + 8 * hh;
#pragma unroll
      for (int s = 0; s < 8; ++s) qf[s] = *(const bf16x8*)(qp + 16 * s); }
    const int jt0 = (mc < 4) ? (4 - mc) : 0;
    const float NEG = -__builtin_inff();
    f32x16 sacc[5];
#pragma unroll
    for (int jt = 0; jt < 5; ++jt) {
        f32x16 a;
#pragma unroll
        for (int q = 0; q < 16; ++q) a[q] = 0.f;
        if (jt >= jt0) {
            const int mk = m0 - 128 + 32 * jt + i;
            const bf16_t* kp = Kb + (size_t)((mk << dsh) + r) * AW + h * HD + 8 * hh;
#pragma unroll
            for (int s = 0; s < 8; ++s) { const bf16x8 kf = *(const bf16x8*)(kp + 16 * s); a = __builtin_amdgcn_mfma_f32_32x32x16_bf16(kf, qf[s], a, 0, 0, 0); }
#pragma unroll
            for (int q = 0; q < 16; ++q) { const int kk = (q & 3) + 8 * (q >> 2) + 4 * hh;
                if (jt == 0 && kk < i) a[q] = NEG;
                if (jt == 4 && kk > i) a[q] = NEG; }
        } else {
#pragma unroll
            for (int q = 0; q < 16; ++q) a[q] = NEG;
        }
        sacc[jt] = a;
        __builtin_amdgcn_sched_barrier(0);
    }
    float mx = NEG;
#pragma unroll
    for (int jt = 0; jt < 5; ++jt)
#pragma unroll
        for (int q = 0; q < 16; ++q) mx = fmaxf(mx, sacc[jt][q]);
    mx = fmaxf(mx, __shfl_xor(mx, 32));
    float l = 0.f;
#pragma unroll
    for (int jt = 0; jt < 5; ++jt)
#pragma unroll
        for (int q = 0; q < 16; ++q) { const float e = __builtin_amdgcn_exp2f(sacc[jt][q] - mx); sacc[jt][q] = e; l += e; }
    l += __shfl_xor(l, 32);
    const float inv = 1.0f / l;
    if (hh == 0) LSE[(size_t)tq * NH + h] = (mx + __log2f(l)) * LN2;
    bf16x8 pf[5][2];
#pragma unroll
    for (int jt = 0; jt < 5; ++jt)
#pragma unroll
        for (int s2 = 0; s2 < 2; ++s2) { u32x4 w;
            w.x = cvt_pk(sacc[jt][8 * s2 + 0] * inv, sacc[jt][8 * s2 + 1] * inv); w.y = cvt_pk(sacc[jt][8 * s2 + 2] * inv, sacc[jt][8 * s2 + 3] * inv);
            w.z = cvt_pk(sacc[jt][8 * s2 + 4] * inv, sacc[jt][8 * s2 + 5] * inv); w.w = cvt_pk(sacc[jt][8 * s2 + 6] * inv, sacc[jt][8 * s2 + 7] * inv);
            pf[jt][s2] = __builtin_bit_cast(bf16x8, w); }
    f32x16 o[4];
#pragma unroll
    for (int z = 0; z < 4; ++z)
#pragma unroll
        for (int q = 0; q < 16; ++q) o[z][q] = 0.f;
    const bf16_t* vcol = Vb + h * HD + 2 * i;
#pragma unroll
    for (int jt = 0; jt < 5; ++jt) {
        if (jt >= jt0) {
#pragma unroll
            for (int s2 = 0; s2 < 2; ++s2) {
                unsigned wa[8], wb[8];
#pragma unroll
                for (int j = 0; j < 8; ++j) { const int mk = m0 - 128 + 32 * jt + 16 * s2 + 8 * (j >> 2) + 4 * hh + (j & 3); const bf16_t* vp = vcol + (size_t)((mk << dsh) + r) * AW;
                    wa[j] = *(const unsigned*)vp; wb[j] = *(const unsigned*)(vp + 64); }
                u32x4 f0, f1, f2, f3;
                f0.x = (wa[0] & 0xffffu) | (wa[1] << 16); f0.y = (wa[2] & 0xffffu) | (wa[3] << 16); f0.z = (wa[4] & 0xffffu) | (wa[5] << 16); f0.w = (wa[6] & 0xffffu) | (wa[7] << 16);
                f1.x = (wa[0] >> 16) | (wa[1] & 0xffff0000u); f1.y = (wa[2] >> 16) | (wa[3] & 0xffff0000u); f1.z = (wa[4] >> 16) | (wa[5] & 0xffff0000u); f1.w = (wa[6] >> 16) | (wa[7] & 0xffff0000u);
                f2.x = (wb[0] & 0xffffu) | (wb[1] << 16); f2.y = (wb[2] & 0xffffu) | (wb[3] << 16); f2.z = (wb[4] & 0xffffu) | (wb[5] << 16); f2.w = (wb[6] & 0xffffu) | (wb[7] << 16);
                f3.x = (wb[0] >> 16) | (wb[1] & 0xffff0000u); f3.y = (wb[2] >> 16) | (wb[3] & 0xffff0000u); f3.z = (wb[4] >> 16) | (wb[5] & 0xffff0000u); f3.w = (wb[6] >> 16) | (wb[7] & 0xffff0000u);
                o[0] = __builtin_amdgcn_mfma_f32_32x32x16_bf16(pf[jt][s2], __builtin_bit_cast(bf16x8, f0), o[0], 0, 0, 0);
                o[1] = __builtin_amdgcn_mfma_f32_32x32x16_bf16(pf[jt][s2], __builtin_bit_cast(bf16x8, f1), o[1], 0, 0, 0);
                o[2] = __builtin_amdgcn_mfma_f32_32x32x16_bf16(pf[jt][s2], __builtin_bit_cast(bf16x8, f2), o[2], 0, 0, 0);
                o[3] = __builtin_amdgcn_mfma_f32_32x32x16_bf16(pf[jt][s2], __builtin_bit_cast(bf16x8, f3), o[3], 0, 0, 0);
                __builtin_amdgcn_sched_barrier(0);
            }
        }
    }
#pragma unroll
    for (int q = 0; q < 16; ++q) { const int qi = (q & 3) + 8 * (q >> 2) + 4 * hh; const int tt = ((m0 + qi) << dsh) + r;
        float* op = OG + ((size_t)tt * NH + h) * HD + 2 * i;
        *(f32x2*)op = (f32x2){o[0][q], o[1][q]}; *(f32x2*)(op + 64) = (f32x2){o[2][q], o[3][q]}; }
}

__global__ void __launch_bounds__(NWAVES * 64, 2) mk_fwd(Args args) {
    extern __shared__ __attribute__((aligned(16))) unsigned char lds[];
    Frame F;
    F.lds = (LAS unsigned char*)lds;
    F.MISC = (volatile LAS unsigned*)(F.lds + MISC_OFF);
    F.tid = threadIdx.x; F.lane = F.tid & 63; F.wave = __builtin_amdgcn_readfirstlane(F.tid >> 6);
    F.G = gridDim.x; { const int bx = blockIdx.x; F.vcu = (F.G % 8 == 0) ? (bx % 8) * (F.G / 8) + bx / 8 : bx; }
    unsigned char* ws = args.ws;
    F.ctl = (gu32*)(ws + WS_CTL);
    for (int u = F.tid; u < (LDS_BYTES - LDSCTL_OFF) / 4; u += NWAVES * 64) ((LAS unsigned*)(F.lds + LDSCTL_OFF))[u] = 0u;
    __syncthreads();
    const bool one_launch = (args.ph_hi - args.ph_lo) > 1;
    XcdBarrier bar; bar.bar = (unsigned*)(F.ctl + CW_BAR) + args.li * XCD_BAR_WORDS; bar.x = 0; bar.st = nullptr;
    if (one_launch) bar = xcd_barrier_post((unsigned*)(F.ctl + CW_BAR) + args.li * XCD_BAR_WORDS, F.MISC + 8);
    const int lo = args.ph_lo, hi = args.ph_hi;
#ifndef MK_PHASE_MASK
#define MK_PHASE_MASK 0xfff
#endif
#define IN(k) ((((MK_PHASE_MASK) >> (k)) & 1) && lo <= (k) && (k) < hi)
#define SEAM(k) do { if (IN(k) && IN((k) + 1)) xcd_barrier(bar); } while (0)

    const float* x = args.in[0]; const float* n1g = args.in[1]; const float* w_in = args.in[2]; const float* b_gate = args.in[3];
    const float* conv_w = args.in[4]; const float* conv_b = args.in[5]; const float* ln_g = args.in[6]; const float* ln_b = args.in[7];
    const float* w_co = args.in[8]; const float* b_co = args.in[9]; const float* w_ao = args.in[10]; const float* w_out = args.in[11];
    const float* n2g = args.in[12]; const float* w_r = args.in[13]; const float* b_r = args.in[14];
    const float* w_ei = args.in[15]; const float* b_ei = args.in[16]; const float* w_eo = args.in[17]; const float* b_eo = args.in[18]; const float* nfg = args.in[19];
    bf16_t* WIN = (bf16_t*)(ws + WS_WIN); bf16_t* WCO = (bf16_t*)(ws + WS_WCO); bf16_t* WAO = (bf16_t*)(ws + WS_WAO); bf16_t* WOUT = (bf16_t*)(ws + WS_WOUT);
    bf16_t* WE1 = (bf16_t*)(ws + WS_WE1); bf16_t* WE2 = (bf16_t*)(ws + WS_WE2);
    bf16_t* Hb = (bf16_t*)(ws + WS_H); bf16_t* Ub = (bf16_t*)(ws + WS_U); bf16_t* Qb = (bf16_t*)(ws + WS_Q); bf16_t* Kb = (bf16_t*)(ws + WS_K); bf16_t* Vb = (bf16_t*)(ws + WS_V);
    bf16_t* Gb = (bf16_t*)(ws + WS_GATE); bf16_t* UCb = (bf16_t*)(ws + WS_UC); float* OG = (float*)(ws + WS_OG); float* LSE = (float*)(ws + WS_LSE); bf16_t* OCb = (bf16_t*)(ws + WS_OC);
    float* M1 = (float*)(ws + WS_M1); bf16_t* MGb = (bf16_t*)(ws + WS_MG); float* X1 = (float*)(ws + WS_X1); bf16_t* H2b = (bf16_t*)(ws + WS_H2);
    int* a_e = (int*)(ws + WS_AE); int* a_pos = (int*)(ws + WS_APOS); float* a_gate = (float*)(ws + WS_AGATE); int* a_slot = (int*)(ws + WS_ASLOT);
    bf16_t* XG = (bf16_t*)(ws + WS_XG); bf16_t* ACT = (bf16_t*)(ws + WS_ACT); bf16_t* Yb = (bf16_t*)(ws + WS_Y);
    int* cnt = (int*)(F.ctl + CW_CNT);
    const int gw = F.vcu * NWAVES + F.wave, NGW = F.G * NWAVES;

    if (IN(0)) {
        LAS float* scr = (LAS float*)(F.lds + F.wave * 16384);
        constexpr int I_IN = (D / 64) * (DIN / 32), I_CO = (DC / 64) * (D / 32), I_AO = (AO / 64) * (D / 32), I_OUT = (D / 64) * (D / 32);
        constexpr int I_E1 = (D / 64) * (2 * DE / 32), I_E2 = (DE / 64) * (D / 32);
        constexpr int NSMALL = I_IN + I_CO + I_AO + I_OUT;
        for (int it = gw; it < NSMALL; it += NGW) {
            int q = it;
            if (q < I_IN) { const int nb = DIN / 32, k0 = 64 * (q / nb), n0 = 32 * (q % nb); const int dr = (n0 < 2048) ? paired_row(n0, 1024) : n0; p0_transpose_item(w_in, D, DIN, WIN, k0, n0, dr, scr, F.lane); continue; } q -= I_IN;
            if (q < I_CO) { const int nb = D / 32, k0 = 64 * (q / nb), n0 = 32 * (q % nb); p0_transpose_item(w_co, DC, D, WCO, k0, n0, n0, scr, F.lane); continue; } q -= I_CO;
            if (q < I_AO) { const int nb = D / 32, k0 = 64 * (q / nb), n0 = 32 * (q % nb); p0_transpose_item(w_ao, AO, D, WAO, k0, n0, n0, scr, F.lane); continue; } q -= I_AO;
            { const int nb = D / 32, k0 = 64 * (q / nb), n0 = 32 * (q % nb); p0_transpose_item(w_out, D, D, WOUT, k0, n0, n0, scr, F.lane); }
        }
        for (int it = gw; it < NE * I_E1; it += NGW) { const int e = it / I_E1, q = it % I_E1; const int nb = 2 * DE / 32, k0 = 64 * (q / nb), n0 = 32 * (q % nb);
            p0_transpose_item(w_ei + (size_t)e * D * 2 * DE, D, 2 * DE, WE1 + (size_t)e * 2 * DE * D, k0, n0, paired_row(n0, DE), scr, F.lane); }
        for (int it = gw; it < NE * I_E2; it += NGW) { const int e = it / I_E2, q = it % I_E2; const int nb = D / 32, k0 = 64 * (q / nb), n0 = 32 * (q % nb);
            p0_transpose_item(w_eo + (size_t)e * DE * D, DE, D, WE2 + (size_t)e * D * DE, k0, n0, n0, scr, F.lane); }
        for (int m = gw; m < T; m += NGW) rms_row_to_bf16(x + (size_t)m * D, n1g, Hb + (size_t)m * D, F.lane);
    }
    SEAM(0);
    if (IN(1)) {
        pg8::Gemm g{Hb, WIN, T, DIN, D}; pg8::StaticOrder S; S.init(T, DIN, F.G, (int)blockIdx.x);
        static_assert(WS_V - WS_K == WS_K - WS_Q, "q|k|v strides"); EpiProj E{Ub, Qb, Gb, b_gate};
        pg8::gemm_phase<EpiProj, pg8::StaticOrder, true, true>(F.lds, g, S, E);
    }
    SEAM(1);
    if (IN(2)) {
#ifndef MK_NO_CONV
        for (int tile = F.vcu; tile < T / 32; tile += F.G) conv_tile(F, tile, Ub, conv_w, conv_b, ln_g, ln_b, UCb);
#endif
#ifndef MK_NO_ATTN
        for (int task = gw; task < NH * 256; task += NGW) attn_task(Qb, Kb, Vb, OG, LSE, task, F.lane);
#endif
    }
    SEAM(2);
    if (IN(3)) {
        for (int it = gw; it < T * 4; it += NGW) { const int t = it >> 2, hg = it & 3;
            const float l0 = LSE[(size_t)t * NH + hg], l1 = LSE[(size_t)t * NH + 4 + hg], l2 = LSE[(size_t)t * NH + 8 + hg];
            const float m = fmaxf(l0, fmaxf(l1, l2)); const float w0 = __expf(l0 - m), w1 = __expf(l1 - m), w2 = __expf(l2 - m), inv = 1.0f / (w0 + w1 + w2);
            const f32x2 a = *(const f32x2*)(OG + ((size_t)t * NH + hg) * HD + 2 * F.lane), b = *(const f32x2*)(OG + ((size_t)t * NH + 4 + hg) * HD + 2 * F.lane), c = *(const f32x2*)(OG + ((size_t)t * NH + 8 + hg) * HD + 2 * F.lane);
            const f32x2 o = (a * w0 + b * w1 + c * w2) * inv;
            *(unsigned*)(OCb + (size_t)t * AO + hg * HD + 2 * F.lane) = cvt_pk(o[0], o[1]); }
    }
    SEAM(3);
    if (IN(4)) {
        pg8::Gemm g{UCb, WCO, T, D, DC}; pg8::StaticOrder S; S.init(T, D, F.G, (int)blockIdx.x);
        EpiConvOut E{M1, Gb, b_co};
        pg8::gemm_phase<EpiConvOut, pg8::StaticOrder, false, true>(F.lds, g, S, E);
    }
    SEAM(4);
    if (IN(5)) {
        pg8::Gemm g{OCb, WAO, T, D, AO}; pg8::StaticOrder S; S.init(T, D, F.G, (int)blockIdx.x);
        EpiAttnOut E{M1, Gb, MGb};
        pg8::gemm_phase<EpiAttnOut, pg8::StaticOrder, false, true>(F.lds, g, S, E);
    }
    SEAM(5);
    if (IN(6)) {
        pg8::Gemm g{MGb, WOUT, T, D, D}; pg8::StaticOrder S; S.init(T, D, F.G, (int)blockIdx.x);
        EpiResid E{x, X1};
        pg8::gemm_phase<EpiResid, pg8::StaticOrder, false, true>(F.lds, g, S, E);
    }
    SEAM(6);
    if (IN(7)) {
        LAS float* xs = (LAS float*)F.lds;
        for (int unit = F.vcu; unit < T / 16; unit += F.G) {
            const int t0 = unit * 16;
#pragma unroll 1
            for (int tt = 2 * F.wave; tt < 2 * F.wave + 2; ++tt) {
                const GAS f32x4* xr = (const GAS f32x4*)(X1 + (size_t)(t0 + tt) * D) + F.lane;
                f32x4 v[8]; float ss = 0.f;
#pragma unroll
                for (int j = 0; j < 8; ++j) { v[j] = xr[64 * j]; ss += (v[j][0] * v[j][0] + v[j][1] * v[j][1]) + (v[j][2] * v[j][2] + v[j][3] * v[j][3]); }
                const float rs = rsqrtf(wave_sum(ss) * (1.0f / D) + EPS);
                GAS u32x2* o8 = (GAS u32x2*)(H2b + (size_t)(t0 + tt) * D) + F.lane;
#pragma unroll
                for (int j = 0; j < 8; ++j) { const f32x4 gg = ((const GAS f32x4*)n2g)[F.lane + 64 * j]; const f32x4 y = v[j] * rs * gg;
                    *(LAS f32x4*)(xs + tt * D + 4 * (F.lane + 64 * j)) = y; u32x2 w; w.x = pk2(y[0], y[1]); w.y = pk2(y[2], y[3]); o8[64 * j] = w; }
            }
            __syncthreads();
            float pacc[16];
#pragma unroll
            for (int tt = 0; tt < 16; ++tt) pacc[tt] = 0.f;
            { const int e = F.lane & 31, kh = F.lane >> 5, i0 = 256 * F.wave + 128 * kh;
#pragma unroll 2
              for (int ii = 0; ii < 128; ii += 4) {
                  const float w0 = w_r[(size_t)(i0 + ii) * NE + e], w1 = w_r[(size_t)(i0 + ii + 1) * NE + e], w2 = w_r[(size_t)(i0 + ii + 2) * NE + e], w3 = w_r[(size_t)(i0 + ii + 3) * NE + e];
#pragma unroll
                  for (int tt = 0; tt < 16; ++tt) { const f32x4 xv = *(const LAS f32x4*)(xs + tt * D + i0 + ii); pacc[tt] += (xv[0] * w0 + xv[1] * w1) + (xv[2] * w2 + xv[3] * w3); }
              } }
#pragma unroll
            for (int tt = 0; tt < 16; ++tt) pacc[tt] += __shfl_xor(pacc[tt], 32);
            __syncthreads();
            if (F.lane < 32) {
#pragma unroll
                for (int tt = 0; tt < 16; ++tt) xs[(F.wave * 16 + tt) * 32 + F.lane] = pacc[tt];
            }
            __syncthreads();
#pragma unroll 1
            for (int tt = 2 * F.wave; tt < 2 * F.wave + 2; ++tt) {
                float lg = -__builtin_inff();
                if (F.lane < 32) { float s = b_r[F.lane];
#pragma unroll
                    for (int w = 0; w < 8; ++w) s += xs[(w * 16 + tt) * 32 + F.lane];
                    lg = s; }
                int sel_e[4]; float sel_v[4];
#pragma unroll
                for (int k = 0; k < 4; ++k) { const float m = wave_max(lg); const unsigned long long b = __ballot(lg == m); const int e = __ffsll((long long)b) - 1; sel_e[k] = e; sel_v[k] = m; if (F.lane == e) lg = -__builtin_inff(); }
                const float e1 = __expf(sel_v[1] - sel_v[0]), e2 = __expf(sel_v[2] - sel_v[0]), e3 = __expf(sel_v[3] - sel_v[0]);
                const float inv = 1.0f / (1.0f + e1 + e2 + e3);
                if (F.lane < 4) {
                    const int e = F.lane == 0 ? sel_e[0] : F.lane == 1 ? sel_e[1] : F.lane == 2 ? sel_e[2] : sel_e[3];
                    const float gt = (F.lane == 0 ? 1.0f : F.lane == 1 ? e1 : F.lane == 2 ? e2 : e3) * inv;
                    const int pos = atomicAdd(&cnt[e], 1);
                    const int a = (t0 + tt) * 4 + F.lane; a_e[a] = e; a_pos[a] = pos; a_gate[a] = gt;
                }
            }
            __syncthreads();
        }
    }
    SEAM(7);
    LAS int* rt0 = (LAS int*)(F.lds + TAB_OFF);
    if (hi > 8 && lo <= 10) {
        if (F.tid == 0) { int a = 0; for (int e = 0; e < NE; ++e) { rt0[e] = a; a += (__hip_atomic_load(&cnt[e], RLX_AGENT) + 255) >> 8; } rt0[NE] = a; }
        __syncthreads();
    }
    if (IN(8)) {
        for (int a = gw; a < T * TOPK; a += NGW) { const int e = a_e[a], slot = 256 * rt0[e] + a_pos[a];
            if (F.lane == 0) a_slot[a] = slot;
            const GAS u32x4* src = (const GAS u32x4*)(H2b + (size_t)(a >> 2) * D) + F.lane; GAS u32x4* dst = (GAS u32x4*)(XG + (size_t)slot * D) + F.lane;
#pragma unroll
            for (int j = 0; j < 4; ++j) dst[64 * j] = src[64 * j]; }
        for (int it = gw; it < NE * 256; it += NGW) { const int e = it >> 8, j = it & 255; const int row = 256 * rt0[e] + __hip_atomic_load(&cnt[e], RLX_AGENT) + j;
            if (row < 256 * rt0[e + 1]) { GAS u32x4* dst = (GAS u32x4*)(XG + (size_t)row * D) + F.lane;
#pragma unroll
                for (int j2 = 0; j2 < 4; ++j2) dst[64 * j2] = (u32x4){0u, 0u, 0u, 0u}; } }
    }
    SEAM(8);
    if (IN(9)) {
        pg8::Gemm g{XG, WE1, NROWS, NE * 2 * DE, D}; MoeOrder S{rt0, 16, F.G, F.vcu};
        EpiSwiGLU E{ACT, b_ei};
        pg8::gemm_phase<EpiSwiGLU, MoeOrder, true, true>(F.lds, g, S, E);
    }
    SEAM(9);
    if (IN(10)) {
        pg8::Gemm g{ACT, WE2, NROWS, NE * D, DE}; MoeOrder S{rt0, 8, F.G, F.vcu};
        EpiExpOut E{Yb, b_eo};
        pg8::gemm_phase<EpiExpOut, MoeOrder, true, true>(F.lds, g, S, E);
    }
    SEAM(10);
    if (IN(11)) {
        for (int t = gw; t < T; t += NGW) {
            f32x4 v[8];
#pragma unroll
            for (int j = 0; j < 8; ++j) v[j] = ((const GAS f32x4*)(X1 + (size_t)t * D))[F.lane + 64 * j];
#pragma unroll
            for (int k = 0; k < 4; ++k) { const int s = a_slot[t * 4 + k]; const float gt = a_gate[t * 4 + k]; const GAS u32x2* yr = (const GAS u32x2*)(Yb + (size_t)s * D) + F.lane;
#pragma unroll
                for (int j = 0; j < 8; ++j) { const u32x2 w = yr[64 * j]; v[j][0] += gt * bflo(w.x); v[j][1] += gt * bfhi(w.x); v[j][2] += gt * bflo(w.y); v[j][3] += gt * bfhi(w.y); } }
            float ss = 0.f;
#pragma unroll
            for (int j = 0; j < 8; ++j) ss += (v[j][0] * v[j][0] + v[j][1] * v[j][1]) + (v[j][2] * v[j][2] + v[j][3] * v[j][3]);
            const float rs = rsqrtf(wave_sum(ss) * (1.0f / D) + EPS);
            GAS f32x4* o = (GAS f32x4*)(args.out + (size_t)t * D);
#pragma unroll
            for (int j = 0; j < 8; ++j) { const f32x4 gg = ((const GAS f32x4*)nfg)[F.lane + 64 * j]; o[F.lane + 64 * j] = v[j] * rs * gg; }
        }
    }
#undef IN
#undef SEAM
}
constexpr int N_PHASES = 12;
}

#ifndef MK_CUTS
#define MK_CUTS 0
#endif
extern "C" void kernel_launch(void* const* d_in, const int* in_sizes, int n_in, void* d_out, int out_size, void* d_ws, size_t ws_size, hipStream_t stream) {
    using namespace mk;
    static int grid = 0;
    if (grid == 0) {
        int dev = 0, cus = 0;
        if (hipGetDevice(&dev) != hipSuccess || hipDeviceGetAttribute(&cus, hipDeviceAttributeMultiprocessorCount, dev) != hipSuccess) { grid = -1; return; }
        if (hipFuncSetAttribute((const void*)mk_fwd, hipFuncAttributeMaxDynamicSharedMemorySize, LDS_BYTES) != hipSuccess) { grid = -1; return; }
        int per_cu = 0;
        if (hipOccupancyMaxActiveBlocksPerMultiprocessor(&per_cu, (const void*)mk_fwd, NWAVES * 64, LDS_BYTES) != hipSuccess || per_cu < 1) { fprintf(stderr, "kernel_launch: occupancy query says %d\n", per_cu); }
        (void)hipGetLastError();
        grid = cus;
    }
    if (grid < 0) return;
    (void)hipMemsetAsync((char*)d_ws + WS_CTL, 0, CTL_ZERO_BYTES, stream);
    Args a{};
    for (int i = 0; i < 20; ++i) a.in[i] = (const float*)d_in[i];
    a.out = (float*)d_out; a.ws = (unsigned char*)d_ws;
#if MK_CUTS == 0
    a.ph_lo = 0; a.ph_hi = N_PHASES; a.li = 0; a.pad = 0;
    hipLaunchKernelGGL(mk_fwd, dim3(grid), dim3(NWAVES * 64), LDS_BYTES, stream, a);
#else
    for (int p = 0; p < N_PHASES; ++p) { a.ph_lo = p; a.ph_hi = p + 1; a.li = 0; a.pad = 0; hipLaunchKernelGGL(mk_fwd, dim3(grid), dim3(NWAVES * 64), LDS_BYTES, stream, a); }
#endif
}
```

```cpp
#include <hip/hip_runtime.h>
#include <cstdio>
#include <cstdint>
namespace pg8 {
#define PG8_LAS __attribute__((address_space(3)))
typedef unsigned short bf16_t;
typedef short bf16x8 __attribute__((ext_vector_type(8)));
typedef float f32x4 __attribute__((ext_vector_type(4)));
typedef unsigned u32x4 __attribute__((ext_vector_type(4)));
typedef int pg8_v4i __attribute__((ext_vector_type(4)));
constexpr int BM = 256, BK = 64, HALF = 128, HTB = HALF * BK * 2  , STAGE_BYTES = 8 * HTB, NXCD = 8, WGM = 8;

__host__ __device__ __forceinline__ int lds_byte(int r, int c) { const int st = (r >> 4) * 2 + (c >> 5), rr = r & 15, cc = c & 31, ob = rr * 64 + cc * 2; return st * 1024 + (ob ^ (((ob >> 9) & 1) << 5)); }
__host__ __device__ __forceinline__ void stage_rc(int b, int& R, int& C) { const int st = b / 1024, sb = b % 1024, swz = sb ^ (((sb >> 9) & 1) << 5); R = (st >> 1) * 16 + swz / 64; C = (st & 1) * 32 + (swz % 64) / 2; }
__host__ __device__ __forceinline__ int perm32(int rho) { const int n = rho >> 4, i = rho & 15; return 8 * (i >> 2) + 4 * n + (i & 3); }

struct Unit { int pm, pn; };
struct Gemm { const bf16_t* A; const bf16_t* Bt; int M, N, K; };

struct StaticOrder {
    int nM, nN, nwg, G, c;
    __host__ __device__ void init(int M, int N, int G_, int c_) { nM = M / BM; nN = N / BM; nwg = nM * nN; G = G_; c = c_; }
    __host__ __device__ bool next(int i, Unit& u) const {
        const long L = (long)i * G + c; if (L >= nwg) return false;
        int wgid = (int)L; { const int q = nwg / NXCD, r = nwg % NXCD, xcd = wgid % NXCD, off = wgid / NXCD; wgid = (xcd < r ? xcd * (q + 1) : r * (q + 1) + (xcd - r) * q) + off; }
        const int nig = WGM * nN, gid = wgid / nig, fm = gid * WGM, gsz = (nM - fm) < WGM ? (nM - fm) : WGM;
        u.pm = fm + ((wgid % nig) % gsz); u.pn = (wgid % nig) / gsz; return true;
    }
    __device__ __forceinline__ void a_ready(const Unit&) const {}
    __device__ __forceinline__ void done(const Unit&) const {}
};

__device__ __forceinline__ unsigned cvt_pk_bf16(float lo, float hi) { unsigned r; asm volatile("v_cvt_pk_bf16_f32 %0, %1, %2" : "=v"(r) : "v"(lo), "v"(hi)); return r; }
template <class Epi, class Sched, bool ALIGN_EPI = false, bool SP2 = false, int F8W = 0, int F8X = 0>
__device__ __forceinline__ void gemm_phase(PG8_LAS unsigned char* lds, const Gemm g, const Sched& S, const Epi& E) {
    const int tid = threadIdx.x, wid = __builtin_amdgcn_readfirstlane(tid >> 6), lane = tid & 63, wr = wid >> 2, wc = wid & 3, fr = lane & 15, fq = lane >> 4;
    const int K = g.K, nt = K / BK;
    int f8w_ = F8W, f8x_ = F8X; asm volatile("" : "+v"(f8w_), "+v"(f8x_));
    unsigned voffA[2], voffB[2];
#pragma unroll
    for (int i = 0; i < 2; ++i) { int R, C; stage_rc(tid * 16 + i * 8192, R, C); const int Rb = Epi::PERM ? ((R & ~31) + perm32(R & 31)) : R;
        voffA[i] = (unsigned)(R * K + C) * 2u; voffB[i] = (unsigned)(Rb * K + C) * 2u; }
    const size_t kstep = (size_t)(BK * 2);
    const size_t hstep = (size_t)HALF * K * 2;
    const size_t tstep = 2 * hstep;
    const unsigned ldsw = (unsigned)wid * 1024u;
    const int aoff = lds_byte(wr * 64 + fr, fq * 8), boff = lds_byte(wc * 32 + fr, fq * 8);
#define PG8_SA(b, h) (((b) * 2 + (h)) * HTB)
#define PG8_SB(b, h) ((4 + (b) * 2 + (h)) * HTB)
#define PG8_STAGE(bufoff, gbase, voff) do { _Pragma("unroll") for (int _i = 0; _i < 2; ++_i) \
        __builtin_amdgcn_global_load_lds((const unsigned*)((const char*)(gbase) + (voff)[_i]), (PG8_LAS unsigned*)(lds + (bufoff) + ldsw + _i * 8192), 16, 0, 0); } while (0)
#define PG8_LDA(dst, b, h) do { _Pragma("unroll") for (int m = 0; m < 4; ++m) _Pragma("unroll") for (int k = 0; k < 2; ++k) dst[m][k] = *(const PG8_LAS bf16x8*)(lds + PG8_SA(b, h) + aoff + m * 2048 + k * 1024); } while (0)
#define PG8_LDB(dst, b, h) do { _Pragma("unroll") for (int n = 0; n < 2; ++n) _Pragma("unroll") for (int k = 0; k < 2; ++k) dst[n][k] = *(const PG8_LAS bf16x8*)(lds + PG8_SB(b, h) + boff + n * 2048 + k * 1024); } while (0)
#define PG8_CAT8(lo, hi) __builtin_shufflevector(__builtin_bit_cast(pg8_v4i, lo), __builtin_bit_cast(pg8_v4i, hi), 0, 1, 2, 3, 4, 5, 6, 7)
#define PG8_MMA(ai, bj, At, Bt) do { __builtin_amdgcn_s_setprio(1); if constexpr (F8W != 0) { _Pragma("unroll") for (int m = 0; m < 4; ++m) _Pragma("unroll") for (int n = 0; n < 2; ++n) \
        asm volatile("v_mfma_scale_f32_16x16x128_f8f6f4 %0, %1, %2, %0, %3, %4 op_sel_hi:[0,0,0]" : "+v"(acc[ai][bj][m][n]) : "v"(PG8_CAT8(Bt[n][0], Bt[n][1])), "v"(PG8_CAT8(At[m][0], At[m][1])), "v"(f8w_), "v"(f8x_)); } else { \
        _Pragma("unroll") for (int m = 0; m < 4; ++m) _Pragma("unroll") for (int n = 0; n < 2; ++n) _Pragma("unroll") for (int k = 0; k < 2; ++k) \
        acc[ai][bj][m][n] = __builtin_amdgcn_mfma_f32_16x16x32_bf16(Bt[n][k], At[m][k], acc[ai][bj][m][n], 0, 0, 0); } __builtin_amdgcn_s_setprio(0); } while (0)
#define PG8_WAIT_V(n) asm volatile("s_waitcnt vmcnt(" #n ")" ::: "memory")
#define PG8_WAIT_L(n) asm volatile("s_waitcnt lgkmcnt(" #n ")" ::: "memory")
#define PG8_BAR __builtin_amdgcn_s_barrier()
#define PG8_SCHED __builtin_amdgcn_sched_barrier(0)
    Unit cur, nxt; int ui = 0;
    if (!S.next(0, cur)) return;
    f32x4 acc[2][2][4][2];
#pragma unroll
    for (int a = 0; a < 2; ++a)
#pragma unroll
        for (int b = 0; b < 2; ++b)
#pragma unroll
            for (int m = 0; m < 4; ++m)
#pragma unroll
                for (int n = 0; n < 2; ++n) acc[a][b][m][n] = (f32x4){0.f, 0.f, 0.f, 0.f};
    bf16x8 At[4][2], B0[2][2], B1[2][2];
    const char* cA = (const char*)g.A + (size_t)cur.pm * tstep; const char* cB = (const char*)g.Bt + (size_t)cur.pn * tstep;
    S.a_ready(cur);
    if constexpr (SP2) {
        PG8_STAGE(PG8_SB(0, 0), cB, voffB); PG8_STAGE(PG8_SB(0, 1), cB + hstep, voffB); PG8_STAGE(PG8_SA(0, 0), cA, voffA); PG8_STAGE(PG8_SA(0, 1), cA + hstep, voffA);
        if (wr == 1) PG8_BAR;
        PG8_WAIT_V(2); PG8_BAR;
        PG8_STAGE(PG8_SB(1, 0), cB + kstep, voffB); PG8_STAGE(PG8_SA(1, 0), cA + kstep, voffA); PG8_STAGE(PG8_SB(1, 1), cB + hstep + kstep, voffB);
        PG8_WAIT_V(6); PG8_BAR;
    } else {
        PG8_STAGE(PG8_SB(0, 0), cB, voffB); PG8_STAGE(PG8_SA(0, 0), cA, voffA); PG8_STAGE(PG8_SB(0, 1), cB + hstep, voffB); PG8_STAGE(PG8_SA(0, 1), cA + hstep, voffA);
        if (wr == 1) PG8_BAR;
        PG8_WAIT_V(4); PG8_BAR;
        PG8_STAGE(PG8_SB(1, 0), cB + kstep, voffB); PG8_STAGE(PG8_SA(1, 0), cA + kstep, voffA); PG8_STAGE(PG8_SB(1, 1), cB + hstep + kstep, voffB);
        PG8_WAIT_V(6); PG8_BAR;
    }
    for (;;) {
        const bool has_next = S.next(ui + 1, nxt);
        const char* nA = has_next ? (const char*)g.A + (size_t)nxt.pm * tstep : cA; const char* nB = has_next ? (const char*)g.Bt + (size_t)nxt.pn * tstep : cB;
        for (int t = 0; t < nt; t += 2) {
            const bool last = (t == nt - 2);
            const char* a1 = cA + (size_t)(t + 1) * kstep;
            const char* a2 = last ? nA : cA + (size_t)(t + 2) * kstep; const char* b2 = last ? nB : cB + (size_t)(t + 2) * kstep;
            const char* a3 = a2 + kstep; const char* b3 = b2 + kstep;
            if (last && has_next) S.a_ready(nxt);
            if constexpr (SP2) {
            PG8_LDB(B0, 0, 0); PG8_LDB(B1, 0, 1); PG8_SCHED; PG8_LDA(At, 0, 0); PG8_STAGE(PG8_SA(1, 1), a1 + hstep, voffA);
            PG8_WAIT_V(8); PG8_WAIT_L(0); PG8_BAR; PG8_MMA(0, 0, At, B0); PG8_MMA(0, 1, At, B1); PG8_BAR; PG8_SCHED;
            PG8_LDA(At, 0, 1); PG8_STAGE(PG8_SB(0, 0), b2, voffB); PG8_STAGE(PG8_SB(0, 1), b2 + hstep, voffB); PG8_STAGE(PG8_SA(0, 0), a2, voffA);
            PG8_WAIT_V(8); PG8_WAIT_L(0); PG8_BAR; PG8_MMA(1, 0, At, B0); PG8_MMA(1, 1, At, B1); PG8_BAR; PG8_SCHED;
            PG8_LDB(B0, 1, 0); PG8_LDB(B1, 1, 1); PG8_SCHED; PG8_LDA(At, 1, 0); PG8_STAGE(PG8_SA(0, 1), a2 + hstep, voffA);
            PG8_WAIT_V(8); PG8_WAIT_L(0); PG8_BAR; PG8_MMA(0, 0, At, B0); PG8_MMA(0, 1, At, B1); PG8_BAR; PG8_SCHED;
            PG8_LDA(At, 1, 1); PG8_STAGE(PG8_SB(1, 0), b3, voffB); PG8_STAGE(PG8_SB(1, 1), b3 + hstep, voffB); PG8_STAGE(PG8_SA(1, 0), a3, voffA);
            PG8_WAIT_V(8); PG8_WAIT_L(0); PG8_BAR; PG8_MMA(1, 0, At, B0); PG8_MMA(1, 1, At, B1); PG8_BAR; PG8_SCHED;
            } else {
            PG8_LDB(B0, 0, 0); PG8_SCHED; PG8_LDA(At, 0, 0); PG8_STAGE(PG8_SA(1, 1), a1 + hstep, voffA);
            PG8_WAIT_L(8); PG8_BAR; PG8_WAIT_L(0); PG8_MMA(0, 0, At, B0); PG8_BAR; PG8_SCHED;
            PG8_LDB(B1, 0, 1); PG8_STAGE(PG8_SB(0, 0), b2, voffB);
            PG8_BAR; PG8_WAIT_L(0); PG8_MMA(0, 1, At, B1); PG8_BAR;
            PG8_LDA(At, 0, 1); PG8_STAGE(PG8_SA(0, 0), a2, voffA);
            PG8_BAR; PG8_WAIT_L(0); PG8_MMA(1, 0, At, B0); PG8_BAR; PG8_SCHED;
            PG8_STAGE(PG8_SB(0, 1), b2 + hstep, voffB);
            PG8_WAIT_V(6); PG8_BAR; PG8_MMA(1, 1, At, B1); PG8_BAR;
            PG8_LDB(B0, 1, 0); PG8_SCHED; PG8_LDA(At, 1, 0); PG8_STAGE(PG8_SA(0, 1), a2 + hstep, voffA);
            PG8_WAIT_L(8); PG8_BAR; PG8_WAIT_L(0); PG8_MMA(0, 0, At, B0); PG8_BAR; PG8_SCHED;
            PG8_LDB(B1, 1, 1); PG8_STAGE(PG8_SB(1, 0), b3, voffB);
            PG8_BAR; PG8_WAIT_L(0); PG8_MMA(0, 1, At, B1); PG8_BAR;
            PG8_LDA(At, 1, 1); PG8_STAGE(PG8_SA(1, 0), a3, voffA);
            PG8_BAR; PG8_WAIT_L(0); PG8_MMA(1, 0, At, B0); PG8_BAR; PG8_SCHED;
            PG8_STAGE(PG8_SB(1, 1), b3 + hstep, voffB);
            PG8_WAIT_V(6); PG8_BAR; PG8_MMA(1, 1, At, B1); PG8_BAR;
            }
        }
        if constexpr (F8W != 0) asm volatile("s_nop 15\n\ts_nop 15" ::: "memory");
        if constexpr (ALIGN_EPI) { if (wr == 0) PG8_BAR; }
        if constexpr (!Epi::AFTER_DRAIN) { E(acc, cur, wr, wc, fr, fq); S.done(cur); }
        if (!has_next) break;
#pragma unroll
        for (int a = 0; a < 2; ++a)
#pragma unroll
            for (int b = 0; b < 2; ++b)
#pragma unroll
                for (int m = 0; m < 4; ++m)
#pragma unroll
                    for (int n = 0; n < 2; ++n) acc[a][b][m][n] = (f32x4){0.f, 0.f, 0.f, 0.f};
        cur = nxt; cA = nA; cB = nB; ++ui;
        if constexpr (ALIGN_EPI) { if (wr == 1) PG8_BAR; }
    }
    PG8_WAIT_V(0);
    if constexpr (!ALIGN_EPI) { if (wr == 0) PG8_BAR; }
    PG8_BAR;
    if constexpr (Epi::AFTER_DRAIN) { E.fused(acc, cur, wr, wc, fr, fq, lds, wid, lane); S.done(cur); }
#undef PG8_SA
#undef PG8_SB
#undef PG8_STAGE
#undef PG8_LDA
#undef PG8_LDB
#undef PG8_MMA
#undef PG8_CAT8
#undef PG8_WAIT_V
#undef PG8_WAIT_L
#undef PG8_BAR
#undef PG8_SCHED
}
}
#define GAS __attribute__((address_space(1)))
#define LAS __attribute__((address_space(3)))
namespace mk {
using pg8::bf16_t; using pg8::bf16x8; using pg8::f32x4; using pg8::u32x4; using pg8::Unit; using pg8::cvt_pk_bf16;
typedef float f32x16 __attribute__((ext_vector_type(16)));
typedef float f32x2 __attribute__((ext_vector_type(2)));
typedef unsigned u32x2 __attribute__((ext_vector_type(2)));
typedef GAS unsigned gu32;
typedef __bf16 bf16x2_t __attribute__((ext_vector_type(2)));
__device__ __forceinline__ unsigned cvt_pk(float lo, float hi) { f32x2 v = {lo, hi}; bf16x2_t b = __builtin_convertvector(v, bf16x2_t); return __builtin_bit_cast(unsigned, b); }
#define RLX_AGENT __ATOMIC_RELAXED, __HIP_MEMORY_SCOPE_AGENT
#define LDS_WAIT() asm volatile("s_waitcnt lgkmcnt(0)" ::: "memory")
#define VM_WAIT() asm volatile("s_waitcnt vmcnt(0)" ::: "memory")

constexpr int T = 8192, D = 2048, DIN = 10752, DC = 1024, NH = 12, HD = 128, AW = 1536, AO = 512, NE = 32, DE = 2048, TOPK = 4;
constexpr float EPS = 1e-5f;
constexpr float QSCALE = 0.12751743082459868f;
constexpr float LN2 = 0.6931471805599453f;
constexpr int MAXRT = 160, NROWS = MAXRT * 256;
constexpr int NWAVES = 8;

constexpr size_t MiB = 1u << 20;
constexpr size_t WS_CTL = 0, CTL_ZERO_BYTES = 64 * 1024;
constexpr size_t WS_WIN = 1 * MiB;
constexpr size_t WS_WCO = 43 * MiB;
constexpr size_t WS_WAO = 47 * MiB;
constexpr size_t WS_WOUT = 49 * MiB;
constexpr size_t WS_WE1 = 57 * MiB;
constexpr size_t WS_WE2 = 569 * MiB;
constexpr size_t WS_H = 825 * MiB;
constexpr size_t WS_U = 857 * MiB;
constexpr size_t WS_Q = 873 * MiB, WS_K = 897 * MiB, WS_V = 921 * MiB;
constexpr size_t WS_GATE = 945 * MiB;
constexpr size_t WS_UC = 1009 * MiB;
constexpr size_t WS_OG = 1025 * MiB;
constexpr size_t WS_LSE = 1073 * MiB;
constexpr size_t WS_OC = 1074 * MiB;
constexpr size_t WS_M1 = 1082 * MiB;
constexpr size_t WS_MG = 1146 * MiB;
constexpr size_t WS_X1 = 1178 * MiB;
constexpr size_t WS_H2 = 1242 * MiB;
constexpr size_t WS_AE = 1274 * MiB, WS_APOS = 1275 * MiB, WS_AGATE = 1276 * MiB, WS_ASLOT = 1277 * MiB;
constexpr size_t WS_HIST = WS_ASLOT + 512 * 1024;
constexpr size_t WS_XG = 1278 * MiB;
constexpr size_t WS_ACT = 1438 * MiB;
constexpr size_t WS_Y = 1598 * MiB;
constexpr size_t WS_END = 1758 * MiB;
constexpr int CW_CNT = 64;
constexpr int CW_BAR = 4096;

constexpr int RING_BYTES = 131072;
constexpr int LDSCTL_OFF = RING_BYTES, MISC_OFF = LDSCTL_OFF + 320, TAB_OFF = LDSCTL_OFF + 1024;
constexpr int LDS_BYTES = 147456;

__device__ __forceinline__ unsigned f2bf(float f) { unsigned u = __builtin_bit_cast(unsigned, f); return (u + 0x7fffu + ((u >> 16) & 1u)) >> 16; }
__device__ __forceinline__ unsigned pk2(float lo, float hi) { return f2bf(lo) | (f2bf(hi) << 16); }
__device__ __forceinline__ float bflo(unsigned w) { return __builtin_bit_cast(float, w << 16); }
__device__ __forceinline__ float bfhi(unsigned w) { return __builtin_bit_cast(float, w & 0xffff0000u); }
__device__ __forceinline__ unsigned pk4_fp8(float a, float b, float c, float d) { int w = __builtin_amdgcn_cvt_pk_fp8_f32(a, b, 0, false); w = __builtin_amdgcn_cvt_pk_fp8_f32(c, d, w, true); return (unsigned)w; }
constexpr float S_W = 128.0f, S_X = 16.0f, S_ACT = 4.0f;
constexpr int E8_W = 127 - 7, E8_X = 127 - 4, E8_ACT = 127 - 2;
__device__ __forceinline__ float sigm(float x) { return __builtin_amdgcn_rcpf(1.0f + __expf(-x)); }
__device__ __forceinline__ float wave_sum(float v) {
#pragma unroll
    for (int o = 1; o < 64; o <<= 1) v += __shfl_xor(v, o);
    return v;
}
__device__ __forceinline__ float wave_max(float v) {
#pragma unroll
    for (int o = 1; o < 64; o <<= 1) v = fmaxf(v, __shfl_xor(v, o));
    return v;
}

struct EpiProj {
    static constexpr bool PERM = true, AFTER_DRAIN = false;
    bf16_t *U, *Q, *G; const float* bgate;
    __device__ __forceinline__ void operator()(const f32x4 (&acc)[2][2][4][2], const Unit& u, int wr, int wc, int fr, int fq) const {
        const int row0 = u.pm * 256 + wr * 64 + fr, cl = wc * 32 + 8 * fq;
        if (u.pn < 8) {
#pragma unroll
            for (int ai = 0; ai < 2; ++ai)
#pragma unroll
                for (int m = 0; m < 4; ++m) {
                    const f32x4 a0 = acc[ai][0][m][0], a1 = acc[ai][0][m][1], g0 = acc[ai][1][m][0], g1 = acc[ai][1][m][1];
                    u32x4 w; w.x = cvt_pk(a0[0] * sigm(g0[0]), a0[1] * sigm(g0[1])); w.y = cvt_pk(a0[2] * sigm(g0[2]), a0[3] * sigm(g0[3]));
                    w.z = cvt_pk(a1[0] * sigm(g1[0]), a1[1] * sigm(g1[1])); w.w = cvt_pk(a1[2] * sigm(g1[2]), a1[3] * sigm(g1[3]));
                    *(u32x4*)(U + (size_t)(row0 + ai * 128 + m * 16) * DC + u.pn * 128 + cl) = w; }
        } else if (u.pn < 26) {
            const int s = (u.pn - 8) / 6, pl = (u.pn - 8) % 6; bf16_t* base = Q + (size_t)s * ((WS_K - WS_Q) / 2); const float sc = (s == 0) ? QSCALE : 1.0f;
#pragma unroll
            for (int ai = 0; ai < 2; ++ai)
#pragma unroll
                for (int m = 0; m < 4; ++m) { bf16_t* rowp = base + (size_t)(row0 + ai * 128 + m * 16) * AW + pl * 256 + cl;
#pragma unroll
                    for (int bj = 0; bj < 2; ++bj) { const f32x4 v0 = acc[ai][bj][m][0] * sc, v1 = acc[ai][bj][m][1] * sc;
                        u32x4 w; w.x = cvt_pk(v0[0], v0[1]); w.y = cvt_pk(v0[2], v0[3]); w.z = cvt_pk(v1[0], v1[1]); w.w = cvt_pk(v1[2], v1[3]);
                        *(u32x4*)(rowp + bj * 128) = w; } }
        } else {
            const int c0 = (u.pn - 26) * 256 + cl;
            f32x4 bv[2][2];
#pragma unroll
            for (int bj = 0; bj < 2; ++bj)
#pragma unroll
                for (int n = 0; n < 2; ++n) bv[bj][n] = *(const f32x4*)(bgate + c0 + bj * 128 + 4 * n);
#pragma unroll
            for (int ai = 0; ai < 2; ++ai)
#pragma unroll
                for (int m = 0; m < 4; ++m) { bf16_t* rowp = G + (size_t)(row0 + ai * 128 + m * 16) * (2 * D) + c0;
#pragma unroll
                    for (int bj = 0; bj < 2; ++bj) { const f32x4 v0 = acc[ai][bj][m][0] + bv[bj][0], v1 = acc[ai][bj][m][1] + bv[bj][1];
                        u32x4 w; w.x = cvt_pk(sigm(v0[0]), sigm(v0[1])); w.y = cvt_pk(sigm(v0[2]), sigm(v0[3])); w.z = cvt_pk(sigm(v1[0]), sigm(v1[1])); w.w = cvt_pk(sigm(v1[2]), sigm(v1[3]));
                        *(u32x4*)(rowp + bj * 128) = w; } }
        }
    }
};
struct EpiConvOut {
    static constexpr bool PERM = false, AFTER_DRAIN = false;
    float* M1; const bf16_t* G; const float* bco;
    __device__ __forceinline__ void operator()(const f32x4 (&acc)[2][2][4][2], const Unit& u, int wr, int wc, int fr, int fq) const {
        const int row0 = u.pm * 256 + wr * 64 + fr, col0 = u.pn * 256 + wc * 32 + 4 * fq;
        f32x4 bv[2][2];
#pragma unroll
        for (int bj = 0; bj < 2; ++bj)
#pragma unroll
            for (int n = 0; n < 2; ++n) bv[bj][n] = *(const f32x4*)(bco + col0 + bj * 128 + n * 16);
#pragma unroll
        for (int ai = 0; ai < 2; ++ai)
#pragma unroll
            for (int m = 0; m < 4; ++m) { const size_t row = (size_t)(row0 + ai * 128 + m * 16);
#pragma unroll
                for (int bj = 0; bj < 2; ++bj)
#pragma unroll
                    for (int n = 0; n < 2; ++n) { const int col = col0 + bj * 128 + n * 16;
                        const u32x2 gw = *(const u32x2*)(G + row * (2 * D) + col); const f32x4 v = acc[ai][bj][m][n] + bv[bj][n];
                        f32x4 o; o[0] = bflo(gw.x) * v[0]; o[1] = bfhi(gw.x) * v[1]; o[2] = bflo(gw.y) * v[2]; o[3] = bfhi(gw.y) * v[3];
                        *(f32x4*)(M1 + row * D + col) = o; } }
    }
};
struct EpiAttnOut {
    static constexpr bool PERM = false, AFTER_DRAIN = false;
    const float* M1; const bf16_t* G; bf16_t* MG;
    __device__ __forceinline__ void operator()(const f32x4 (&acc)[2][2][4][2], const Unit& u, int wr, int wc, int fr, int fq) const {
        const int row0 = u.pm * 256 + wr * 64 + fr, col0 = u.pn * 256 + wc * 32 + 4 * fq;
#pragma unroll
        for (int ai = 0; ai < 2; ++ai)
#pragma unroll
            for (int m = 0; m < 4; ++m) { const size_t row = (size_t)(row0 + ai * 128 + m * 16);
#pragma unroll
                for (int bj = 0; bj < 2; ++bj)
#pragma unroll
                    for (int n = 0; n < 2; ++n) { const int col = col0 + bj * 128 + n * 16;
                        const u32x2 gw = *(const u32x2*)(G + row * (2 * D) + D + col); const f32x4 v = acc[ai][bj][m][n]; const f32x4 m1 = *(const f32x4*)(M1 + row * D + col);
                        u32x2 w; w.x = cvt_pk(m1[0] + bflo(gw.x) * v[0], m1[1] + bfhi(gw.x) * v[1]); w.y = cvt_pk(m1[2] + bflo(gw.y) * v[2], m1[3] + bfhi(gw.y) * v[3]);
                        *(u32x2*)(MG + row * D + col) = w; } }
    }
};
struct EpiResid {
    static constexpr bool PERM = false, AFTER_DRAIN = false;
    const float* X; float* X1;
    __device__ __forceinline__ void operator()(const f32x4 (&acc)[2][2][4][2], const Unit& u, int wr, int wc, int fr, int fq) const {
        const int row0 = u.pm * 256 + wr * 64 + fr, col0 = u.pn * 256 + wc * 32 + 4 * fq;
#pragma unroll
        for (int ai = 0; ai < 2; ++ai)
#pragma unroll
            for (int m = 0; m < 4; ++m) { const size_t off = (size_t)(row0 + ai * 128 + m * 16) * D + col0;
#pragma unroll
                for (int bj = 0; bj < 2; ++bj)
#pragma unroll
                    for (int n = 0; n < 2; ++n) { const f32x4 xv = *(const f32x4*)(X + off + bj * 128 + n * 16); *(f32x4*)(X1 + off + bj * 128 + n * 16) = xv + acc[ai][bj][m][n]; } }
    }
};
struct EpiSwiGLU {
    static constexpr bool PERM = true, AFTER_DRAIN = false;
    unsigned char* ACT; const float* bin;
    __device__ __forceinline__ void operator()(const f32x4 (&acc)[2][2][4][2], const Unit& u, int wr, int wc, int fr, int fq) const {
        const int e = u.pn >> 4, pl = u.pn & 15;
        const int row0 = u.pm * 256 + wr * 64 + fr, cl = pl * 128 + wc * 32 + 8 * fq;
        f32x4 bg[2], bu[2];
#pragma unroll
        for (int n = 0; n < 2; ++n) { bg[n] = *(const f32x4*)(bin + (size_t)e * (2 * DE) + cl + 4 * n); bu[n] = *(const f32x4*)(bin + (size_t)e * (2 * DE) + DE + cl + 4 * n); }
#pragma unroll
        for (int ai = 0; ai < 2; ++ai)
#pragma unroll
            for (int m = 0; m < 4; ++m) {
                float o[8];
#pragma unroll
                for (int n = 0; n < 2; ++n) { const f32x4 gv = acc[ai][0][m][n] + bg[n], uv = acc[ai][1][m][n] + bu[n];
#pragma unroll
                    for (int q = 0; q < 4; ++q) { const float gg = fminf(gv[q], 7.0f), uu = fminf(fmaxf(uv[q], -7.0f), 7.0f); o[4 * n + q] = (uu + 1.0f) * (gg * sigm(1.702f * gg)); } }
                u32x2 w; w.x = pk4_fp8(o[0] * S_ACT, o[1] * S_ACT, o[2] * S_ACT, o[3] * S_ACT); w.y = pk4_fp8(o[4] * S_ACT, o[5] * S_ACT, o[6] * S_ACT, o[7] * S_ACT);
                *(u32x2*)(ACT + (size_t)(row0 + ai * 128 + m * 16) * DE + cl) = w; }
    }
};
struct EpiExpOut {
    static constexpr bool PERM = true, AFTER_DRAIN = false;
    bf16_t* Y; const float* bout;
    __device__ __forceinline__ void operator()(const f32x4 (&acc)[2][2][4][2], const Unit& u, int wr, int wc, int fr, int fq) const {
        const int e = u.pn >> 3, pl = u.pn & 7;
        const int row0 = u.pm * 256 + wr * 64 + fr, c0 = pl * 256 + wc * 32 + 8 * fq;
        f32x4 bv[2][2];
#pragma unroll
        for (int bj = 0; bj < 2; ++bj)
#pragma unroll
            for (int n = 0; n < 2; ++n) bv[bj][n] = *(const f32x4*)(bout + (size_t)e * D + c0 + bj * 128 + 4 * n);
#pragma unroll
        for (int ai = 0; ai < 2; ++ai)
#pragma unroll
            for (int m = 0; m < 4; ++m) { bf16_t* rowp = Y + (size_t)(row0 + ai * 128 + m * 16) * D + c0;
#pragma unroll
                for (int bj = 0; bj < 2; ++bj) { const f32x4 v0 = acc[ai][bj][m][0] + bv[bj][0], v1 = acc[ai][bj][m][1] + bv[bj][1];
                    u32x4 w; w.x = cvt_pk(v0[0], v0[1]); w.y = cvt_pk(v0[2], v0[3]); w.z = cvt_pk(v1[0], v1[1]); w.w = cvt_pk(v1[2], v1[3]);
                    *(u32x4*)(rowp + bj * 128) = w; } }
    }
};
struct MoeOrder {
    const LAS int* rt0; int NT, G, c;
    __device__ __forceinline__ bool next(int i, Unit& u) const {
        const int L = i * G + c; const int total = rt0[NE] * NT; if (L >= total) return false;
        int e = 0;
#pragma unroll 1
        for (int q = 1; q < NE; ++q) if (L >= rt0[q] * NT) e = q;
        const int b = rt0[e], mt = rt0[e + 1] - b, idx = L - b * NT;
        u.pn = __builtin_amdgcn_readfirstlane(e * NT + idx / mt); u.pm = __builtin_amdgcn_readfirstlane(b + idx % mt); return true;
    }
    __device__ __forceinline__ void a_ready(const Unit&) const {}
    __device__ __forceinline__ void done(const Unit&) const {}
};

#define XB_TMO      128
#define XB_XCNT(j)  (256  + 64 * (j))
#define XB_XSUB(j)  (1280 + 64 * (j))
#define XB_XGEN(j)  (2304 + 64 * (j))
#define XB_TOP      3328
#define XB_TOPGEN   3392
#define XCD_BAR_WORDS 3456
#define XB_SPIN_CAP (1u << 18)

__device__ __forceinline__ unsigned xb_ld(unsigned* p)              { return __hip_atomic_load(p, __ATOMIC_RELAXED, __HIP_MEMORY_SCOPE_AGENT); }
__device__ __forceinline__ unsigned xb_add(unsigned* p, unsigned v) { return __hip_atomic_fetch_add(p, v, __ATOMIC_RELAXED, __HIP_MEMORY_SCOPE_AGENT); }
__device__ __forceinline__ unsigned xb_xcc_id() { return (unsigned)__builtin_amdgcn_s_getreg((3 << 11) | 20) & 0xFu; }
#define XB_SPIN(cond, bar) do { unsigned _sp = 0; while (cond) { __builtin_amdgcn_s_sleep(1); \
    if ((++_sp & 255u) == 0u) { if (xb_ld(&(bar)[XB_TMO])) break; if (_sp > XB_SPIN_CAP) { atomicAdd(&(bar)[XB_TMO], 1u); break; } } } } while (0)

struct XcdBarrier {
    unsigned* bar; unsigned x;
    volatile LAS unsigned* st;
};

__device__ __forceinline__ XcdBarrier xcd_barrier_post(unsigned* bar, volatile LAS unsigned* st) {
    XcdBarrier b; b.bar = bar; b.x = xb_xcc_id(); b.st = st;
    if (threadIdx.x == 0) (void)xb_add(&bar[XB_XCNT(b.x)], 1u);
    return b;
}
__device__ __forceinline__ void xcd_barrier_complete(unsigned* bar, unsigned x, unsigned& nloc, unsigned& nx) {
    const unsigned G = gridDim.x * gridDim.y * gridDim.z;
    unsigned sum, cnt, mine, sp = 0u;
    for (;;) {
        sum = 0u; cnt = 0u; mine = 0u;
#pragma unroll
        for (unsigned j = 0; j < 16; ++j) { const unsigned c = xb_ld(&bar[XB_XCNT(j)]); sum += c; cnt += (c > 0u) ? 1u : 0u; mine = (j == x) ? c : mine; }
        if (sum == G) break;
        __builtin_amdgcn_s_sleep(1);
        if ((++sp & 255u) == 0u) { if (xb_ld(&bar[XB_TMO])) break; if (sp > XB_SPIN_CAP) { atomicAdd(&bar[XB_TMO], 1u); break; } }
    }
    nloc = mine > 0u ? mine : 1u; nx = cnt > 0u ? cnt : 1u;
}

__device__ __forceinline__ void xcd_barrier(const XcdBarrier& b) {
    asm volatile("s_waitcnt vmcnt(0)" ::: "memory");
    __syncthreads();
    if (threadIdx.x == 0) {
        unsigned* bar = b.bar;
        __builtin_amdgcn_s_waitcnt(0);
        unsigned nloc = b.st[0], nx = b.st[1];
        if (nloc == 0u) { xcd_barrier_complete(bar, b.x, nloc, nx); b.st[0] = nloc; b.st[1] = nx; }
        const unsigned old = xb_add(&bar[XB_XSUB(b.x)], 1u);
        const unsigned gen = old / nloc;
        if (old + 1u == (gen + 1u) * nloc) {
            __builtin_amdgcn_fence(__ATOMIC_RELEASE, "agent");
            asm volatile("s_waitcnt vmcnt(0)" ::: "memory");
            const unsigned og = xb_add(&bar[XB_TOP], 1u);
            const unsigned tg = og / nx;
            if (og + 1u == (tg + 1u) * nx) xb_add(&bar[XB_TOPGEN], 1u);
            else XB_SPIN(xb_ld(&bar[XB_TOPGEN]) == tg, bar);
            __builtin_amdgcn_fence(__ATOMIC_ACQUIRE, "agent");
            xb_add(&bar[XB_XGEN(b.x)], 1u);
            asm volatile("s_waitcnt vmcnt(0)" ::: "memory");
        } else {
            XB_SPIN(xb_ld(&bar[XB_XGEN(b.x)]) == gen, bar);
            __builtin_amdgcn_fence(__ATOMIC_ACQUIRE, "agent");
            asm volatile("s_waitcnt vmcnt(0)" ::: "memory");
        }
    }
    __syncthreads();
}

struct Frame {
    LAS unsigned char* lds; volatile LAS unsigned* MISC; gu32* ctl;
    int tid, lane, wave, vcu, G;
};
struct Args { const float* in[20]; float* out; unsigned char* ws; int ph_lo, ph_hi, li, pad; };

__device__ __forceinline__ void p0_transpose_item(const float* W, int K, int N, bf16_t* WT, int k0, int n0, int drow0, LAS float* scr, int lane) {
#pragma unroll 8
    for (int i = 0; i < 32; ++i) { const int kk = 2 * i + (lane >> 5); scr[kk * 33 + (lane & 31)] = W[(size_t)(k0 + kk) * N + n0 + (lane & 31)]; }
    LDS_WAIT(); asm volatile("" ::: "memory");
    const int c = lane & 7;
#pragma unroll
    for (int j = 0; j < 4; ++j) { const int n = (lane >> 3) + 8 * j; const LAS float* s = scr + (8 * c) * 33 + n;
        u32x4 o; o.x = pk2(s[0 * 33], s[1 * 33]); o.y = pk2(s[2 * 33], s[3 * 33]); o.z = pk2(s[4 * 33], s[5 * 33]); o.w = pk2(s[6 * 33], s[7 * 33]);
        *(GAS u32x4*)(WT + (size_t)(drow0 + n) * K + k0 + 8 * c) = o; }
    LDS_WAIT(); asm volatile("" ::: "memory");
}
__device__ __forceinline__ void p0_transpose_item_fp8(const float* W, int K, int N, unsigned char* WT, int k0, int n0, int drow0, LAS float* scr, int lane) {
#pragma unroll 8
    for (int i = 0; i < 32; ++i) { const int kk = 2 * i + (lane >> 5); scr[kk * 33 + (lane & 31)] = W[(size_t)(k0 + kk) * N + n0 + (lane & 31)]; }
    LDS_WAIT(); asm volatile("" ::: "memory");
    const int c = lane & 3;
#pragma unroll
    for (int j = 0; j < 2; ++j) { const int n = (lane >> 2) + 16 * j; const LAS float* s = scr + (16 * c) * 33 + n;
        u32x4 o; o.x = pk4_fp8(s[0 * 33] * S_W, s[1 * 33] * S_W, s[2 * 33] * S_W, s[3 * 33] * S_W); o.y = pk4_fp8(s[4 * 33] * S_W, s[5 * 33] * S_W, s[6 * 33] * S_W, s[7 * 33] * S_W);
        o.z = pk4_fp8(s[8 * 33] * S_W, s[9 * 33] * S_W, s[10 * 33] * S_W, s[11 * 33] * S_W); o.w = pk4_fp8(s[12 * 33] * S_W, s[13 * 33] * S_W, s[14 * 33] * S_W, s[15 * 33] * S_W);
        *(GAS u32x4*)(WT + (size_t)(drow0 + n) * K + k0 + 16 * c) = o; }
    LDS_WAIT(); asm volatile("" ::: "memory");
}
__device__ __forceinline__ int paired_row(int n0, int halfN) { return (n0 < halfN) ? ((n0 >> 7) * 256 + (n0 & 127)) : (((n0 - halfN) >> 7) * 256 + 128 + ((n0 - halfN) & 127)); }

__device__ __forceinline__ void rms_row_to_bf16(const float* xrow, const float* g, bf16_t* orow, int lane) {
    const GAS f32x4* xr = (const GAS f32x4*)xrow + lane;
    f32x4 v[8]; float ss = 0.f;
#pragma unroll
    for (int j = 0; j < 8; ++j) { v[j] = xr[64 * j]; ss += (v[j][0] * v[j][0] + v[j][1] * v[j][1]) + (v[j][2] * v[j][2] + v[j][3] * v[j][3]); }
    const float rs = rsqrtf(wave_sum(ss) * (1.0f / D) + EPS);
    GAS u32x2* o8 = (GAS u32x2*)orow + lane;
#pragma unroll
    for (int j = 0; j < 8; ++j) { const f32x4 gg = ((const GAS f32x4*)g)[lane + 64 * j]; u32x2 w; w.x = pk2(v[j][0] * rs * gg[0], v[j][1] * rs * gg[1]); w.y = pk2(v[j][2] * rs * gg[2], v[j][3] * rs * gg[3]); o8[64 * j] = w; }
}

__device__ __forceinline__ void conv_tile(Frame& F, int tile, const bf16_t* U, const float* cw, const float* cb, const float* lg, const float* lb, bf16_t* UC) {
    const int t0 = tile * 32, c = 2 * F.tid;
    LAS float* ys = (LAS float*)F.lds;
    f32x2 w[31];
#pragma unroll
    for (int k = 0; k < 31; ++k) w[k] = *(const f32x2*)(cw + k * DC + c);
    const f32x2 bias = *(const f32x2*)(cb + c);
    f32x2 win[31];
#pragma unroll
    for (int p = 0; p < 30; ++p) { const int tt = t0 - 30 + p; unsigned v = 0u; if (tt >= 0) v = *(const unsigned*)(U + (size_t)tt * DC + c); win[p] = (f32x2){bflo(v), bfhi(v)}; }
    win[30] = (f32x2){0.f, 0.f};
#pragma unroll 1
    for (int jb = 0; jb < 32; jb += 31) {
#pragma unroll
        for (int p = 0; p < 31; ++p) {
            const int j = jb + p;
            if (j < 32) {
                const unsigned v = *(const unsigned*)(U + (size_t)(t0 + j) * DC + c);
                win[(30 + p) % 31] = (f32x2){bflo(v), bfhi(v)};
                f32x2 a = bias;
#pragma unroll
                for (int k = 0; k < 31; ++k) a += w[k] * win[(p + k) % 31];
                *(LAS f32x2*)(ys + j * DC + c) = a;
            }
        }
    }
    __syncthreads();
#pragma unroll 1
    for (int jj = 0; jj < 4; ++jj) {
        const int j = F.wave * 4 + jj;
        f32x4 v[4]; float s = 0.f;
#pragma unroll
        for (int q = 0; q < 4; ++q) { v[q] = *(const LAS f32x4*)(ys + j * DC + 4 * F.lane + 256 * q); s += (v[q][0] + v[q][1]) + (v[q][2] + v[q][3]); }
        const float mu = wave_sum(s) * (1.0f / DC); float qq = 0.f;
#pragma unroll
        for (int q = 0; q < 4; ++q) { v[q] = v[q] - mu; qq += (v[q][0] * v[q][0] + v[q][1] * v[q][1]) + (v[q][2] * v[q][2] + v[q][3] * v[q][3]); }
        const float rstd = rsqrtf(wave_sum(qq) * (1.0f / DC) + EPS);
#pragma unroll
        for (int q = 0; q < 4; ++q) { const int cc = 4 * F.lane + 256 * q; const f32x4 g4 = *(const f32x4*)(lg + cc), b4 = *(const f32x4*)(lb + cc);
            float y[4];
#pragma unroll
            for (int z = 0; z < 4; ++z) { const float t = v[q][z] * rstd * g4[z] + b4[z]; y[z] = t * sigm(t); }
            u32x2 o; o.x = cvt_pk(y[0], y[1]); o.y = cvt_pk(y[2], y[3]);
            *(u32x2*)(UC + (size_t)(t0 + j) * DC + cc) = o; }
    }
    __syncthreads();
}

__device__ __forceinline__ void attn_task(const bf16_t* __restrict__ Q, const bf16_t* __restrict__ Kb, const bf16_t* __restrict__ Vb, float* OG, float* LSE, int task, int lane) {
    const int h = task >> 8, rem = task & 255;
    const int dsh = 2 * (h >> 2), dil = 1 << dsh;
    const int r = rem & (dil - 1), mc = rem >> dsh;
    const int i = lane & 31, hh = lane >> 5;
    const int m0 = mc * 32;
    const int tq = ((m0 + i) << dsh) + r;
    bf16x8 qf[8];
    { const bf16_t* qp = Q + (size_t)tq * AW + h * HD + 8 * hh;
#pragma unroll
      for (int s = 0; s < 8; ++s) qf[s] = *(const bf16x8*)(qp + 16 * s); }
    const int jt0 = (mc < 4) ? (4 - mc) : 0;
    const float NEG = -__builtin_inff();
    f32x16 sacc[5];
#pragma unroll
    for (int jt = 0; jt < 5; ++jt) {
        f32x16 a;
#pragma unroll
        for (int q = 0; q < 16; ++q) a[q] = 0.f;
        if (jt >= jt0) {
            const int mk = m0 - 128 + 32 * jt + i;
            const bf16_t* kp = Kb + (size_t)((mk << dsh) + r) * AW + h * HD + 8 * hh;
#pragma unroll
            for (int s = 0; s < 8; ++s) { const bf16x8 kf = *(const bf16x8*)(kp + 16 * s); a = __builtin_amdgcn_mfma_f32_32x32x16_bf16(kf, qf[s], a, 0, 0, 0); }
#pragma unroll
            for (int q = 0; q < 16; ++q) { const int kk = (q & 3) + 8 * (q >> 2) + 4 * hh;
                if (jt == 0 && kk < i) a[q] = NEG;
                if (jt == 4 && kk > i) a[q] = NEG; }
        } else {
#pragma unroll
            for (int q = 0; q < 16; ++q) a[q] = NEG;
        }
        sacc[jt] = a;
        __builtin_amdgcn_sched_barrier(0);
    }
    float mx = NEG;
#pragma unroll
    for (int jt = 0; jt < 5; ++jt)
#pragma unroll
        for (int q = 0; q < 16; ++q) mx = fmaxf(mx, sacc[jt][q]);
    mx = fmaxf(mx, __shfl_xor(mx, 32));
    float l = 0.f;
#pragma unroll
    for (int jt = 0; jt < 5; ++jt)
#pragma unroll
        for (int q = 0; q < 16; ++q) { const float e = __builtin_amdgcn_exp2f(sacc[jt][q] - mx); sacc[jt][q] = e; l += e; }
    l += __shfl_xor(l, 32);
    const float inv = 1.0f / l;
    if (hh == 0) LSE[(size_t)tq * NH + h] = (mx + __log2f(l)) * LN2;
    bf16x8 pf[5][2];
#pragma unroll
    for (int jt = 0; jt < 5; ++jt)
#pragma unroll
        for (int s2 = 0; s2 < 2; ++s2) { u32x4 w;
            w.x = cvt_pk(sacc[jt][8 * s2 + 0] * inv, sacc[jt][8 * s2 + 1] * inv); w.y = cvt_pk(sacc[jt][8 * s2 + 2] * inv, sacc[jt][8 * s2 + 3] * inv);
            w.z = cvt_pk(sacc[jt][8 * s2 + 4] * inv, sacc[jt][8 * s2 + 5] * inv); w.w = cvt_pk(sacc[jt][8 * s2 + 6] * inv, sacc[jt][8 * s2 + 7] * inv);
            pf[jt][s2] = __builtin_bit_cast(bf16x8, w); }
    f32x16 o[4];
#pragma unroll
    for (int z = 0; z < 4; ++z)
#pragma unroll
        for (int q = 0; q < 16; ++q) o[z][q] = 0.f;
    const bf16_t* vcol = Vb + h * HD + 2 * i;
#pragma unroll
    for (int jt = 0; jt < 5; ++jt) {
        if (jt >= jt0) {
#pragma unroll
            for (int s2 = 0; s2 < 2; ++s2) {
                unsigned wa[8], wb[8];
#pragma unroll
                for (int j = 0; j < 8; ++j) { const int mk = m0 - 128 + 32 * jt + 16 * s2 + 8 * (j >> 2) + 4 * hh + (j & 3); const bf16_t* vp = vcol + (size_t)((mk << dsh) + r) * AW;
                    wa[j] = *(const unsigned*)vp; wb[j] = *(const unsigned*)(vp + 64); }
                u32x4 f0, f1, f2, f3;
                f0.x = (wa[0] & 0xffffu) | (wa[1] << 16); f0.y = (wa[2] & 0xffffu) | (wa[3] << 16); f0.z = (wa[4] & 0xffffu) | (wa[5] << 16); f0.w = (wa[6] & 0xffffu) | (wa[7] << 16);
                f1.x = (wa[0] >> 16) | (wa[1] & 0xffff0000u); f1.y = (wa[2] >> 16) | (wa[3] & 0xffff0000u); f1.z = (wa[4] >> 16) | (wa[5] & 0xffff0000u); f1.w = (wa[6] >> 16) | (wa[7] & 0xffff0000u);
                f2.x = (wb[0] & 0xffffu) | (wb[1] << 16); f2.y = (wb[2] & 0xffffu) | (wb[3] << 16); f2.z = (wb[4] & 0xffffu) | (wb[5] << 16); f2.w = (wb[6] & 0xffffu) | (wb[7] << 16);
                f3.x = (wb[0] >> 16) | (wb[1] & 0xffff0000u); f3.y = (wb[2] >> 16) | (wb[3] & 0xffff0000u); f3.z = (wb[4] >> 16) | (wb[5] & 0xffff0000u); f3.w = (wb[6] >> 16) | (wb[7] & 0xffff0000u);
                o[0] = __builtin_amdgcn_mfma_f32_32x32x16_bf16(pf[jt][s2], __builtin_bit_cast(bf16x8, f0), o[0], 0, 0, 0);
                o[1] = __builtin_amdgcn_mfma_f32_32x32x16_bf16(pf[jt][s2], __builtin_bit_cast(bf16x8, f1), o[1], 0, 0, 0);
                o[2] = __builtin_amdgcn_mfma_f32_32x32x16_bf16(pf[jt][s2], __builtin_bit_cast(bf16x8, f2), o[2], 0, 0, 0);
                o[3] = __builtin_amdgcn_mfma_f32_32x32x16_bf16(pf[jt][s2], __builtin_bit_cast(bf16x8, f3), o[3], 0, 0, 0);
                __builtin_amdgcn_sched_barrier(0);
            }
        }
    }
#pragma unroll
    for (int q = 0; q < 16; ++q) { const int qi = (q & 3) + 8 * (q >> 2) + 4 * hh; const int tt = ((m0 + qi) << dsh) + r;
        float* op = OG + ((size_t)tt * NH + h) * HD + 2 * i;
        *(f32x2*)op = (f32x2){o[0][q], o[1][q]}; *(f32x2*)(op + 64) = (f32x2){o[2][q], o[3][q]}; }
}

__global__ void __launch_bounds__(NWAVES * 64, 2) mk_fwd(Args args) {
    extern __shared__ __attribute__((aligned(16))) unsigned char lds[];
    Frame F;
    F.lds = (LAS unsigned char*)lds;
    F.MISC = (volatile LAS unsigned*)(F.lds + MISC_OFF);
    F.tid = threadIdx.x; F.lane = F.tid & 63; F.wave = __builtin_amdgcn_readfirstlane(F.tid >> 6);
    F.G = gridDim.x; { const int bx = blockIdx.x; F.vcu = (F.G % 8 == 0) ? (bx % 8) * (F.G / 8) + bx / 8 : bx; }
    unsigned char* ws = args.ws;
    F.ctl = (gu32*)(ws + WS_CTL);
    for (int u = F.tid; u < (LDS_BYTES - LDSCTL_OFF) / 4; u += NWAVES * 64) ((LAS unsigned*)(F.lds + LDSCTL_OFF))[u] = 0u;
    __syncthreads();
    const bool one_launch = (args.ph_hi - args.ph_lo) > 1;
    XcdBarrier bar; bar.bar = (unsigned*)(F.ctl + CW_BAR) + args.li * XCD_BAR_WORDS; bar.x = 0; bar.st = nullptr;
    if (one_launch) bar = xcd_barrier_post((unsigned*)(F.ctl + CW_BAR) + args.li * XCD_BAR_WORDS, F.MISC + 8);
    const int lo = args.ph_lo, hi = args.ph_hi;
#ifndef MK_PHASE_MASK
#define MK_PHASE_MASK 0xfff
#endif
#define IN(k) ((((MK_PHASE_MASK) >> (k)) & 1) && lo <= (k) && (k) < hi)
#define SEAM(k) do { if (IN(k) && IN((k) + 1)) xcd_barrier(bar); } while (0)
#ifndef MK_REPEAT
#define MK_REPEAT (-1)
#endif
#define REPS(k) for (int rep_ = 0; rep_ < ((k) == MK_REPEAT ? 2 : 1); ++rep_)

    const float* x = args.in[0]; const float* n1g = args.in[1]; const float* w_in = args.in[2]; const float* b_gate = args.in[3];
    const float* conv_w = args.in[4]; const float* conv_b = args.in[5]; const float* ln_g = args.in[6]; const float* ln_b = args.in[7];
    const float* w_co = args.in[8]; const float* b_co = args.in[9]; const float* w_ao = args.in[10]; const float* w_out = args.in[11];
    const float* n2g = args.in[12]; const float* w_r = args.in[13]; const float* b_r = args.in[14];
    const float* w_ei = args.in[15]; const float* b_ei = args.in[16]; const float* w_eo = args.in[17]; const float* b_eo = args.in[18]; const float* nfg = args.in[19];
    bf16_t* WIN = (bf16_t*)(ws + WS_WIN); bf16_t* WCO = (bf16_t*)(ws + WS_WCO); bf16_t* WAO = (bf16_t*)(ws + WS_WAO); bf16_t* WOUT = (bf16_t*)(ws + WS_WOUT);
    unsigned char* WE1 = ws + WS_WE1; unsigned char* WE2 = ws + WS_WE2;
    bf16_t* Hb = (bf16_t*)(ws + WS_H); bf16_t* Ub = (bf16_t*)(ws + WS_U); bf16_t* Qb = (bf16_t*)(ws + WS_Q); bf16_t* Kb = (bf16_t*)(ws + WS_K); bf16_t* Vb = (bf16_t*)(ws + WS_V);
    bf16_t* Gb = (bf16_t*)(ws + WS_GATE); bf16_t* UCb = (bf16_t*)(ws + WS_UC); float* OG = (float*)(ws + WS_OG); float* LSE = (float*)(ws + WS_LSE); bf16_t* OCb = (bf16_t*)(ws + WS_OC);
    float* M1 = (float*)(ws + WS_M1); bf16_t* MGb = (bf16_t*)(ws + WS_MG); float* X1 = (float*)(ws + WS_X1); unsigned char* H2f = ws + WS_H2;
    int* a_e = (int*)(ws + WS_AE); int* a_pos = (int*)(ws + WS_APOS); float* a_gate = (float*)(ws + WS_AGATE); int* a_slot = (int*)(ws + WS_ASLOT);
    unsigned char* XG = ws + WS_XG; unsigned char* ACT = ws + WS_ACT; bf16_t* Yb = (bf16_t*)(ws + WS_Y);
    int* hist = (int*)(ws + WS_HIST);
    const int gw = F.vcu * NWAVES + F.wave, NGW = F.G * NWAVES;

    REPS(0) if (IN(0)) {
        if (rep_) xcd_barrier(bar);
        LAS float* scr = (LAS float*)(F.lds + F.wave * 16384);
        constexpr int I_IN = (D / 64) * (DIN / 32), I_CO = (DC / 64) * (D / 32), I_AO = (AO / 64) * (D / 32), I_OUT = (D / 64) * (D / 32);
        constexpr int I_E1 = (D / 64) * (2 * DE / 32), I_E2 = (DE / 64) * (D / 32);
        constexpr int NSMALL = I_IN + I_CO + I_AO + I_OUT;
        for (int it = gw; it < NSMALL; it += NGW) {
            int q = it;
            if (q < I_IN) { const int nb = DIN / 32, k0 = 64 * (q / nb), n0 = 32 * (q % nb); const int dr = (n0 < 2048) ? paired_row(n0, 1024) : n0; p0_transpose_item(w_in, D, DIN, WIN, k0, n0, dr, scr, F.lane); continue; } q -= I_IN;
            if (q < I_CO) { const int nb = D / 32, k0 = 64 * (q / nb), n0 = 32 * (q % nb); p0_transpose_item(w_co, DC, D, WCO, k0, n0, n0, scr, F.lane); continue; } q -= I_CO;
            if (q < I_AO) { const int nb = D / 32, k0 = 64 * (q / nb), n0 = 32 * (q % nb); p0_transpose_item(w_ao, AO, D, WAO, k0, n0, n0, scr, F.lane); continue; } q -= I_AO;
            { const int nb = D / 32, k0 = 64 * (q / nb), n0 = 32 * (q % nb); p0_transpose_item(w_out, D, D, WOUT, k0, n0, n0, scr, F.lane); }
        }
        for (int it = gw; it < NE * I_E1; it += NGW) { const int e = it / I_E1, q = it % I_E1; const int nb = 2 * DE / 32, k0 = 64 * (q / nb), n0 = 32 * (q % nb);
            p0_transpose_item_fp8(w_ei + (size_t)e * D * 2 * DE, D, 2 * DE, WE1 + (size_t)e * 2 * DE * D, k0, n0, paired_row(n0, DE), scr, F.lane); }
        for (int it = gw; it < NE * I_E2; it += NGW) { const int e = it / I_E2, q = it % I_E2; const int nb = D / 32, k0 = 64 * (q / nb), n0 = 32 * (q % nb);
            p0_transpose_item_fp8(w_eo + (size_t)e * DE * D, DE, D, WE2 + (size_t)e * D * DE, k0, n0, n0, scr, F.lane); }
        for (int m = gw; m < T; m += NGW) rms_row_to_bf16(x + (size_t)m * D, n1g, Hb + (size_t)m * D, F.lane);
    }
    SEAM(0);
    if (IN(1)) {
        pg8::Gemm g{Hb, WIN, T, DIN, D}; pg8::StaticOrder S; S.init(T, DIN, F.G, (int)blockIdx.x);
        static_assert(WS_V - WS_K == WS_K - WS_Q, "q|k|v strides"); EpiProj E{Ub, Qb, Gb, b_gate};
        pg8::gemm_phase<EpiProj, pg8::StaticOrder, true, true>(F.lds, g, S, E);
        if (MK_REPEAT == 1) {
            xcd_barrier(bar);
            pg8::Gemm g{Hb, WIN, T, DIN, D}; pg8::StaticOrder S; S.init(T, DIN, F.G, (int)blockIdx.x);
        static_assert(WS_V - WS_K == WS_K - WS_Q, "q|k|v strides"); EpiProj E{Ub, Qb, Gb, b_gate};
        pg8::gemm_phase<EpiProj, pg8::StaticOrder, true, true>(F.lds, g, S, E);
        }
    }
    SEAM(1);
    REPS(2) if (IN(2)) {
        if (rep_) xcd_barrier(bar);
#ifndef MK_NO_CONV
        for (int tile = F.vcu; tile < T / 32; tile += F.G) conv_tile(F, tile, Ub, conv_w, conv_b, ln_g, ln_b, UCb);
#endif
#ifndef MK_NO_ATTN
        for (int task = gw; task < NH * 256; task += NGW) attn_task(Qb, Kb, Vb, OG, LSE, task, F.lane);
#endif
    }
    SEAM(2);
    REPS(3) if (IN(3)) {
        if (rep_) xcd_barrier(bar);
        for (int it = gw; it < T * 4; it += NGW) { const int t = it >> 2, hg = it & 3;
            const float l0 = LSE[(size_t)t * NH + hg], l1 = LSE[(size_t)t * NH + 4 + hg], l2 = LSE[(size_t)t * NH + 8 + hg];
            const float m = fmaxf(l0, fmaxf(l1, l2)); const float w0 = __expf(l0 - m), w1 = __expf(l1 - m), w2 = __expf(l2 - m), inv = 1.0f / (w0 + w1 + w2);
            const f32x2 a = *(const f32x2*)(OG + ((size_t)t * NH + hg) * HD + 2 * F.lane), b = *(const f32x2*)(OG + ((size_t)t * NH + 4 + hg) * HD + 2 * F.lane), c = *(const f32x2*)(OG + ((size_t)t * NH + 8 + hg) * HD + 2 * F.lane);
            const f32x2 o = (a * w0 + b * w1 + c * w2) * inv;
            *(unsigned*)(OCb + (size_t)t * AO + hg * HD + 2 * F.lane) = cvt_pk(o[0], o[1]); }
    }
    SEAM(3);
    if (IN(4)) {
        pg8::Gemm g{UCb, WCO, T, D, DC}; pg8::StaticOrder S; S.init(T, D, F.G, (int)blockIdx.x);
        EpiConvOut E{M1, Gb, b_co};
        pg8::gemm_phase<EpiConvOut, pg8::StaticOrder, false, true>(F.lds, g, S, E);
        if (MK_REPEAT == 4) {
            xcd_barrier(bar);
            pg8::Gemm g{UCb, WCO, T, D, DC}; pg8::StaticOrder S; S.init(T, D, F.G, (int)blockIdx.x);
        EpiConvOut E{M1, Gb, b_co};
        pg8::gemm_phase<EpiConvOut, pg8::StaticOrder, false, true>(F.lds, g, S, E);
        }
    }
    SEAM(4);
    if (IN(5)) {
        pg8::Gemm g{OCb, WAO, T, D, AO}; pg8::StaticOrder S; S.init(T, D, F.G, (int)blockIdx.x);
        EpiAttnOut E{M1, Gb, MGb};
        pg8::gemm_phase<EpiAttnOut, pg8::StaticOrder, false, true>(F.lds, g, S, E);
    }
    SEAM(5);
    if (IN(6)) {
        pg8::Gemm g{MGb, WOUT, T, D, D}; pg8::StaticOrder S; S.init(T, D, F.G, (int)blockIdx.x);
        EpiResid E{x, X1};
        pg8::gemm_phase<EpiResid, pg8::StaticOrder, false, true>(F.lds, g, S, E);
        if (MK_REPEAT == 6) {
            xcd_barrier(bar);
            pg8::Gemm g{MGb, WOUT, T, D, D}; pg8::StaticOrder S; S.init(T, D, F.G, (int)blockIdx.x);
        EpiResid E{x, X1};
        pg8::gemm_phase<EpiResid, pg8::StaticOrder, false, true>(F.lds, g, S, E);
        }
    }
    SEAM(6);
    REPS(7) if (IN(7)) {
        if (rep_) xcd_barrier(bar);
        LAS float* xs = (LAS float*)F.lds;
        LAS int* ue = (LAS int*)(F.lds + TAB_OFF + 256);
        for (int unit = F.vcu; unit < T / 16; unit += F.G) {
            const int t0 = unit * 16;
#pragma unroll 1
            for (int tt = 2 * F.wave; tt < 2 * F.wave + 2; ++tt) {
                const GAS f32x4* xr = (const GAS f32x4*)(X1 + (size_t)(t0 + tt) * D) + F.lane;
                f32x4 v[8]; float ss = 0.f;
#pragma unroll
                for (int j = 0; j < 8; ++j) { v[j] = xr[64 * j]; ss += (v[j][0] * v[j][0] + v[j][1] * v[j][1]) + (v[j][2] * v[j][2] + v[j][3] * v[j][3]); }
                const float rs = rsqrtf(wave_sum(ss) * (1.0f / D) + EPS);
                GAS unsigned* o4 = (GAS unsigned*)(H2f + (size_t)(t0 + tt) * D) + F.lane;
#pragma unroll
                for (int j = 0; j < 8; ++j) { const f32x4 gg = ((const GAS f32x4*)n2g)[F.lane + 64 * j]; const f32x4 y = v[j] * rs * gg;
                    *(LAS f32x4*)(xs + tt * D + 4 * (F.lane + 64 * j)) = y; o4[64 * j] = pk4_fp8(y[0] * S_X, y[1] * S_X, y[2] * S_X, y[3] * S_X); }
            }
            __syncthreads();
            float pacc[16];
#pragma unroll
            for (int tt = 0; tt < 16; ++tt) pacc[tt] = 0.f;
            { const int e = F.lane & 31, kh = F.lane >> 5, i0 = 256 * F.wave + 128 * kh;
#pragma unroll 2
              for (int ii = 0; ii < 128; ii += 4) {
                  const float w0 = w_r[(size_t)(i0 + ii) * NE + e], w1 = w_r[(size_t)(i0 + ii + 1) * NE + e], w2 = w_r[(size_t)(i0 + ii + 2) * NE + e], w3 = w_r[(size_t)(i0 + ii + 3) * NE + e];
#pragma unroll
                  for (int tt = 0; tt < 16; ++tt) { const f32x4 xv = *(const LAS f32x4*)(xs + tt * D + i0 + ii); pacc[tt] += (xv[0] * w0 + xv[1] * w1) + (xv[2] * w2 + xv[3] * w3); }
              } }
#pragma unroll
            for (int tt = 0; tt < 16; ++tt) pacc[tt] += __shfl_xor(pacc[tt], 32);
            __syncthreads();
            if (F.lane < 32) {
#pragma unroll
                for (int tt = 0; tt < 16; ++tt) xs[(F.wave * 16 + tt) * 32 + F.lane] = pacc[tt];
            }
            __syncthreads();
#pragma unroll 1
            for (int tt = 2 * F.wave; tt < 2 * F.wave + 2; ++tt) {
                float lg = -__builtin_inff();
                if (F.lane < 32) { float s = b_r[F.lane];
#pragma unroll
                    for (int w = 0; w < 8; ++w) s += xs[(w * 16 + tt) * 32 + F.lane];
                    lg = s; }
                int sel_e[4]; float sel_v[4];
#pragma unroll
                for (int k = 0; k < 4; ++k) { const float m = wave_max(lg); const unsigned long long b = __ballot(lg == m); const int e = __ffsll((long long)b) - 1; sel_e[k] = e; sel_v[k] = m; if (F.lane == e) lg = -__builtin_inff(); }
                const float e1 = __expf(sel_v[1] - sel_v[0]), e2 = __expf(sel_v[2] - sel_v[0]), e3 = __expf(sel_v[3] - sel_v[0]);
                const float inv = 1.0f / (1.0f + e1 + e2 + e3);
                if (F.lane < 4) {
                    const int e = F.lane == 0 ? sel_e[0] : F.lane == 1 ? sel_e[1] : F.lane == 2 ? sel_e[2] : sel_e[3];
                    const float gt = (F.lane == 0 ? 1.0f : F.lane == 1 ? e1 : F.lane == 2 ? e2 : e3) * inv;
                    const int a = (t0 + tt) * 4 + F.lane; a_e[a] = e; a_gate[a] = gt; ue[tt * 4 + F.lane] = e;
                }
            }
            __syncthreads();
            if (F.wave == 0) {
                const int e = ue[F.lane]; int rank = 0, mycount = 0;
#pragma unroll 4
                for (int q = 0; q < NE; ++q) { const unsigned long long mq = __ballot(e == q); if (e == q) rank = __popcll(mq & ((1ull << F.lane) - 1ull)); if (F.lane == q) mycount = __popcll(mq); }
                a_pos[t0 * 4 + F.lane] = rank;
                if (F.lane < NE) hist[unit * NE + F.lane] = mycount;
            }
            __syncthreads();
        }
    }
    SEAM(7);
    LAS int* rt0 = (LAS int*)(F.lds + TAB_OFF);
    LAS int* cntl = (LAS int*)(F.lds + TAB_OFF + 512);
    LAS int* ubase = (LAS int*)(F.lds + TAB_OFF + 768);
    LAS int* part = (LAS int*)(F.lds + TAB_OFF + 1024);
    if (hi > 8 && lo <= 10) {
        { const int e = F.tid & 31, p = F.tid >> 5; int sacc_ = 0;
#pragma unroll 8
          for (int u = 32 * p; u < 32 * p + 32; ++u) sacc_ += hist[u * NE + e];
          part[p * NE + e] = sacc_; }
        __syncthreads();
        if (F.tid < NE) { int c = 0;
#pragma unroll
            for (int p = 0; p < 16; ++p) c += part[p * NE + F.tid];
            cntl[F.tid] = c; }
        __syncthreads();
        if (F.tid == 0) { int a = 0; for (int e = 0; e < NE; ++e) { rt0[e] = a; a += (cntl[e] + 255) >> 8; } rt0[NE] = a; }
        __syncthreads();
    }
    REPS(8) if (IN(8)) {
        if (rep_) xcd_barrier(bar);
        for (int unit = F.vcu; unit < T / 16; unit += F.G) {
            if (F.tid < NE) { int b = 0; const int p0 = unit >> 5;
                for (int p = 0; p < p0; ++p) b += part[p * NE + F.tid];
                for (int u = 32 * p0; u < unit; ++u) b += hist[u * NE + F.tid];
                ubase[F.tid] = b; }
            __syncthreads();
#pragma unroll 1
            for (int j = 0; j < 8; ++j) { const int a = unit * 64 + F.wave * 8 + j; const int e = a_e[a], slot = 256 * rt0[e] + ubase[e] + a_pos[a];
                if (F.lane == 0) a_slot[a] = slot;
                const GAS u32x4* src = (const GAS u32x4*)(H2f + (size_t)(a >> 2) * D) + F.lane; GAS u32x4* dst = (GAS u32x4*)(XG + (size_t)slot * D) + F.lane;
#pragma unroll
                for (int q = 0; q < 2; ++q) dst[64 * q] = src[64 * q]; }
            __syncthreads();
        }
        for (int it = gw; it < NE * 256; it += NGW) { const int e = it >> 8, j = it & 255; const int row = 256 * rt0[e] + cntl[e] + j;
            if (row < 256 * rt0[e + 1]) { GAS u32x4* dst = (GAS u32x4*)(XG + (size_t)row * D) + F.lane;
#pragma unroll
                for (int j2 = 0; j2 < 2; ++j2) dst[64 * j2] = (u32x4){0u, 0u, 0u, 0u}; } }
    }
    SEAM(8);
    if (IN(9)) {
        pg8::Gemm g{(const bf16_t*)XG, (const bf16_t*)WE1, NROWS, NE * 2 * DE, D / 2}; MoeOrder S{rt0, 16, F.G, F.vcu};
        EpiSwiGLU E{ACT, b_ei};
        pg8::gemm_phase<EpiSwiGLU, MoeOrder, true, true, E8_W, E8_X>(F.lds, g, S, E);
        if (MK_REPEAT == 9) {
            xcd_barrier(bar);
            pg8::Gemm g{(const bf16_t*)XG, (const bf16_t*)WE1, NROWS, NE * 2 * DE, D / 2}; MoeOrder S{rt0, 16, F.G, F.vcu};
        EpiSwiGLU E{ACT, b_ei};
        pg8::gemm_phase<EpiSwiGLU, MoeOrder, true, true, E8_W, E8_X>(F.lds, g, S, E);
        }
    }
    SEAM(9);
    if (IN(10)) {
        pg8::Gemm g{(const bf16_t*)ACT, (const bf16_t*)WE2, NROWS, NE * D, DE / 2}; MoeOrder S{rt0, 8, F.G, F.vcu};
        EpiExpOut E{Yb, b_eo};
        pg8::gemm_phase<EpiExpOut, MoeOrder, true, true, E8_W, E8_ACT>(F.lds, g, S, E);
        if (MK_REPEAT == 10) {
            xcd_barrier(bar);
            pg8::Gemm g{(const bf16_t*)ACT, (const bf16_t*)WE2, NROWS, NE * D, DE / 2}; MoeOrder S{rt0, 8, F.G, F.vcu};
        EpiExpOut E{Yb, b_eo};
        pg8::gemm_phase<EpiExpOut, MoeOrder, true, true, E8_W, E8_ACT>(F.lds, g, S, E);
        }
    }
    SEAM(10);
    REPS(11) if (IN(11)) {
        if (rep_) xcd_barrier(bar);
        for (int t = gw; t < T; t += NGW) {
            f32x4 v[8];
#pragma unroll
            for (int j = 0; j < 8; ++j) v[j] = ((const GAS f32x4*)(X1 + (size_t)t * D))[F.lane + 64 * j];
#pragma unroll
            for (int k = 0; k < 4; ++k) { const int s = a_slot[t * 4 + k]; const float gt = a_gate[t * 4 + k]; const GAS u32x2* yr = (const GAS u32x2*)(Yb + (size_t)s * D) + F.lane;
#pragma unroll
                for (int j = 0; j < 8; ++j) { const u32x2 w = yr[64 * j]; v[j][0] += gt * bflo(w.x); v[j][1] += gt * bfhi(w.x); v[j][2] += gt * bflo(w.y); v[j][3] += gt * bfhi(w.y); } }
            float ss = 0.f;
#pragma unroll
            for (int j = 0; j < 8; ++j) ss += (v[j][0] * v[j][0] + v[j][1] * v[j][1]) + (v[j][2] * v[j][2] + v[j][3] * v[j][3]);
            const float rs = rsqrtf(wave_sum(ss) * (1.0f / D) + EPS);
            GAS f32x4* o = (GAS f32x4*)(args.out + (size_t)t * D);
#pragma unroll
            for (int j = 0; j < 8; ++j) { const f32x4 gg = ((const GAS f32x4*)nfg)[F.lane + 64 * j]; o[F.lane + 64 * j] = v[j] * rs * gg; }
        }
    }
#undef IN
#undef SEAM
}
constexpr int N_PHASES = 12;
}

#ifndef MK_CUTS
#define MK_CUTS 0
#endif
extern "C" void kernel_launch(void* const* d_in, const int* in_sizes, int n_in, void* d_out, int out_size, void* d_ws, size_t ws_size, hipStream_t stream) {
    using namespace mk;
    static int grid = 0;
    if (grid == 0) {
        int dev = 0, cus = 0;
        if (hipGetDevice(&dev) != hipSuccess || hipDeviceGetAttribute(&cus, hipDeviceAttributeMultiprocessorCount, dev) != hipSuccess) { grid = -1; return; }
        if (hipFuncSetAttribute((const void*)mk_fwd, hipFuncAttributeMaxDynamicSharedMemorySize, LDS_BYTES) != hipSuccess) { grid = -1; return; }
        int per_cu = 0;
        if (hipOccupancyMaxActiveBlocksPerMultiprocessor(&per_cu, (const void*)mk_fwd, NWAVES * 64, LDS_BYTES) != hipSuccess || per_cu < 1) { fprintf(stderr, "kernel_launch: occupancy query says %d\n", per_cu); }
        (void)hipGetLastError();
        grid = cus;
    }
    if (grid < 0) return;
    (void)hipMemsetAsync((char*)d_ws + WS_CTL, 0, CTL_ZERO_BYTES, stream);
    Args a{};
    for (int i = 0; i < 20; ++i) a.in[i] = (const float*)d_in[i];
    a.out = (float*)d_out; a.ws = (unsigned char*)d_ws;
#if MK_CUTS == 0
    a.ph_lo = 0; a.ph_hi = N_PHASES; a.li = 0; a.pad = 0;
    hipLaunchKernelGGL(mk_fwd, dim3(grid), dim3(NWAVES * 64), LDS_BYTES, stream, a);
#else
    for (int p = 0; p < N_PHASES; ++p) { a.ph_lo = p; a.ph_hi = p + 1; a.li = 0; a.pad = 0; hipLaunchKernelGGL(mk_fwd, dim3(grid), dim3(NWAVES * 64), LDS_BYTES, stream, a); }
#endif
}
```

```cpp
#include <hip/hip_runtime.h>
#include <cstdio>
#include <cstdint>
namespace pg8 {
#define PG8_LAS __attribute__((address_space(3)))
typedef unsigned short bf16_t;
typedef short bf16x8 __attribute__((ext_vector_type(8)));
typedef float f32x4 __attribute__((ext_vector_type(4)));
typedef unsigned u32x4 __attribute__((ext_vector_type(4)));
typedef int pg8_v4i __attribute__((ext_vector_type(4)));
constexpr int BM = 256, BK = 64, HALF = 128, HTB = HALF * BK * 2  , STAGE_BYTES = 8 * HTB, NXCD = 8, WGM = 8;

__host__ __device__ __forceinline__ int lds_byte(int r, int c) { const int st = (r >> 4) * 2 + (c >> 5), rr = r & 15, cc = c & 31, ob = rr * 64 + cc * 2; return st * 1024 + (ob ^ (((ob >> 9) & 1) << 5)); }
__host__ __device__ __forceinline__ void stage_rc(int b, int& R, int& C) { const int st = b / 1024, sb = b % 1024, swz = sb ^ (((sb >> 9) & 1) << 5); R = (st >> 1) * 16 + swz / 64; C = (st & 1) * 32 + (swz % 64) / 2; }
__host__ __device__ __forceinline__ int perm32(int rho) { const int n = rho >> 4, i = rho & 15; return 8 * (i >> 2) + 4 * n + (i & 3); }

struct Unit { int pm, pn; };
struct Gemm { const bf16_t* A; const bf16_t* Bt; int M, N, K; };

struct StaticOrder {
    int nM, nN, nwg, G, c;
    __host__ __device__ void init(int M, int N, int G_, int c_) { nM = M / BM; nN = N / BM; nwg = nM * nN; G = G_; c = c_; }
    __host__ __device__ bool next(int i, Unit& u) const {
        const long L = (long)i * G + c; if (L >= nwg) return false;
        int wgid = (int)L; { const int q = nwg / NXCD, r = nwg % NXCD, xcd = wgid % NXCD, off = wgid / NXCD; wgid = (xcd < r ? xcd * (q + 1) : r * (q + 1) + (xcd - r) * q) + off; }
        const int nig = WGM * nN, gid = wgid / nig, fm = gid * WGM, gsz = (nM - fm) < WGM ? (nM - fm) : WGM;
        u.pm = fm + ((wgid % nig) % gsz); u.pn = (wgid % nig) / gsz; return true;
    }
    __device__ __forceinline__ void a_ready(const Unit&) const {}
    __device__ __forceinline__ void done(const Unit&) const {}
};

__device__ __forceinline__ unsigned cvt_pk_bf16(float lo, float hi) { unsigned r; asm volatile("v_cvt_pk_bf16_f32 %0, %1, %2" : "=v"(r) : "v"(lo), "v"(hi)); return r; }
template <class Epi, class Sched, bool ALIGN_EPI = false, bool SP2 = false, int F8W = 0, int F8X = 0>
__device__ __forceinline__ void gemm_phase(PG8_LAS unsigned char* lds, const Gemm g, const Sched& S, const Epi& E) {
    const int tid = threadIdx.x, wid = __builtin_amdgcn_readfirstlane(tid >> 6), lane = tid & 63, wr = wid >> 2, wc = wid & 3, fr = lane & 15, fq = lane >> 4;
    const int K = g.K, nt = K / BK;
    int f8w_ = F8W, f8x_ = F8X; asm volatile("" : "+v"(f8w_), "+v"(f8x_));
    unsigned voffA[2], voffB[2];
#pragma unroll
    for (int i = 0; i < 2; ++i) { int R, C; stage_rc(tid * 16 + i * 8192, R, C); const int Rb = Epi::PERM ? ((R & ~31) + perm32(R & 31)) : R;
        voffA[i] = (unsigned)(R * K + C) * 2u; voffB[i] = (unsigned)(Rb * K + C) * 2u; }
    const size_t kstep = (size_t)(BK * 2);
    const size_t hstep = (size_t)HALF * K * 2;
    const size_t tstep = 2 * hstep;
    const unsigned ldsw = (unsigned)wid * 1024u;
    const int aoff = lds_byte(wr * 64 + fr, fq * 8), boff = lds_byte(wc * 32 + fr, fq * 8);
#define PG8_SA(b, h) (((b) * 2 + (h)) * HTB)
#define PG8_SB(b, h) ((4 + (b) * 2 + (h)) * HTB)
#define PG8_STAGE(bufoff, gbase, voff) do { _Pragma("unroll") for (int _i = 0; _i < 2; ++_i) \
        __builtin_amdgcn_global_load_lds((const unsigned*)((const char*)(gbase) + (voff)[_i]), (PG8_LAS unsigned*)(lds + (bufoff) + ldsw + _i * 8192), 16, 0, 0); } while (0)
#define PG8_LDA(dst, b, h) do { _Pragma("unroll") for (int m = 0; m < 4; ++m) _Pragma("unroll") for (int k = 0; k < 2; ++k) dst[m][k] = *(const PG8_LAS bf16x8*)(lds + PG8_SA(b, h) + aoff + m * 2048 + k * 1024); } while (0)
#define PG8_LDB(dst, b, h) do { _Pragma("unroll") for (int n = 0; n < 2; ++n) _Pragma("unroll") for (int k = 0; k < 2; ++k) dst[n][k] = *(const PG8_LAS bf16x8*)(lds + PG8_SB(b, h) + boff + n * 2048 + k * 1024); } while (0)
#define PG8_CAT8(lo, hi) __builtin_shufflevector(__builtin_bit_cast(pg8_v4i, lo), __builtin_bit_cast(pg8_v4i, hi), 0, 1, 2, 3, 4, 5, 6, 7)
#define PG8_MMA(ai, bj, At, Bt) do { __builtin_amdgcn_s_setprio(1); if constexpr (F8W != 0) { _Pragma("unroll") for (int m = 0; m < 4; ++m) _Pragma("unroll") for (int n = 0; n < 2; ++n) \
        asm volatile("v_mfma_scale_f32_16x16x128_f8f6f4 %0, %1, %2, %0, %3, %4 op_sel_hi:[0,0,0]" : "+v"(acc[ai][bj][m][n]) : "v"(PG8_CAT8(Bt[n][0], Bt[n][1])), "v"(PG8_CAT8(At[m][0], At[m][1])), "v"(f8w_), "v"(f8x_)); } else { \
        _Pragma("unroll") for (int m = 0; m < 4; ++m) _Pragma("unroll") for (int n = 0; n < 2; ++n) _Pragma("unroll") for (int k = 0; k < 2; ++k) \
        acc[ai][bj][m][n] = __builtin_amdgcn_mfma_f32_16x16x32_bf16(Bt[n][k], At[m][k], acc[ai][bj][m][n], 0, 0, 0); } __builtin_amdgcn_s_setprio(0); } while (0)
#define PG8_WAIT_V(n) asm volatile("s_waitcnt vmcnt(" #n ")" ::: "memory")
#define PG8_WAIT_L(n) asm volatile("s_waitcnt lgkmcnt(" #n ")" ::: "memory")
#define PG8_BAR __builtin_amdgcn_s_barrier()
#define PG8_SCHED __builtin_amdgcn_sched_barrier(0)
    Unit cur, nxt; int ui = 0;
    if (!S.next(0, cur)) return;
    f32x4 acc[2][2][4][2];
#pragma unroll
    for (int a = 0; a < 2; ++a)
#pragma unroll
        for (int b = 0; b < 2; ++b)
#pragma unroll
            for (int m = 0; m < 4; ++m)
#pragma unroll
                for (int n = 0; n < 2; ++n) acc[a][b][m][n] = (f32x4){0.f, 0.f, 0.f, 0.f};
    bf16x8 At[4][2], B0[2][2], B1[2][2];
    const char* cA = (const char*)g.A + (size_t)cur.pm * tstep; const char* cB = (const char*)g.Bt + (size_t)cur.pn * tstep;
    S.a_ready(cur);
    if constexpr (SP2) {
        PG8_STAGE(PG8_SB(0, 0), cB, voffB); PG8_STAGE(PG8_SB(0, 1), cB + hstep, voffB); PG8_STAGE(PG8_SA(0, 0), cA, voffA); PG8_STAGE(PG8_SA(0, 1), cA + hstep, voffA);
        if (wr == 1) PG8_BAR;
        PG8_WAIT_V(2); PG8_BAR;
        PG8_STAGE(PG8_SB(1, 0), cB + kstep, voffB); PG8_STAGE(PG8_SA(1, 0), cA + kstep, voffA); PG8_STAGE(PG8_SB(1, 1), cB + hstep + kstep, voffB);
        PG8_WAIT_V(6); PG8_BAR;
    } else {
        PG8_STAGE(PG8_SB(0, 0), cB, voffB); PG8_STAGE(PG8_SA(0, 0), cA, voffA); PG8_STAGE(PG8_SB(0, 1), cB + hstep, voffB); PG8_STAGE(PG8_SA(0, 1), cA + hstep, voffA);
        if (wr == 1) PG8_BAR;
        PG8_WAIT_V(4); PG8_BAR;
        PG8_STAGE(PG8_SB(1, 0), cB + kstep, voffB); PG8_STAGE(PG8_SA(1, 0), cA + kstep, voffA); PG8_STAGE(PG8_SB(1, 1), cB + hstep + kstep, voffB);
        PG8_WAIT_V(6); PG8_BAR;
    }
    for (;;) {
        const bool has_next = S.next(ui + 1, nxt);
        const char* nA = has_next ? (const char*)g.A + (size_t)nxt.pm * tstep : cA; const char* nB = has_next ? (const char*)g.Bt + (size_t)nxt.pn * tstep : cB;
        for (int t = 0; t < nt; t += 2) {
            const bool last = (t == nt - 2);
            const char* a1 = cA + (size_t)(t + 1) * kstep;
            const char* a2 = last ? nA : cA + (size_t)(t + 2) * kstep; const char* b2 = last ? nB : cB + (size_t)(t + 2) * kstep;
            const char* a3 = a2 + kstep; const char* b3 = b2 + kstep;
            if (last && has_next) S.a_ready(nxt);
            if constexpr (SP2) {
            PG8_LDB(B0, 0, 0); PG8_LDB(B1, 0, 1); PG8_SCHED; PG8_LDA(At, 0, 0); PG8_STAGE(PG8_SA(1, 1), a1 + hstep, voffA);
            PG8_WAIT_V(8); PG8_WAIT_L(0); PG8_BAR; PG8_MMA(0, 0, At, B0); PG8_MMA(0, 1, At, B1); PG8_BAR; PG8_SCHED;
            PG8_LDA(At, 0, 1); PG8_STAGE(PG8_SB(0, 0), b2, voffB); PG8_STAGE(PG8_SB(0, 1), b2 + hstep, voffB); PG8_STAGE(PG8_SA(0, 0), a2, voffA);
            PG8_WAIT_V(8); PG8_WAIT_L(0); PG8_BAR; PG8_MMA(1, 0, At, B0); PG8_MMA(1, 1, At, B1); PG8_BAR; PG8_SCHED;
            PG8_LDB(B0, 1, 0); PG8_LDB(B1, 1, 1); PG8_SCHED; PG8_LDA(At, 1, 0); PG8_STAGE(PG8_SA(0, 1), a2 + hstep, voffA);
            PG8_WAIT_V(8); PG8_WAIT_L(0); PG8_BAR; PG8_MMA(0, 0, At, B0); PG8_MMA(0, 1, At, B1); PG8_BAR; PG8_SCHED;
            PG8_LDA(At, 1, 1); PG8_STAGE(PG8_SB(1, 0), b3, voffB); PG8_STAGE(PG8_SB(1, 1), b3 + hstep, voffB); PG8_STAGE(PG8_SA(1, 0), a3, voffA);
            PG8_WAIT_V(8); PG8_WAIT_L(0); PG8_BAR; PG8_MMA(1, 0, At, B0); PG8_MMA(1, 1, At, B1); PG8_BAR; PG8_SCHED;
            } else {
            PG8_LDB(B0, 0, 0); PG8_SCHED; PG8_LDA(At, 0, 0); PG8_STAGE(PG8_SA(1, 1), a1 + hstep, voffA);
            PG8_WAIT_L(8); PG8_BAR; PG8_WAIT_L(0); PG8_MMA(0, 0, At, B0); PG8_BAR; PG8_SCHED;
            PG8_LDB(B1, 0, 1); PG8_STAGE(PG8_SB(0, 0), b2, voffB);
            PG8_BAR; PG8_WAIT_L(0); PG8_MMA(0, 1, At, B1); PG8_BAR;
            PG8_LDA(At, 0, 1); PG8_STAGE(PG8_SA(0, 0), a2, voffA);
            PG8_BAR; PG8_WAIT_L(0); PG8_MMA(1, 0, At, B0); PG8_BAR; PG8_SCHED;
            PG8_STAGE(PG8_SB(0, 1), b2 + hstep, voffB);
            PG8_WAIT_V(6); PG8_BAR; PG8_MMA(1, 1, At, B1); PG8_BAR;
            PG8_LDB(B0, 1, 0); PG8_SCHED; PG8_LDA(At, 1, 0); PG8_STAGE(PG8_SA(0, 1), a2 + hstep, voffA);
            PG8_WAIT_L(8); PG8_BAR; PG8_WAIT_L(0); PG8_MMA(0, 0, At, B0); PG8_BAR; PG8_SCHED;
            PG8_LDB(B1, 1, 1); PG8_STAGE(PG8_SB(1, 0), b3, voffB);
            PG8_BAR; PG8_WAIT_L(0); PG8_MMA(0, 1, At, B1); PG8_BAR;
            PG8_LDA(At, 1, 1); PG8_STAGE(PG8_SA(1, 0), a3, voffA);
            PG8_BAR; PG8_WAIT_L(0); PG8_MMA(1, 0, At, B0); PG8_BAR; PG8_SCHED;
            PG8_STAGE(PG8_SB(1, 1), b3 + hstep, voffB);
            PG8_WAIT_V(6); PG8_BAR; PG8_MMA(1, 1, At, B1); PG8_BAR;
            }
        }
        if constexpr (F8W != 0) asm volatile("s_nop 15\n\ts_nop 15" ::: "memory");
        if constexpr (ALIGN_EPI) { if (wr == 0) PG8_BAR; }
        if constexpr (!Epi::AFTER_DRAIN) { E(acc, cur, wr, wc, fr, fq); S.done(cur); }
        if (!has_next) break;
#pragma unroll
        for (int a = 0; a < 2; ++a)
#pragma unroll
            for (int b = 0; b < 2; ++b)
#pragma unroll
                for (int m = 0; m < 4; ++m)
#pragma unroll
                    for (int n = 0; n < 2; ++n) acc[a][b][m][n] = (f32x4){0.f, 0.f, 0.f, 0.f};
        cur = nxt; cA = nA; cB = nB; ++ui;
        if constexpr (ALIGN_EPI) { if (wr == 1) PG8_BAR; }
    }
    PG8_WAIT_V(0);
    if constexpr (!ALIGN_EPI) { if (wr == 0) PG8_BAR; }
    PG8_BAR;
    if constexpr (Epi::AFTER_DRAIN) { E.fused(acc, cur, wr, wc, fr, fq, lds, wid, lane); S.done(cur); }
#undef PG8_SA
#undef PG8_SB
#undef PG8_STAGE
#undef PG8_LDA
#undef PG8_LDB
#undef PG8_MMA
#undef PG8_CAT8
#undef PG8_WAIT_V
#undef PG8_WAIT_L
#undef PG8_BAR
#undef PG8_SCHED
}
}
#define GAS __attribute__((address_space(1)))
#define LAS __attribute__((address_space(3)))
namespace mk {
using pg8::bf16_t; using pg8::bf16x8; using pg8::f32x4; using pg8::u32x4; using pg8::Unit; using pg8::cvt_pk_bf16;
typedef float f32x16 __attribute__((ext_vector_type(16)));
typedef float f32x2 __attribute__((ext_vector_type(2)));
typedef unsigned u32x2 __attribute__((ext_vector_type(2)));
typedef GAS unsigned gu32;
typedef __bf16 bf16x2_t __attribute__((ext_vector_type(2)));
__device__ __forceinline__ unsigned cvt_pk(float lo, float hi) { f32x2 v = {lo, hi}; bf16x2_t b = __builtin_convertvector(v, bf16x2_t); return __builtin_bit_cast(unsigned, b); }
#define RLX_AGENT __ATOMIC_RELAXED, __HIP_MEMORY_SCOPE_AGENT
#define LDS_WAIT() asm volatile("s_waitcnt lgkmcnt(0)" ::: "memory")
#define VM_WAIT() asm volatile("s_waitcnt vmcnt(0)" ::: "memory")

constexpr int T = 8192, D = 2048, DIN = 10752, DC = 1024, NH = 12, HD = 128, AW = 1536, AO = 512, NE = 32, DE = 2048, TOPK = 4;
constexpr float EPS = 1e-5f;
constexpr float QSCALE = 0.12751743082459868f;
constexpr float LN2 = 0.6931471805599453f;
constexpr int MAXRT = 160, NROWS = MAXRT * 256;
constexpr int NWAVES = 8;

constexpr size_t MiB = 1u << 20;
constexpr size_t WS_CTL = 0, CTL_ZERO_BYTES = 64 * 1024;
constexpr size_t WS_WIN = 1 * MiB;
constexpr size_t WS_WCO = 43 * MiB;
constexpr size_t WS_WAO = 47 * MiB;
constexpr size_t WS_WOUT = 49 * MiB;
constexpr size_t WS_WE1 = 57 * MiB;
constexpr size_t WS_WE2 = 569 * MiB;
constexpr size_t WS_H = 825 * MiB;
constexpr size_t WS_U = 857 * MiB;
constexpr size_t WS_Q = 873 * MiB, WS_K = 897 * MiB, WS_V = 921 * MiB;
constexpr size_t WS_GATE = 945 * MiB;
constexpr size_t WS_UC = 1009 * MiB;
constexpr size_t WS_OG = 1025 * MiB;
constexpr size_t WS_LSE = 1073 * MiB;
constexpr size_t WS_OC = 1074 * MiB;
constexpr size_t WS_M1 = 1082 * MiB;
constexpr size_t WS_MG = 1146 * MiB;
constexpr size_t WS_X1 = 1178 * MiB;
constexpr size_t WS_H2 = 1242 * MiB;
constexpr size_t WS_AE = 1274 * MiB, WS_APOS = 1275 * MiB, WS_AGATE = 1276 * MiB, WS_ASLOT = 1277 * MiB;
constexpr size_t WS_HIST = WS_ASLOT + 512 * 1024;
constexpr size_t WS_XG = 1278 * MiB;
constexpr size_t WS_ACT = 1438 * MiB;
constexpr size_t WS_Y = 1598 * MiB;
constexpr size_t WS_END = 1758 * MiB;
constexpr int CW_CNT = 64;
constexpr int CW_BAR = 4096;

constexpr int RING_BYTES = 131072;
constexpr int LDSCTL_OFF = RING_BYTES, MISC_OFF = LDSCTL_OFF + 320, TAB_OFF = LDSCTL_OFF + 1024;
constexpr int LDS_BYTES = 147456;

__device__ __forceinline__ unsigned f2bf(float f) { unsigned u = __builtin_bit_cast(unsigned, f); return (u + 0x7fffu + ((u >> 16) & 1u)) >> 16; }
__device__ __forceinline__ unsigned pk2(float lo, float hi) { return f2bf(lo) | (f2bf(hi) << 16); }
__device__ __forceinline__ float bflo(unsigned w) { return __builtin_bit_cast(float, w << 16); }
__device__ __forceinline__ float bfhi(unsigned w) { return __builtin_bit_cast(float, w & 0xffff0000u); }
__device__ __forceinline__ unsigned pk4_fp8(float a, float b, float c, float d) { int w = __builtin_amdgcn_cvt_pk_fp8_f32(a, b, 0, false); w = __builtin_amdgcn_cvt_pk_fp8_f32(c, d, w, true); return (unsigned)w; }
constexpr float S_W = 128.0f, S_X = 16.0f, S_ACT = 4.0f;
constexpr int E8_W = 127 - 7, E8_X = 127 - 4, E8_ACT = 127 - 2;
__device__ __forceinline__ float sigm(float x) { return __builtin_amdgcn_rcpf(1.0f + __expf(-x)); }
__device__ __forceinline__ float wave_sum(float v) {
#pragma unroll
    for (int o = 1; o < 64; o <<= 1) v += __shfl_xor(v, o);
    return v;
}
__device__ __forceinline__ float wave_max(float v) {
#pragma unroll
    for (int o = 1; o < 64; o <<= 1) v = fmaxf(v, __shfl_xor(v, o));
    return v;
}

struct EpiProj {
    static constexpr bool PERM = true, AFTER_DRAIN = false;
    bf16_t *U, *Q, *G; const float* bgate;
    __device__ __forceinline__ void operator()(const f32x4 (&acc)[2][2][4][2], const Unit& u, int wr, int wc, int fr, int fq) const {
        const int row0 = u.pm * 256 + wr * 64 + fr, cl = wc * 32 + 8 * fq;
        if (u.pn < 8) {
#pragma unroll
            for (int ai = 0; ai < 2; ++ai)
#pragma unroll
                for (int m = 0; m < 4; ++m) {
                    const f32x4 a0 = acc[ai][0][m][0], a1 = acc[ai][0][m][1], g0 = acc[ai][1][m][0], g1 = acc[ai][1][m][1];
                    u32x4 w; w.x = cvt_pk(a0[0] * sigm(g0[0]), a0[1] * sigm(g0[1])); w.y = cvt_pk(a0[2] * sigm(g0[2]), a0[3] * sigm(g0[3]));
                    w.z = cvt_pk(a1[0] * sigm(g1[0]), a1[1] * sigm(g1[1])); w.w = cvt_pk(a1[2] * sigm(g1[2]), a1[3] * sigm(g1[3]));
                    *(u32x4*)(U + (size_t)(row0 + ai * 128 + m * 16) * DC + u.pn * 128 + cl) = w; }
        } else if (u.pn < 26) {
            const int s = (u.pn - 8) / 6, pl = (u.pn - 8) % 6; bf16_t* base = Q + (size_t)s * ((WS_K - WS_Q) / 2); const float sc = (s == 0) ? QSCALE : 1.0f;
#pragma unroll
            for (int ai = 0; ai < 2; ++ai)
#pragma unroll
                for (int m = 0; m < 4; ++m) { bf16_t* rowp = base + (size_t)(row0 + ai * 128 + m * 16) * AW + pl * 256 + cl;
#pragma unroll
                    for (int bj = 0; bj < 2; ++bj) { const f32x4 v0 = acc[ai][bj][m][0] * sc, v1 = acc[ai][bj][m][1] * sc;
                        u32x4 w; w.x = cvt_pk(v0[0], v0[1]); w.y = cvt_pk(v0[2], v0[3]); w.z = cvt_pk(v1[0], v1[1]); w.w = cvt_pk(v1[2], v1[3]);
                        *(u32x4*)(rowp + bj * 128) = w; } }
        } else {
            const int c0 = (u.pn - 26) * 256 + cl;
            f32x4 bv[2][2];
#pragma unroll
            for (int bj = 0; bj < 2; ++bj)
#pragma unroll
                for (int n = 0; n < 2; ++n) bv[bj][n] = *(const f32x4*)(bgate + c0 + bj * 128 + 4 * n);
#pragma unroll
            for (int ai = 0; ai < 2; ++ai)
#pragma unroll
                for (int m = 0; m < 4; ++m) { bf16_t* rowp = G + (size_t)(row0 + ai * 128 + m * 16) * (2 * D) + c0;
#pragma unroll
                    for (int bj = 0; bj < 2; ++bj) { const f32x4 v0 = acc[ai][bj][m][0] + bv[bj][0], v1 = acc[ai][bj][m][1] + bv[bj][1];
                        u32x4 w; w.x = cvt_pk(sigm(v0[0]), sigm(v0[1])); w.y = cvt_pk(sigm(v0[2]), sigm(v0[3])); w.z = cvt_pk(sigm(v1[0]), sigm(v1[1])); w.w = cvt_pk(sigm(v1[2]), sigm(v1[3]));
                        *(u32x4*)(rowp + bj * 128) = w; } }
        }
    }
};
struct EpiConvOut {
    static constexpr bool PERM = false, AFTER_DRAIN = false;
    float* M1; const bf16_t* G; const float* bco;
    __device__ __forceinline__ void operator()(const f32x4 (&acc)[2][2][4][2], const Unit& u, int wr, int wc, int fr, int fq) const {
        const int row0 = u.pm * 256 + wr * 64 + fr, col0 = u.pn * 256 + wc * 32 + 4 * fq;
        f32x4 bv[2][2];
#pragma unroll
        for (int bj = 0; bj < 2; ++bj)
#pragma unroll
            for (int n = 0; n < 2; ++n) bv[bj][n] = *(const f32x4*)(bco + col0 + bj * 128 + n * 16);
#pragma unroll
        for (int ai = 0; ai < 2; ++ai)
#pragma unroll
            for (int m = 0; m < 4; ++m) { const size_t row = (size_t)(row0 + ai * 128 + m * 16);
#pragma unroll
                for (int bj = 0; bj < 2; ++bj)
#pragma unroll
                    for (int n = 0; n < 2; ++n) { const int col = col0 + bj * 128 + n * 16;
                        const u32x2 gw = *(const u32x2*)(G + row * (2 * D) + col); const f32x4 v = acc[ai][bj][m][n] + bv[bj][n];
                        f32x4 o; o[0] = bflo(gw.x) * v[0]; o[1] = bfhi(gw.x) * v[1]; o[2] = bflo(gw.y) * v[2]; o[3] = bfhi(gw.y) * v[3];
                        *(f32x4*)(M1 + row * D + col) = o; } }
    }
};
struct EpiAttnOut {
    static constexpr bool PERM = false, AFTER_DRAIN = false;
    const float* M1; const bf16_t* G; bf16_t* MG;
    __device__ __forceinline__ void operator()(const f32x4 (&acc)[2][2][4][2], const Unit& u, int wr, int wc, int fr, int fq) const {
        const int row0 = u.pm * 256 + wr * 64 + fr, col0 = u.pn * 256 + wc * 32 + 4 * fq;
#pragma unroll
        for (int ai = 0; ai < 2; ++ai)
#pragma unroll
            for (int m = 0; m < 4; ++m) { const size_t row = (size_t)(row0 + ai * 128 + m * 16);
#pragma unroll
                for (int bj = 0; bj < 2; ++bj)
#pragma unroll
                    for (int n = 0; n < 2; ++n) { const int col = col0 + bj * 128 + n * 16;
                        const u32x2 gw = *(const u32x2*)(G + row * (2 * D) + D + col); const f32x4 v = acc[ai][bj][m][n]; const f32x4 m1 = *(const f32x4*)(M1 + row * D + col);
                        u32x2 w; w.x = cvt_pk(m1[0] + bflo(gw.x) * v[0], m1[1] + bfhi(gw.x) * v[1]); w.y = cvt_pk(m1[2] + bflo(gw.y) * v[2], m1[3] + bfhi(gw.y) * v[3]);
                        *(u32x2*)(MG + row * D + col) = w; } }
    }
};
struct EpiResid {
    static constexpr bool PERM = false, AFTER_DRAIN = false;
    const float* X; float* X1;
    __device__ __forceinline__ void operator()(const f32x4 (&acc)[2][2][4][2], const Unit& u, int wr, int wc, int fr, int fq) const {
        const int row0 = u.pm * 256 + wr * 64 + fr, col0 = u.pn * 256 + wc * 32 + 4 * fq;
#pragma unroll
        for (int ai = 0; ai < 2; ++ai)
#pragma unroll
            for (int m = 0; m < 4; ++m) { const size_t off = (size_t)(row0 + ai * 128 + m * 16) * D + col0;
#pragma unroll
                for (int bj = 0; bj < 2; ++bj)
#pragma unroll
                    for (int n = 0; n < 2; ++n) { const f32x4 xv = *(const f32x4*)(X + off + bj * 128 + n * 16); *(f32x4*)(X1 + off + bj * 128 + n * 16) = xv + acc[ai][bj][m][n]; } }
    }
};
struct EpiSwiGLU {
    static constexpr bool PERM = true, AFTER_DRAIN = false;
    unsigned char* ACT; const float* bin;
    __device__ __forceinline__ void operator()(const f32x4 (&acc)[2][2][4][2], const Unit& u, int wr, int wc, int fr, int fq) const {
        const int e = u.pn >> 4, pl = u.pn & 15;
        const int row0 = u.pm * 256 + wr * 64 + fr, cl = pl * 128 + wc * 32 + 8 * fq;
        f32x4 bg[2], bu[2];
#pragma unroll
        for (int n = 0; n < 2; ++n) { bg[n] = *(const f32x4*)(bin + (size_t)e * (2 * DE) + cl + 4 * n); bu[n] = *(const f32x4*)(bin + (size_t)e * (2 * DE) + DE + cl + 4 * n); }
#pragma unroll
        for (int ai = 0; ai < 2; ++ai)
#pragma unroll
            for (int m = 0; m < 4; ++m) {
                float o[8];
#pragma unroll
                for (int n = 0; n < 2; ++n) { const f32x4 gv = acc[ai][0][m][n] + bg[n], uv = acc[ai][1][m][n] + bu[n];
#pragma unroll
                    for (int q = 0; q < 4; ++q) { const float gg = fminf(gv[q], 7.0f), uu = fminf(fmaxf(uv[q], -7.0f), 7.0f); o[4 * n + q] = (uu + 1.0f) * (gg * sigm(1.702f * gg)); } }
                u32x2 w; w.x = pk4_fp8(o[0] * S_ACT, o[1] * S_ACT, o[2] * S_ACT, o[3] * S_ACT); w.y = pk4_fp8(o[4] * S_ACT, o[5] * S_ACT, o[6] * S_ACT, o[7] * S_ACT);
                *(u32x2*)(ACT + (size_t)(row0 + ai * 128 + m * 16) * DE + cl) = w; }
    }
};
struct EpiExpOut {
    static constexpr bool PERM = true, AFTER_DRAIN = false;
    bf16_t* Y; const float* bout;
    __device__ __forceinline__ void operator()(const f32x4 (&acc)[2][2][4][2], const Unit& u, int wr, int wc, int fr, int fq) const {
        const int e = u.pn >> 3, pl = u.pn & 7;
        const int row0 = u.pm * 256 + wr * 64 + fr, c0 = pl * 256 + wc * 32 + 8 * fq;
        f32x4 bv[2][2];
#pragma unroll
        for (int bj = 0; bj < 2; ++bj)
#pragma unroll
            for (int n = 0; n < 2; ++n) bv[bj][n] = *(const f32x4*)(bout + (size_t)e * D + c0 + bj * 128 + 4 * n);
#pragma unroll
        for (int ai = 0; ai < 2; ++ai)
#pragma unroll
            for (int m = 0; m < 4; ++m) { bf16_t* rowp = Y + (size_t)(row0 + ai * 128 + m * 16) * D + c0;
#pragma unroll
                for (int bj = 0; bj < 2; ++bj) { const f32x4 v0 = acc[ai][bj][m][0] + bv[bj][0], v1 = acc[ai][bj][m][1] + bv[bj][1];
                    u32x4 w; w.x = cvt_pk(v0[0], v0[1]); w.y = cvt_pk(v0[2], v0[3]); w.z = cvt_pk(v1[0], v1[1]); w.w = cvt_pk(v1[2], v1[3]);
                    *(u32x4*)(rowp + bj * 128) = w; } }
    }
};
struct MoeOrder {
    const LAS int* rt0; int NT, G, c;
    __device__ __forceinline__ bool next(int i, Unit& u) const {
        const int L = i * G + c; const int total = rt0[NE] * NT; if (L >= total) return false;
        int e = 0;
#pragma unroll 1
        for (int q = 1; q < NE; ++q) if (L >= rt0[q] * NT) e = q;
        const int b = rt0[e], mt = rt0[e + 1] - b, idx = L - b * NT;
        u.pn = __builtin_amdgcn_readfirstlane(e * NT + idx / mt); u.pm = __builtin_amdgcn_readfirstlane(b + idx % mt); return true;
    }
    __device__ __forceinline__ void a_ready(const Unit&) const {}
    __device__ __forceinline__ void done(const Unit&) const {}
};

#define XB_TMO      128
#define XB_XCNT(j)  (256  + 64 * (j))
#define XB_XSUB(j)  (1280 + 64 * (j))
#define XB_XGEN(j)  (2304 + 64 * (j))
#define XB_TOP      3328
#define XB_TOPGEN   3392
#define XCD_BAR_WORDS 3456
#define XB_SPIN_CAP (1u << 18)

__device__ __forceinline__ unsigned xb_ld(unsigned* p)              { return __hip_atomic_load(p, __ATOMIC_RELAXED, __HIP_MEMORY_SCOPE_AGENT); }
__device__ __forceinline__ unsigned xb_add(unsigned* p, unsigned v) { return __hip_atomic_fetch_add(p, v, __ATOMIC_RELAXED, __HIP_MEMORY_SCOPE_AGENT); }
__device__ __forceinline__ unsigned xb_xcc_id() { return (unsigned)__builtin_amdgcn_s_getreg((3 << 11) | 20) & 0xFu; }
#define XB_SPIN(cond, bar) do { unsigned _sp = 0; while (cond) { __builtin_amdgcn_s_sleep(1); \
    if ((++_sp & 255u) == 0u) { if (xb_ld(&(bar)[XB_TMO])) break; if (_sp > XB_SPIN_CAP) { atomicAdd(&(bar)[XB_TMO], 1u); break; } } } } while (0)

struct XcdBarrier {
    unsigned* bar; unsigned x;
    volatile LAS unsigned* st;
};

__device__ __forceinline__ XcdBarrier xcd_barrier_post(unsigned* bar, volatile LAS unsigned* st) {
    XcdBarrier b; b.bar = bar; b.x = xb_xcc_id(); b.st = st;
    if (threadIdx.x == 0) (void)xb_add(&bar[XB_XCNT(b.x)], 1u);
    return b;
}
__device__ __forceinline__ void xcd_barrier_complete(unsigned* bar, unsigned x, unsigned& nloc, unsigned& nx) {
    const unsigned G = gridDim.x * gridDim.y * gridDim.z;
    unsigned sum, cnt, mine, sp = 0u;
    for (;;) {
        sum = 0u; cnt = 0u; mine = 0u;
#pragma unroll
        for (unsigned j = 0; j < 16; ++j) { const unsigned c = xb_ld(&bar[XB_XCNT(j)]); sum += c; cnt += (c > 0u) ? 1u : 0u; mine = (j == x) ? c : mine; }
        if (sum == G) break;
        __builtin_amdgcn_s_sleep(1);
        if ((++sp & 255u) == 0u) { if (xb_ld(&bar[XB_TMO])) break; if (sp > XB_SPIN_CAP) { atomicAdd(&bar[XB_TMO], 1u); break; } }
    }
    nloc = mine > 0u ? mine : 1u; nx = cnt > 0u ? cnt : 1u;
}

__device__ __forceinline__ void xcd_barrier(const XcdBarrier& b) {
    asm volatile("s_waitcnt vmcnt(0)" ::: "memory");
    __syncthreads();
    if (threadIdx.x == 0) {
        unsigned* bar = b.bar;
        __builtin_amdgcn_s_waitcnt(0);
        unsigned nloc = b.st[0], nx = b.st[1];
        if (nloc == 0u) { xcd_barrier_complete(bar, b.x, nloc, nx); b.st[0] = nloc; b.st[1] = nx; }
        const unsigned old = xb_add(&bar[XB_XSUB(b.x)], 1u);
        const unsigned gen = old / nloc;
        if (old + 1u == (gen + 1u) * nloc) {
            __builtin_amdgcn_fence(__ATOMIC_RELEASE, "agent");
            asm volatile("s_waitcnt vmcnt(0)" ::: "memory");
            const unsigned og = xb_add(&bar[XB_TOP], 1u);
            const unsigned tg = og / nx;
            if (og + 1u == (tg + 1u) * nx) xb_add(&bar[XB_TOPGEN], 1u);
            else XB_SPIN(xb_ld(&bar[XB_TOPGEN]) == tg, bar);
            __builtin_amdgcn_fence(__ATOMIC_ACQUIRE, "agent");
            xb_add(&bar[XB_XGEN(b.x)], 1u);
            asm volatile("s_waitcnt vmcnt(0)" ::: "memory");
        } else {
            XB_SPIN(xb_ld(&bar[XB_XGEN(b.x)]) == gen, bar);
            __builtin_amdgcn_fence(__ATOMIC_ACQUIRE, "agent");
            asm volatile("s_waitcnt vmcnt(0)" ::: "memory");
        }
    }
    __syncthreads();
}

struct Frame {
    LAS unsigned char* lds; volatile LAS unsigned* MISC; gu32* ctl;
    int tid, lane, wave, vcu, G;
};
struct Args { const float* in[20]; float* out; unsigned char* ws; int ph_lo, ph_hi, li, pad; };

__device__ __forceinline__ void p0_transpose_item(const float* W, int K, int N, bf16_t* WT, int k0, int n0, int drow0, LAS float* scr, int lane) {
#pragma unroll 8
    for (int i = 0; i < 32; ++i) { const int kk = 2 * i + (lane >> 5); scr[kk * 33 + (lane & 31)] = W[(size_t)(k0 + kk) * N + n0 + (lane & 31)]; }
    LDS_WAIT(); asm volatile("" ::: "memory");
    const int c = lane & 7;
#pragma unroll
    for (int j = 0; j < 4; ++j) { const int n = (lane >> 3) + 8 * j; const LAS float* s = scr + (8 * c) * 33 + n;
        u32x4 o; o.x = pk2(s[0 * 33], s[1 * 33]); o.y = pk2(s[2 * 33], s[3 * 33]); o.z = pk2(s[4 * 33], s[5 * 33]); o.w = pk2(s[6 * 33], s[7 * 33]);
        *(GAS u32x4*)(WT + (size_t)(drow0 + n) * K + k0 + 8 * c) = o; }
    LDS_WAIT(); asm volatile("" ::: "memory");
}
__device__ __forceinline__ void p0_transpose_item_fp8(const float* W, int K, int N, unsigned char* WT, int k0, int n0, int drow0, LAS float* scr, int lane) {
#pragma unroll 8
    for (int i = 0; i < 32; ++i) { const int kk = 2 * i + (lane >> 5); scr[kk * 33 + (lane & 31)] = W[(size_t)(k0 + kk) * N + n0 + (lane & 31)]; }
    LDS_WAIT(); asm volatile("" ::: "memory");
    const int c = lane & 3;
#pragma unroll
    for (int j = 0; j < 2; ++j) { const int n = (lane >> 2) + 16 * j; const LAS float* s = scr + (16 * c) * 33 + n;
        u32x4 o; o.x = pk4_fp8(s[0 * 33] * S_W, s[1 * 33] * S_W, s[2 * 33] * S_W, s[3 * 33] * S_W); o.y = pk4_fp8(s[4 * 33] * S_W, s[5 * 33] * S_W, s[6 * 33] * S_W, s[7 * 33] * S_W);
        o.z = pk4_fp8(s[8 * 33] * S_W, s[9 * 33] * S_W, s[10 * 33] * S_W, s[11 * 33] * S_W); o.w = pk4_fp8(s[12 * 33] * S_W, s[13 * 33] * S_W, s[14 * 33] * S_W, s[15 * 33] * S_W);
        *(GAS u32x4*)(WT + (size_t)(drow0 + n) * K + k0 + 16 * c) = o; }
    LDS_WAIT(); asm volatile("" ::: "memory");
}
template <int PMODE> __device__ __forceinline__ void cvt_task_fp8(const float* W, int N, unsigned char* WT, int K, int k0, int n0, int halfN, int lane) {
    const int n = n0 + 4 * (lane >> 3), k = k0 + 16 * (lane & 7);
    const GAS f32x4* src = (const GAS f32x4*)(W + (size_t)k * N + n);
    f32x4 v[16];
#pragma unroll
    for (int i = 0; i < 16; ++i) v[i] = src[(size_t)i * (N / 4)];
    int dr = n;
    if (PMODE == 1 || (PMODE == 2 && n < 2 * halfN)) dr = (n < halfN) ? ((n >> 7) * 256 + (n & 127)) : (((n - halfN) >> 7) * 256 + 128 + ((n - halfN) & 127));
#pragma unroll
    for (int j = 0; j < 4; ++j) { u32x4 o;
        o.x = pk4_fp8(v[0][j] * S_W, v[1][j] * S_W, v[2][j] * S_W, v[3][j] * S_W); o.y = pk4_fp8(v[4][j] * S_W, v[5][j] * S_W, v[6][j] * S_W, v[7][j] * S_W);
        o.z = pk4_fp8(v[8][j] * S_W, v[9][j] * S_W, v[10][j] * S_W, v[11][j] * S_W); o.w = pk4_fp8(v[12][j] * S_W, v[13][j] * S_W, v[14][j] * S_W, v[15][j] * S_W);
        *(GAS u32x4*)(WT + (size_t)(dr + j) * K + k) = o; }
}
template <int PMODE> __device__ __forceinline__ void cvt_task_bf16(const float* W, int N, bf16_t* WT, int K, int k0, int n0, int halfN, int lane) {
    const int n = n0 + 4 * (lane >> 3), k = k0 + 8 * (lane & 7);
    const GAS f32x4* src = (const GAS f32x4*)(W + (size_t)k * N + n);
    f32x4 v[8];
#pragma unroll
    for (int i = 0; i < 8; ++i) v[i] = src[(size_t)i * (N / 4)];
    int dr = n;
    if (PMODE == 1 || (PMODE == 2 && n < 2 * halfN)) dr = (n < halfN) ? ((n >> 7) * 256 + (n & 127)) : (((n - halfN) >> 7) * 256 + 128 + ((n - halfN) & 127));
#pragma unroll
    for (int j = 0; j < 4; ++j) { u32x4 o; o.x = cvt_pk(v[0][j], v[1][j]); o.y = cvt_pk(v[2][j], v[3][j]); o.z = cvt_pk(v[4][j], v[5][j]); o.w = cvt_pk(v[6][j], v[7][j]);
        *(GAS u32x4*)(WT + (size_t)(dr + j) * K + k) = o; }
}
__device__ __forceinline__ int paired_row(int n0, int halfN) { return (n0 < halfN) ? ((n0 >> 7) * 256 + (n0 & 127)) : (((n0 - halfN) >> 7) * 256 + 128 + ((n0 - halfN) & 127)); }

__device__ __forceinline__ void rms_row_to_bf16(const float* xrow, const float* g, bf16_t* orow, int lane) {
    const GAS f32x4* xr = (const GAS f32x4*)xrow + lane;
    f32x4 v[8]; float ss = 0.f;
#pragma unroll
    for (int j = 0; j < 8; ++j) { v[j] = xr[64 * j]; ss += (v[j][0] * v[j][0] + v[j][1] * v[j][1]) + (v[j][2] * v[j][2] + v[j][3] * v[j][3]); }
    const float rs = rsqrtf(wave_sum(ss) * (1.0f / D) + EPS);
    GAS u32x2* o8 = (GAS u32x2*)orow + lane;
#pragma unroll
    for (int j = 0; j < 8; ++j) { const f32x4 gg = ((const GAS f32x4*)g)[lane + 64 * j]; u32x2 w; w.x = pk2(v[j][0] * rs * gg[0], v[j][1] * rs * gg[1]); w.y = pk2(v[j][2] * rs * gg[2], v[j][3] * rs * gg[3]); o8[64 * j] = w; }
}

__device__ __forceinline__ void rms_row_to_fp8(const float* xrow, const float* g, unsigned char* orow, int lane) {
    const GAS f32x4* xr = (const GAS f32x4*)xrow + lane;
    f32x4 v[8]; float ss = 0.f;
#pragma unroll
    for (int j = 0; j < 8; ++j) { v[j] = xr[64 * j]; ss += (v[j][0] * v[j][0] + v[j][1] * v[j][1]) + (v[j][2] * v[j][2] + v[j][3] * v[j][3]); }
    const float rs = rsqrtf(wave_sum(ss) * (1.0f / D) + EPS) * S_X;
    GAS unsigned* o4 = (GAS unsigned*)orow + lane;
#pragma unroll
    for (int j = 0; j < 8; ++j) { const f32x4 gg = ((const GAS f32x4*)g)[lane + 64 * j]; o4[64 * j] = pk4_fp8(v[j][0] * rs * gg[0], v[j][1] * rs * gg[1], v[j][2] * rs * gg[2], v[j][3] * rs * gg[3]); }
}

__device__ __forceinline__ void conv_tile(Frame& F, int tile, const bf16_t* U, const float* cw, const float* cb, const float* lg, const float* lb, bf16_t* UC) {
    const int t0 = tile * 32, c = 2 * F.tid;
    LAS float* ys = (LAS float*)F.lds;
    f32x2 w[31];
#pragma unroll
    for (int k = 0; k < 31; ++k) w[k] = *(const f32x2*)(cw + k * DC + c);
    const f32x2 bias = *(const f32x2*)(cb + c);
    f32x2 win[31];
#pragma unroll
    for (int p = 0; p < 30; ++p) { const int tt = t0 - 30 + p; unsigned v = 0u; if (tt >= 0) v = *(const unsigned*)(U + (size_t)tt * DC + c); win[p] = (f32x2){bflo(v), bfhi(v)}; }
    win[30] = (f32x2){0.f, 0.f};
#pragma unroll 1
    for (int jb = 0; jb < 32; jb += 31) {
#pragma unroll
        for (int p = 0; p < 31; ++p) {
            const int j = jb + p;
            if (j < 32) {
                const unsigned v = *(const unsigned*)(U + (size_t)(t0 + j) * DC + c);
                win[(30 + p) % 31] = (f32x2){bflo(v), bfhi(v)};
                f32x2 a = bias;
#pragma unroll
                for (int k = 0; k < 31; ++k) a += w[k] * win[(p + k) % 31];
                *(LAS f32x2*)(ys + j * DC + c) = a;
            }
        }
    }
    __syncthreads();
#pragma unroll 1
    for (int jj = 0; jj < 4; ++jj) {
        const int j = F.wave * 4 + jj;
        f32x4 v[4]; float s = 0.f;
#pragma unroll
        for (int q = 0; q < 4; ++q) { v[q] = *(const LAS f32x4*)(ys + j * DC + 4 * F.lane + 256 * q); s += (v[q][0] + v[q][1]) + (v[q][2] + v[q][3]); }
        const float mu = wave_sum(s) * (1.0f / DC); float qq = 0.f;
#pragma unroll
        for (int q = 0; q < 4; ++q) { v[q] = v[q] - mu; qq += (v[q][0] * v[q][0] + v[q][1] * v[q][1]) + (v[q][2] * v[q][2] + v[q][3] * v[q][3]); }
        const float rstd = rsqrtf(wave_sum(qq) * (1.0f / DC) + EPS);
#pragma unroll
        for (int q = 0; q < 4; ++q) { const int cc = 4 * F.lane + 256 * q; const f32x4 g4 = *(const f32x4*)(lg + cc), b4 = *(const f32x4*)(lb + cc);
            float y[4];
#pragma unroll
            for (int z = 0; z < 4; ++z) { const float t = v[q][z] * rstd * g4[z] + b4[z]; y[z] = t * sigm(t); }
            u32x2 o; o.x = cvt_pk(y[0], y[1]); o.y = cvt_pk(y[2], y[3]);
            *(u32x2*)(UC + (size_t)(t0 + j) * DC + cc) = o; }
    }
    __syncthreads();
}

__device__ __forceinline__ void attn_task(const bf16_t* __restrict__ Q, const bf16_t* __restrict__ Kb, const bf16_t* __restrict__ Vb, float* OG, float* LSE, int task, int lane) {
    const int h = task >> 8, rem = task & 255;
    const int dsh = 2 * (h >> 2), dil = 1 << dsh;
    const int r = rem & (dil - 1), mc = rem >> dsh;
    const int i = lane & 31, hh = lane >> 5;
    const int m0 = mc * 32;
    const int tq = ((m0 + i) << dsh) + r;
    bf16x8 qf[8];
    { const bf16_t* qp = Q + (size_t)tq * AW + h * HD + 8 * hh;
#pragma unroll
      for (int s = 0; s < 8; ++s) qf[s] = *(const bf16x8*)(qp + 16 * s); }
    const int jt0 = (mc < 4) ? (4 - mc) : 0;
    const float NEG = -__builtin_inff();
    f32x16 sacc[5];
#pragma unroll
    for (int jt = 0; jt < 5; ++jt) {
        f32x16 a;
#pragma unroll
        for (int q = 0; q < 16; ++q) a[q] = 0.f;
        if (jt >= jt0) {
            const int mk = m0 - 128 + 32 * jt + i;
            const bf16_t* kp = Kb + (size_t)((mk << dsh) + r) * AW + h * HD + 8 * hh;
#pragma unroll
            for (int s = 0; s < 8; ++s) { const bf16x8 kf = *(const bf16x8*)(kp + 16 * s); a = __builtin_amdgcn_mfma_f32_32x32x16_bf16(kf, qf[s], a, 0, 0, 0); }
#pragma unroll
            for (int q = 0; q < 16; ++q) { const int kk = (q & 3) + 8 * (q >> 2) + 4 * hh;
                if (jt == 0 && kk < i) a[q] = NEG;
                if (jt == 4 && kk > i) a[q] = NEG; }
        } else {
#pragma unroll
            for (int q = 0; q < 16; ++q) a[q] = NEG;
        }
        sacc[jt] = a;
        __builtin_amdgcn_sched_barrier(0);
    }
    float mx = NEG;
#pragma unroll
    for (int jt = 0; jt < 5; ++jt)
#pragma unroll
        for (int q = 0; q < 16; ++q) mx = fmaxf(mx, sacc[jt][q]);
    mx = fmaxf(mx, __shfl_xor(mx, 32));
    float l = 0.f;
#pragma unroll
    for (int jt = 0; jt < 5; ++jt)
#pragma unroll
        for (int q = 0; q < 16; ++q) { const float e = __builtin_amdgcn_exp2f(sacc[jt][q] - mx); sacc[jt][q] = e; l += e; }
    l += __shfl_xor(l, 32);
    const float inv = 1.0f / l;
    if (hh == 0) LSE[(size_t)tq * NH + h] = (mx + __log2f(l)) * LN2;
    bf16x8 pf[5][2];
#pragma unroll
    for (int jt = 0; jt < 5; ++jt)
#pragma unroll
        for (int s2 = 0; s2 < 2; ++s2) { u32x4 w;
            w.x = cvt_pk(sacc[jt][8 * s2 + 0] * inv, sacc[jt][8 * s2 + 1] * inv); w.y = cvt_pk(sacc[jt][8 * s2 + 2] * inv, sacc[jt][8 * s2 + 3] * inv);
            w.z = cvt_pk(sacc[jt][8 * s2 + 4] * inv, sacc[jt][8 * s2 + 5] * inv); w.w = cvt_pk(sacc[jt][8 * s2 + 6] * inv, sacc[jt][8 * s2 + 7] * inv);
            pf[jt][s2] = __builtin_bit_cast(bf16x8, w); }
    f32x16 o[4];
#pragma unroll
    for (int z = 0; z < 4; ++z)
#pragma unroll
        for (int q = 0; q < 16; ++q) o[z][q] = 0.f;
    const bf16_t* vcol = Vb + h * HD + 2 * i;
#pragma unroll
    for (int jt = 0; jt < 5; ++jt) {
        if (jt >= jt0) {
#pragma unroll
            for (int s2 = 0; s2 < 2; ++s2) {
                unsigned wa[8], wb[8];
#pragma unroll
                for (int j = 0; j < 8; ++j) { const int mk = m0 - 128 + 32 * jt + 16 * s2 + 8 * (j >> 2) + 4 * hh + (j & 3); const bf16_t* vp = vcol + (size_t)((mk << dsh) + r) * AW;
                    wa[j] = *(const unsigned*)vp; wb[j] = *(const unsigned*)(vp + 64); }
                u32x4 f0, f1, f2, f3;
                f0.x = (wa[0] & 0xffffu) | (wa[1] << 16); f0.y = (wa[2] & 0xffffu) | (wa[3] << 16); f0.z = (wa[4] & 0xffffu) | (wa[5] << 16); f0.w = (wa[6] & 0xffffu) | (wa[7] << 16);
                f1.x = (wa[0] >> 16) | (wa[1] & 0xffff0000u); f1.y = (wa[2] >> 16) | (wa[3] & 0xffff0000u); f1.z = (wa[4] >> 16) | (wa[5] & 0xffff0000u); f1.w = (wa[6] >> 16) | (wa[7] & 0xffff0000u);
                f2.x = (wb[0] & 0xffffu) | (wb[1] << 16); f2.y = (wb[2] & 0xffffu) | (wb[3] << 16); f2.z = (wb[4] & 0xffffu) | (wb[5] << 16); f2.w = (wb[6] & 0xffffu) | (wb[7] << 16);
                f3.x = (wb[0] >> 16) | (wb[1] & 0xffff0000u); f3.y = (wb[2] >> 16) | (wb[3] & 0xffff0000u); f3.z = (wb[4] >> 16) | (wb[5] & 0xffff0000u); f3.w = (wb[6] >> 16) | (wb[7] & 0xffff0000u);
                o[0] = __builtin_amdgcn_mfma_f32_32x32x16_bf16(pf[jt][s2], __builtin_bit_cast(bf16x8, f0), o[0], 0, 0, 0);
                o[1] = __builtin_amdgcn_mfma_f32_32x32x16_bf16(pf[jt][s2], __builtin_bit_cast(bf16x8, f1), o[1], 0, 0, 0);
                o[2] = __builtin_amdgcn_mfma_f32_32x32x16_bf16(pf[jt][s2], __builtin_bit_cast(bf16x8, f2), o[2], 0, 0, 0);
                o[3] = __builtin_amdgcn_mfma_f32_32x32x16_bf16(pf[jt][s2], __builtin_bit_cast(bf16x8, f3), o[3], 0, 0, 0);
                __builtin_amdgcn_sched_barrier(0);
            }
        }
    }
#pragma unroll
    for (int q = 0; q < 16; ++q) { const int qi = (q & 3) + 8 * (q >> 2) + 4 * hh; const int tt = ((m0 + qi) << dsh) + r;
        float* op = OG + ((size_t)tt * NH + h) * HD + 2 * i;
        *(f32x2*)op = (f32x2){o[0][q], o[1][q]}; *(f32x2*)(op + 64) = (f32x2){o[2][q], o[3][q]}; }
}

__global__ void __launch_bounds__(NWAVES * 64, 2) mk_fwd(Args args) {
    extern __shared__ __attribute__((aligned(16))) unsigned char lds[];
    Frame F;
    F.lds = (LAS unsigned char*)lds;
    F.MISC = (volatile LAS unsigned*)(F.lds + MISC_OFF);
    F.tid = threadIdx.x; F.lane = F.tid & 63; F.wave = __builtin_amdgcn_readfirstlane(F.tid >> 6);
    F.G = gridDim.x; { const int bx = blockIdx.x; F.vcu = (F.G % 8 == 0) ? (bx % 8) * (F.G / 8) + bx / 8 : bx; }
    unsigned char* ws = args.ws;
    F.ctl = (gu32*)(ws + WS_CTL);
    for (int u = F.tid; u < (LDS_BYTES - LDSCTL_OFF) / 4; u += NWAVES * 64) ((LAS unsigned*)(F.lds + LDSCTL_OFF))[u] = 0u;
    __syncthreads();
    const bool one_launch = (args.ph_hi - args.ph_lo) > 1;
    XcdBarrier bar; bar.bar = (unsigned*)(F.ctl + CW_BAR) + args.li * XCD_BAR_WORDS; bar.x = 0; bar.st = nullptr;
    if (one_launch) bar = xcd_barrier_post((unsigned*)(F.ctl + CW_BAR) + args.li * XCD_BAR_WORDS, F.MISC + 8);
    const int lo = args.ph_lo, hi = args.ph_hi;
#ifndef MK_PHASE_MASK
#define MK_PHASE_MASK 0xfff
#endif
#define IN(k) ((((MK_PHASE_MASK) >> (k)) & 1) && lo <= (k) && (k) < hi)
#define SEAM(k) do { if (IN(k) && IN((k) + 1)) xcd_barrier(bar); } while (0)
#ifndef MK_REPEAT
#define MK_REPEAT (-1)
#endif
#define REPS(k) for (int rep_ = 0; rep_ < ((k) == MK_REPEAT ? 2 : 1); ++rep_)

    const float* x = args.in[0]; const float* n1g = args.in[1]; const float* w_in = args.in[2]; const float* b_gate = args.in[3];
    const float* conv_w = args.in[4]; const float* conv_b = args.in[5]; const float* ln_g = args.in[6]; const float* ln_b = args.in[7];
    const float* w_co = args.in[8]; const float* b_co = args.in[9]; const float* w_ao = args.in[10]; const float* w_out = args.in[11];
    const float* n2g = args.in[12]; const float* w_r = args.in[13]; const float* b_r = args.in[14];
    const float* w_ei = args.in[15]; const float* b_ei = args.in[16]; const float* w_eo = args.in[17]; const float* b_eo = args.in[18]; const float* nfg = args.in[19];
    bf16_t* WIN = (bf16_t*)(ws + WS_WIN); bf16_t* WCO = (bf16_t*)(ws + WS_WCO); bf16_t* WAO = (bf16_t*)(ws + WS_WAO); bf16_t* WOUT = (bf16_t*)(ws + WS_WOUT);
    unsigned char* WE1 = ws + WS_WE1; unsigned char* WE2 = ws + WS_WE2;
    bf16_t* Hb = (bf16_t*)(ws + WS_H); bf16_t* Ub = (bf16_t*)(ws + WS_U); bf16_t* Qb = (bf16_t*)(ws + WS_Q); bf16_t* Kb = (bf16_t*)(ws + WS_K); bf16_t* Vb = (bf16_t*)(ws + WS_V);
    bf16_t* Gb = (bf16_t*)(ws + WS_GATE); bf16_t* UCb = (bf16_t*)(ws + WS_UC); float* OG = (float*)(ws + WS_OG); float* LSE = (float*)(ws + WS_LSE); bf16_t* OCb = (bf16_t*)(ws + WS_OC);
    float* M1 = (float*)(ws + WS_M1); bf16_t* MGb = (bf16_t*)(ws + WS_MG); float* X1 = (float*)(ws + WS_X1); unsigned char* H2f = ws + WS_H2;
    int* a_e = (int*)(ws + WS_AE); int* a_pos = (int*)(ws + WS_APOS); float* a_gate = (float*)(ws + WS_AGATE); int* a_slot = (int*)(ws + WS_ASLOT);
    unsigned char* XG = ws + WS_XG; unsigned char* ACT = ws + WS_ACT; bf16_t* Yb = (bf16_t*)(ws + WS_Y);
    int* hist = (int*)(ws + WS_HIST);
    const int gw = F.vcu * NWAVES + F.wave, NGW = F.G * NWAVES;

    REPS(0) if (IN(0)) {
        if (rep_) xcd_barrier(bar);
        { constexpr int NB_IN = DIN / 32, T_IN = (D / 128) * NB_IN, NB = D / 32, T_CO = (DC / 64) * NB, T_AO = (AO / 64) * NB, T_OUT = (D / 64) * NB;
          for (int it = gw; it < T_IN; it += NGW) cvt_task_fp8<2>(w_in, DIN, (unsigned char*)WIN, D, 128 * (it / NB_IN), 32 * (it % NB_IN), 1024, F.lane);
          for (int it = gw; it < T_CO + T_AO + T_OUT; it += NGW) { int q = it;
              if (q < T_CO) { cvt_task_bf16<0>(w_co, D, WCO, DC, 64 * (q / NB), 32 * (q % NB), 0, F.lane); continue; } q -= T_CO;
              if (q < T_AO) { cvt_task_bf16<0>(w_ao, D, WAO, AO, 64 * (q / NB), 32 * (q % NB), 0, F.lane); continue; } q -= T_AO;
              cvt_task_bf16<0>(w_out, D, WOUT, D, 64 * (q / NB), 32 * (q % NB), 0, F.lane); } }
#ifdef MK_CONV_CUS
        if ((int)blockIdx.x < MK_CONV_CUS)
#endif
        { constexpr int NB1 = 2 * DE / 32, T1 = (D / 128) * NB1, NB2 = D / 32, T2 = (DE / 128) * NB2;
#ifdef MK_CONV_CUS
          const int gw = (int)blockIdx.x * NWAVES + F.wave, NGW = MK_CONV_CUS * NWAVES;
#endif
          for (int it = gw; it < NE * T1; it += NGW) { const int e = it / T1, q = it % T1;
              cvt_task_fp8<1>(w_ei + (size_t)e * D * 2 * DE, 2 * DE, WE1 + (size_t)e * 2 * DE * D, D, 128 * (q / NB1), 32 * (q % NB1), DE, F.lane); }
          for (int it = gw; it < NE * T2; it += NGW) { const int e = it / T2, q = it % T2;
              cvt_task_fp8<0>(w_eo + (size_t)e * DE * D, D, WE2 + (size_t)e * D * DE, DE, 128 * (q / NB2), 32 * (q % NB2), 0, F.lane); } }
        for (int m = gw; m < T; m += NGW) rms_row_to_fp8(x + (size_t)m * D, n1g, (unsigned char*)Hb + (size_t)m * D, F.lane);
    }
    SEAM(0);
    if (IN(1)) {
        pg8::Gemm g{Hb, WIN, T, DIN, D / 2}; pg8::StaticOrder S; S.init(T, DIN, F.G, (int)blockIdx.x);
        static_assert(WS_V - WS_K == WS_K - WS_Q, "q|k|v strides"); EpiProj E{Ub, Qb, Gb, b_gate};
        pg8::gemm_phase<EpiProj, pg8::StaticOrder, true, true, E8_W, E8_X>(F.lds, g, S, E);
        if (MK_REPEAT == 1) {
            xcd_barrier(bar);
            pg8::Gemm g{Hb, WIN, T, DIN, D / 2}; pg8::StaticOrder S; S.init(T, DIN, F.G, (int)blockIdx.x);
        static_assert(WS_V - WS_K == WS_K - WS_Q, "q|k|v strides"); EpiProj E{Ub, Qb, Gb, b_gate};
        pg8::gemm_phase<EpiProj, pg8::StaticOrder, true, true, E8_W, E8_X>(F.lds, g, S, E);
        }
    }
    SEAM(1);
    REPS(2) if (IN(2)) {
        if (rep_) xcd_barrier(bar);
#ifndef MK_NO_CONV
        for (int tile = F.vcu; tile < T / 32; tile += F.G) conv_tile(F, tile, Ub, conv_w, conv_b, ln_g, ln_b, UCb);
#endif
#ifndef MK_NO_ATTN
        for (int task = gw; task < NH * 256; task += NGW) attn_task(Qb, Kb, Vb, OG, LSE, task, F.lane);
#endif
    }
    SEAM(2);
    REPS(3) if (IN(3)) {
        if (rep_) xcd_barrier(bar);
        for (int it = gw; it < T * 4; it += NGW) { const int t = it >> 2, hg = it & 3;
            const float l0 = LSE[(size_t)t * NH + hg], l1 = LSE[(size_t)t * NH + 4 + hg], l2 = LSE[(size_t)t * NH + 8 + hg];
            const float m = fmaxf(l0, fmaxf(l1, l2)); const float w0 = __expf(l0 - m), w1 = __expf(l1 - m), w2 = __expf(l2 - m), inv = 1.0f / (w0 + w1 + w2);
            const f32x2 a = *(const f32x2*)(OG + ((size_t)t * NH + hg) * HD + 2 * F.lane), b = *(const f32x2*)(OG + ((size_t)t * NH + 4 + hg) * HD + 2 * F.lane), c = *(const f32x2*)(OG + ((size_t)t * NH + 8 + hg) * HD + 2 * F.lane);
            const f32x2 o = (a * w0 + b * w1 + c * w2) * inv;
            *(unsigned*)(OCb + (size_t)t * AO + hg * HD + 2 * F.lane) = cvt_pk(o[0], o[1]); }
    }
    SEAM(3);
    if (IN(4)) {
        pg8::Gemm g{UCb, WCO, T, D, DC}; pg8::StaticOrder S; S.init(T, D, F.G, (int)blockIdx.x);
        EpiConvOut E{M1, Gb, b_co};
        pg8::gemm_phase<EpiConvOut, pg8::StaticOrder, false, true>(F.lds, g, S, E);
        if (MK_REPEAT == 4) {
            xcd_barrier(bar);
            pg8::Gemm g{UCb, WCO, T, D, DC}; pg8::StaticOrder S; S.init(T, D, F.G, (int)blockIdx.x);
        EpiConvOut E{M1, Gb, b_co};
        pg8::gemm_phase<EpiConvOut, pg8::StaticOrder, false, true>(F.lds, g, S, E);
        }
    }
    SEAM(4);
    if (IN(5)) {
        pg8::Gemm g{OCb, WAO, T, D, AO}; pg8::StaticOrder S; S.init(T, D, F.G, (int)blockIdx.x);
        EpiAttnOut E{M1, Gb, MGb};
        pg8::gemm_phase<EpiAttnOut, pg8::StaticOrder, false, true>(F.lds, g, S, E);
    }
    SEAM(5);
    if (IN(6)) {
        pg8::Gemm g{MGb, WOUT, T, D, D}; pg8::StaticOrder S; S.init(T, D, F.G, (int)blockIdx.x);
        EpiResid E{x, X1};
        pg8::gemm_phase<EpiResid, pg8::StaticOrder, false, true>(F.lds, g, S, E);
        if (MK_REPEAT == 6) {
            xcd_barrier(bar);
            pg8::Gemm g{MGb, WOUT, T, D, D}; pg8::StaticOrder S; S.init(T, D, F.G, (int)blockIdx.x);
        EpiResid E{x, X1};
        pg8::gemm_phase<EpiResid, pg8::StaticOrder, false, true>(F.lds, g, S, E);
        }
    }
    SEAM(6);
    REPS(7) if (IN(7)) {
        if (rep_) xcd_barrier(bar);
        LAS float* xs = (LAS float*)F.lds;
        LAS int* ue = (LAS int*)(F.lds + TAB_OFF + 256);
        for (int unit = F.vcu; unit < T / 16; unit += F.G) {
            const int t0 = unit * 16;
#pragma unroll 1
            for (int tt = 2 * F.wave; tt < 2 * F.wave + 2; ++tt) {
                const GAS f32x4* xr = (const GAS f32x4*)(X1 + (size_t)(t0 + tt) * D) + F.lane;
                f32x4 v[8]; float ss = 0.f;
#pragma unroll
                for (int j = 0; j < 8; ++j) { v[j] = xr[64 * j]; ss += (v[j][0] * v[j][0] + v[j][1] * v[j][1]) + (v[j][2] * v[j][2] + v[j][3] * v[j][3]); }
                const float rs = rsqrtf(wave_sum(ss) * (1.0f / D) + EPS);
                GAS unsigned* o4 = (GAS unsigned*)(H2f + (size_t)(t0 + tt) * D) + F.lane;
#pragma unroll
                for (int j = 0; j < 8; ++j) { const f32x4 gg = ((const GAS f32x4*)n2g)[F.lane + 64 * j]; const f32x4 y = v[j] * rs * gg;
                    *(LAS f32x4*)(xs + tt * D + 4 * (F.lane + 64 * j)) = y; o4[64 * j] = pk4_fp8(y[0] * S_X, y[1] * S_X, y[2] * S_X, y[3] * S_X); }
            }
            __syncthreads();
            float pacc[16];
#pragma unroll
            for (int tt = 0; tt < 16; ++tt) pacc[tt] = 0.f;
            { const int e = F.lane & 31, kh = F.lane >> 5, i0 = 256 * F.wave + 128 * kh;
#pragma unroll 2
              for (int ii = 0; ii < 128; ii += 4) {
                  const float w0 = w_r[(size_t)(i0 + ii) * NE + e], w1 = w_r[(size_t)(i0 + ii + 1) * NE + e], w2 = w_r[(size_t)(i0 + ii + 2) * NE + e], w3 = w_r[(size_t)(i0 + ii + 3) * NE + e];
#pragma unroll
                  for (int tt = 0; tt < 16; ++tt) { const f32x4 xv = *(const LAS f32x4*)(xs + tt * D + i0 + ii); pacc[tt] += (xv[0] * w0 + xv[1] * w1) + (xv[2] * w2 + xv[3] * w3); }
              } }
#pragma unroll
            for (int tt = 0; tt < 16; ++tt) pacc[tt] += __shfl_xor(pacc[tt], 32);
            __syncthreads();
            if (F.lane < 32) {
#pragma unroll
                for (int tt = 0; tt < 16; ++tt) xs[(F.wave * 16 + tt) * 32 + F.lane] = pacc[tt];
            }
            __syncthreads();
#pragma unroll 1
            for (int tt = 2 * F.wave; tt < 2 * F.wave + 2; ++tt) {
                float lg = -__builtin_inff();
                if (F.lane < 32) { float s = b_r[F.lane];
#pragma unroll
                    for (int w = 0; w < 8; ++w) s += xs[(w * 16 + tt) * 32 + F.lane];
                    lg = s; }
                int sel_e[4]; float sel_v[4];
#pragma unroll
                for (int k = 0; k < 4; ++k) { const float m = wave_max(lg); const unsigned long long b = __ballot(lg == m); const int e = __ffsll((long long)b) - 1; sel_e[k] = e; sel_v[k] = m; if (F.lane == e) lg = -__builtin_inff(); }
                const float e1 = __expf(sel_v[1] - sel_v[0]), e2 = __expf(sel_v[2] - sel_v[0]), e3 = __expf(sel_v[3] - sel_v[0]);
                const float inv = 1.0f / (1.0f + e1 + e2 + e3);
                if (F.lane < 4) {
                    const int e = F.lane == 0 ? sel_e[0] : F.lane == 1 ? sel_e[1] : F.lane == 2 ? sel_e[2] : sel_e[3];
                    const float gt = (F.lane == 0 ? 1.0f : F.lane == 1 ? e1 : F.lane == 2 ? e2 : e3) * inv;
                    const int a = (t0 + tt) * 4 + F.lane; a_e[a] = e; a_gate[a] = gt; ue[tt * 4 + F.lane] = e;
                }
            }
            __syncthreads();
            if (F.wave == 0) {
                const int e = ue[F.lane]; int rank = 0, mycount = 0;
#pragma unroll 4
                for (int q = 0; q < NE; ++q) { const unsigned long long mq = __ballot(e == q); if (e == q) rank = __popcll(mq & ((1ull << F.lane) - 1ull)); if (F.lane == q) mycount = __popcll(mq); }
                a_pos[t0 * 4 + F.lane] = rank;
                if (F.lane < NE) hist[unit * NE + F.lane] = mycount;
            }
            __syncthreads();
        }
    }
    SEAM(7);
    LAS int* rt0 = (LAS int*)(F.lds + TAB_OFF);
    LAS int* cntl = (LAS int*)(F.lds + TAB_OFF + 512);
    LAS int* ubase = (LAS int*)(F.lds + TAB_OFF + 768);
    LAS int* part = (LAS int*)(F.lds + TAB_OFF + 1024);
    if (hi > 8 && lo <= 10) {
        { const int e = F.tid & 31, p = F.tid >> 5; int sacc_ = 0;
#pragma unroll 8
          for (int u = 32 * p; u < 32 * p + 32; ++u) sacc_ += hist[u * NE + e];
          part[p * NE + e] = sacc_; }
        __syncthreads();
        if (F.tid < NE) { int c = 0;
#pragma unroll
            for (int p = 0; p < 16; ++p) c += part[p * NE + F.tid];
            cntl[F.tid] = c; }
        __syncthreads();
        if (F.tid == 0) { int a = 0; for (int e = 0; e < NE; ++e) { rt0[e] = a; a += (cntl[e] + 255) >> 8; } rt0[NE] = a; }
        __syncthreads();
    }
    REPS(8) if (IN(8)) {
        if (rep_) xcd_barrier(bar);
        for (int unit = F.vcu; unit < T / 16; unit += F.G) {
            if (F.tid < NE) { int b = 0; const int p0 = unit >> 5;
                for (int p = 0; p < p0; ++p) b += part[p * NE + F.tid];
                for (int u = 32 * p0; u < unit; ++u) b += hist[u * NE + F.tid];
                ubase[F.tid] = b; }
            __syncthreads();
#pragma unroll 1
            for (int j = 0; j < 8; ++j) { const int a = unit * 64 + F.wave * 8 + j; const int e = a_e[a], slot = 256 * rt0[e] + ubase[e] + a_pos[a];
                if (F.lane == 0) a_slot[a] = slot;
                const GAS u32x4* src = (const GAS u32x4*)(H2f + (size_t)(a >> 2) * D) + F.lane; GAS u32x4* dst = (GAS u32x4*)(XG + (size_t)slot * D) + F.lane;
#pragma unroll
                for (int q = 0; q < 2; ++q) dst[64 * q] = src[64 * q]; }
            __syncthreads();
        }
        for (int it = gw; it < NE * 256; it += NGW) { const int e = it >> 8, j = it & 255; const int row = 256 * rt0[e] + cntl[e] + j;
            if (row < 256 * rt0[e + 1]) { GAS u32x4* dst = (GAS u32x4*)(XG + (size_t)row * D) + F.lane;
#pragma unroll
                for (int j2 = 0; j2 < 2; ++j2) dst[64 * j2] = (u32x4){0u, 0u, 0u, 0u}; } }
    }
    SEAM(8);
    if (IN(9)) {
        pg8::Gemm g{(const bf16_t*)XG, (const bf16_t*)WE1, NROWS, NE * 2 * DE, D / 2}; MoeOrder S{rt0, 16, F.G, F.vcu};
        EpiSwiGLU E{ACT, b_ei};
        pg8::gemm_phase<EpiSwiGLU, MoeOrder, true, true, E8_W, E8_X>(F.lds, g, S, E);
        if (MK_REPEAT == 9) {
            xcd_barrier(bar);
            pg8::Gemm g{(const bf16_t*)XG, (const bf16_t*)WE1, NROWS, NE * 2 * DE, D / 2}; MoeOrder S{rt0, 16, F.G, F.vcu};
        EpiSwiGLU E{ACT, b_ei};
        pg8::gemm_phase<EpiSwiGLU, MoeOrder, true, true, E8_W, E8_X>(F.lds, g, S, E);
        }
    }
    SEAM(9);
    if (IN(10)) {
        pg8::Gemm g{(const bf16_t*)ACT, (const bf16_t*)WE2, NROWS, NE * D, DE / 2}; MoeOrder S{rt0, 8, F.G, F.vcu};
        EpiExpOut E{Yb, b_eo};
        pg8::gemm_phase<EpiExpOut, MoeOrder, true, true, E8_W, E8_ACT>(F.lds, g, S, E);
        if (MK_REPEAT == 10) {
            xcd_barrier(bar);
            pg8::Gemm g{(const bf16_t*)ACT, (const bf16_t*)WE2, NROWS, NE * D, DE / 2}; MoeOrder S{rt0, 8, F.G, F.vcu};
        EpiExpOut E{Yb, b_eo};
        pg8::gemm_phase<EpiExpOut, MoeOrder, true, true, E8_W, E8_ACT>(F.lds, g, S, E);
        }
    }
    SEAM(10);
    REPS(11) if (IN(11)) {
        if (rep_) xcd_barrier(bar);
        for (int t = gw; t < T; t += NGW) {
            f32x4 v[8];
#pragma unroll
            for (int j = 0; j < 8; ++j) v[j] = ((const GAS f32x4*)(X1 + (size_t)t * D))[F.lane + 64 * j];
#pragma unroll
            for (int k = 0; k < 4; ++k) { const int s = a_slot[t * 4 + k]; const float gt = a_gate[t * 4 + k]; const GAS u32x2* yr = (const GAS u32x2*)(Yb + (size_t)s * D) + F.lane;
#pragma unroll
                for (int j = 0; j < 8; ++j) { const u32x2 w = yr[64 * j]; v[j][0] += gt * bflo(w.x); v[j][1] += gt * bfhi(w.x); v[j][2] += gt * bflo(w.y); v[j][3] += gt * bfhi(w.y); } }
            float ss = 0.f;
#pragma unroll
            for (int j = 0; j < 8; ++j) ss += (v[j][0] * v[j][0] + v[j][1] * v[j][1]) + (v[j][2] * v[j][2] + v[j][3] * v[j][3]);
            const float rs = rsqrtf(wave_sum(ss) * (1.0f / D) + EPS);
            GAS f32x4* o = (GAS f32x4*)(args.out + (size_t)t * D);
#pragma unroll
            for (int j = 0; j < 8; ++j) { const f32x4 gg = ((const GAS f32x4*)nfg)[F.lane + 64 * j]; o[F.lane + 64 * j] = v[j] * rs * gg; }
        }
    }
#undef IN
#undef SEAM
}
constexpr int N_PHASES = 12;
}

#ifndef MK_CUTS
#define MK_CUTS 0
#endif
extern "C" void kernel_launch(void* const* d_in, const int* in_sizes, int n_in, void* d_out, int out_size, void* d_ws, size_t ws_size, hipStream_t stream) {
    using namespace mk;
    static int grid = 0;
    if (grid == 0) {
        int dev = 0, cus = 0;
        if (hipGetDevice(&dev) != hipSuccess || hipDeviceGetAttribute(&cus, hipDeviceAttributeMultiprocessorCount, dev) != hipSuccess) { grid = -1; return; }
        if (hipFuncSetAttribute((const void*)mk_fwd, hipFuncAttributeMaxDynamicSharedMemorySize, LDS_BYTES) != hipSuccess) { grid = -1; return; }
        int per_cu = 0;
        if (hipOccupancyMaxActiveBlocksPerMultiprocessor(&per_cu, (const void*)mk_fwd, NWAVES * 64, LDS_BYTES) != hipSuccess || per_cu < 1) { fprintf(stderr, "kernel_launch: occupancy query says %d\n", per_cu); }
        (void)hipGetLastError();
        grid = cus;
    }
    if (grid < 0) return;
    (void)hipMemsetAsync((char*)d_ws + WS_CTL, 0, CTL_ZERO_BYTES, stream);
    Args a{};
    for (int i = 0; i < 20; ++i) a.in[i] = (const float*)d_in[i];
    a.out = (float*)d_out; a.ws = (unsigned char*)d_ws;
#if MK_CUTS == 0
    a.ph_lo = 0; a.ph_hi = N_PHASES; a.li = 0; a.pad = 0;
    hipLaunchKernelGGL(mk_fwd, dim3(grid), dim3(NWAVES * 64), LDS_BYTES, stream, a);
#else
    for (int p = 0; p < N_PHASES; ++p) { a.ph_lo = p; a.ph_hi = p + 1; a.li = 0; a.pad = 0; hipLaunchKernelGGL(mk_fwd, dim3(grid), dim3(NWAVES * 64), LDS_BYTES, stream, a); }
#endif
}
```

```cpp
#include <hip/hip_runtime.h>
#include <cstdio>
#include <cstdint>
namespace pg8 {
#define PG8_LAS __attribute__((address_space(3)))
typedef unsigned short bf16_t;
typedef short bf16x8 __attribute__((ext_vector_type(8)));
typedef float f32x4 __attribute__((ext_vector_type(4)));
typedef unsigned u32x4 __attribute__((ext_vector_type(4)));
typedef int pg8_v4i __attribute__((ext_vector_type(4)));
constexpr int BM = 256, BK = 64, HALF = 128, HTB = HALF * BK * 2  , STAGE_BYTES = 8 * HTB, NXCD = 8, WGM = 8;

__host__ __device__ __forceinline__ int lds_byte(int r, int c) { const int st = (r >> 4) * 2 + (c >> 5), rr = r & 15, cc = c & 31, ob = rr * 64 + cc * 2; return st * 1024 + (ob ^ (((ob >> 9) & 1) << 5)); }
__host__ __device__ __forceinline__ void stage_rc(int b, int& R, int& C) { const int st = b / 1024, sb = b % 1024, swz = sb ^ (((sb >> 9) & 1) << 5); R = (st >> 1) * 16 + swz / 64; C = (st & 1) * 32 + (swz % 64) / 2; }
__host__ __device__ __forceinline__ int perm32(int rho) { const int n = rho >> 4, i = rho & 15; return 8 * (i >> 2) + 4 * n + (i & 3); }

struct Unit { int pm, pn; };
struct Gemm { const bf16_t* A; const bf16_t* Bt; int M, N, K; };

struct StaticOrder {
    int nM, nN, nwg, G, c;
    __host__ __device__ void init(int M, int N, int G_, int c_) { nM = M / BM; nN = N / BM; nwg = nM * nN; G = G_; c = c_; }
    __host__ __device__ bool next(int i, Unit& u) const {
        const long L = (long)i * G + c; if (L >= nwg) return false;
        int wgid = (int)L; { const int q = nwg / NXCD, r = nwg % NXCD, xcd = wgid % NXCD, off = wgid / NXCD; wgid = (xcd < r ? xcd * (q + 1) : r * (q + 1) + (xcd - r) * q) + off; }
        const int nig = WGM * nN, gid = wgid / nig, fm = gid * WGM, gsz = (nM - fm) < WGM ? (nM - fm) : WGM;
        u.pm = fm + ((wgid % nig) % gsz); u.pn = (wgid % nig) / gsz; return true;
    }
    __device__ __forceinline__ void a_ready(const Unit&) const {}
    __device__ __forceinline__ void done(const Unit&) const {}
};

__device__ __forceinline__ unsigned cvt_pk_bf16(float lo, float hi) { unsigned r; asm volatile("v_cvt_pk_bf16_f32 %0, %1, %2" : "=v"(r) : "v"(lo), "v"(hi)); return r; }
template <class Epi, class Sched, bool ALIGN_EPI = false, bool SP2 = false, int F8W = 0, int F8X = 0>
__device__ __forceinline__ void gemm_phase(PG8_LAS unsigned char* lds, const Gemm g, const Sched& S, const Epi& E) {
    const int tid = threadIdx.x, wid = __builtin_amdgcn_readfirstlane(tid >> 6), lane = tid & 63, wr = wid >> 2, wc = wid & 3, fr = lane & 15, fq = lane >> 4;
    const int K = g.K, nt = K / BK;
    int f8w_ = F8W, f8x_ = F8X; asm volatile("" : "+v"(f8w_), "+v"(f8x_));
    unsigned voffA[2], voffB[2];
#pragma unroll
    for (int i = 0; i < 2; ++i) { int R, C; stage_rc(tid * 16 + i * 8192, R, C); const int Rb = Epi::PERM ? ((R & ~31) + perm32(R & 31)) : R;
        voffA[i] = (unsigned)(R * K + C) * 2u; voffB[i] = (unsigned)(Rb * K + C) * 2u; }
    const size_t kstep = (size_t)(BK * 2);
    const size_t hstep = (size_t)HALF * K * 2;
    const size_t tstep = 2 * hstep;
    const unsigned ldsw = (unsigned)wid * 1024u;
    const int aoff = lds_byte(wr * 64 + fr, fq * 8), boff = lds_byte(wc * 32 + fr, fq * 8);
#define PG8_SA(b, h) (((b) * 2 + (h)) * HTB)
#define PG8_SB(b, h) ((4 + (b) * 2 + (h)) * HTB)
#define PG8_STAGE(bufoff, gbase, voff) do { _Pragma("unroll") for (int _i = 0; _i < 2; ++_i) \
        __builtin_amdgcn_global_load_lds((const unsigned*)((const char*)(gbase) + (voff)[_i]), (PG8_LAS unsigned*)(lds + (bufoff) + ldsw + _i * 8192), 16, 0, 0); } while (0)
#define PG8_LDA(dst, b, h) do { _Pragma("unroll") for (int m = 0; m < 4; ++m) _Pragma("unroll") for (int k = 0; k < 2; ++k) dst[m][k] = *(const PG8_LAS bf16x8*)(lds + PG8_SA(b, h) + aoff + m * 2048 + k * 1024); } while (0)
#define PG8_LDB(dst, b, h) do { _Pragma("unroll") for (int n = 0; n < 2; ++n) _Pragma("unroll") for (int k = 0; k < 2; ++k) dst[n][k] = *(const PG8_LAS bf16x8*)(lds + PG8_SB(b, h) + boff + n * 2048 + k * 1024); } while (0)
#define PG8_CAT8(lo, hi) __builtin_shufflevector(__builtin_bit_cast(pg8_v4i, lo), __builtin_bit_cast(pg8_v4i, hi), 0, 1, 2, 3, 4, 5, 6, 7)
#define PG8_MMA(ai, bj, At, Bt) do { __builtin_amdgcn_s_setprio(1); if constexpr (F8W != 0) { _Pragma("unroll") for (int m = 0; m < 4; ++m) _Pragma("unroll") for (int n = 0; n < 2; ++n) \
        asm volatile("v_mfma_scale_f32_16x16x128_f8f6f4 %0, %1, %2, %0, %3, %4 op_sel_hi:[0,0,0]" : "+v"(acc[ai][bj][m][n]) : "v"(PG8_CAT8(Bt[n][0], Bt[n][1])), "v"(PG8_CAT8(At[m][0], At[m][1])), "v"(f8w_), "v"(f8x_)); } else { \
        _Pragma("unroll") for (int m = 0; m < 4; ++m) _Pragma("unroll") for (int n = 0; n < 2; ++n) _Pragma("unroll") for (int k = 0; k < 2; ++k) \
        acc[ai][bj][m][n] = __builtin_amdgcn_mfma_f32_16x16x32_bf16(Bt[n][k], At[m][k], acc[ai][bj][m][n], 0, 0, 0); } __builtin_amdgcn_s_setprio(0); } while (0)
#define PG8_WAIT_V(n) asm volatile("s_waitcnt vmcnt(" #n ")" ::: "memory")
#define PG8_WAIT_L(n) asm volatile("s_waitcnt lgkmcnt(" #n ")" ::: "memory")
#define PG8_BAR __builtin_amdgcn_s_barrier()
#define PG8_SCHED __builtin_amdgcn_sched_barrier(0)
    Unit cur, nxt; int ui = 0;
    if (!S.next(0, cur)) return;
    f32x4 acc[2][2][4][2];
#pragma unroll
    for (int a = 0; a < 2; ++a)
#pragma unroll
        for (int b = 0; b < 2; ++b)
#pragma unroll
            for (int m = 0; m < 4; ++m)
#pragma unroll
                for (int n = 0; n < 2; ++n) acc[a][b][m][n] = (f32x4){0.f, 0.f, 0.f, 0.f};
    bf16x8 At[4][2], B0[2][2], B1[2][2];
    const char* cA = (const char*)g.A + (size_t)cur.pm * tstep; const char* cB = (const char*)g.Bt + (size_t)cur.pn * tstep;
    S.a_ready(cur);
    if constexpr (SP2) {
        PG8_STAGE(PG8_SB(0, 0), cB, voffB); PG8_STAGE(PG8_SB(0, 1), cB + hstep, voffB); PG8_STAGE(PG8_SA(0, 0), cA, voffA); PG8_STAGE(PG8_SA(0, 1), cA + hstep, voffA);
        if (wr == 1) PG8_BAR;
        PG8_WAIT_V(2); PG8_BAR;
        PG8_STAGE(PG8_SB(1, 0), cB + kstep, voffB); PG8_STAGE(PG8_SA(1, 0), cA + kstep, voffA); PG8_STAGE(PG8_SB(1, 1), cB + hstep + kstep, voffB);
        PG8_WAIT_V(6); PG8_BAR;
    } else {
        PG8_STAGE(PG8_SB(0, 0), cB, voffB); PG8_STAGE(PG8_SA(0, 0), cA, voffA); PG8_STAGE(PG8_SB(0, 1), cB + hstep, voffB); PG8_STAGE(PG8_SA(0, 1), cA + hstep, voffA);
        if (wr == 1) PG8_BAR;
        PG8_WAIT_V(4); PG8_BAR;
        PG8_STAGE(PG8_SB(1, 0), cB + kstep, voffB); PG8_STAGE(PG8_SA(1, 0), cA + kstep, voffA); PG8_STAGE(PG8_SB(1, 1), cB + hstep + kstep, voffB);
        PG8_WAIT_V(6); PG8_BAR;
    }
    for (;;) {
        const bool has_next = S.next(ui + 1, nxt);
        const char* nA = has_next ? (const char*)g.A + (size_t)nxt.pm * tstep : cA; const char* nB = has_next ? (const char*)g.Bt + (size_t)nxt.pn * tstep : cB;
        for (int t = 0; t < nt; t += 2) {
            const bool last = (t == nt - 2);
            const char* a1 = cA + (size_t)(t + 1) * kstep;
            const char* a2 = last ? nA : cA + (size_t)(t + 2) * kstep; const char* b2 = last ? nB : cB + (size_t)(t + 2) * kstep;
            const char* a3 = a2 + kstep; const char* b3 = b2 + kstep;
            if (last && has_next) S.a_ready(nxt);
            if constexpr (SP2) {
            PG8_LDB(B0, 0, 0); PG8_LDB(B1, 0, 1); PG8_SCHED; PG8_LDA(At, 0, 0); PG8_STAGE(PG8_SA(1, 1), a1 + hstep, voffA);
            PG8_WAIT_V(8); PG8_WAIT_L(0); PG8_BAR; PG8_MMA(0, 0, At, B0); PG8_MMA(0, 1, At, B1); PG8_BAR; PG8_SCHED;
            PG8_LDA(At, 0, 1); PG8_STAGE(PG8_SB(0, 0), b2, voffB); PG8_STAGE(PG8_SB(0, 1), b2 + hstep, voffB); PG8_STAGE(PG8_SA(0, 0), a2, voffA);
            PG8_WAIT_V(8); PG8_WAIT_L(0); PG8_BAR; PG8_MMA(1, 0, At, B0); PG8_MMA(1, 1, At, B1); PG8_BAR; PG8_SCHED;
            PG8_LDB(B0, 1, 0); PG8_LDB(B1, 1, 1); PG8_SCHED; PG8_LDA(At, 1, 0); PG8_STAGE(PG8_SA(0, 1), a2 + hstep, voffA);
            PG8_WAIT_V(8); PG8_WAIT_L(0); PG8_BAR; PG8_MMA(0, 0, At, B0); PG8_MMA(0, 1, At, B1); PG8_BAR; PG8_SCHED;
            PG8_LDA(At, 1, 1); PG8_STAGE(PG8_SB(1, 0), b3, voffB); PG8_STAGE(PG8_SB(1, 1), b3 + hstep, voffB); PG8_STAGE(PG8_SA(1, 0), a3, voffA);
            PG8_WAIT_V(8); PG8_WAIT_L(0); PG8_BAR; PG8_MMA(1, 0, At, B0); PG8_MMA(1, 1, At, B1); PG8_BAR; PG8_SCHED;
            } else {
            PG8_LDB(B0, 0, 0); PG8_SCHED; PG8_LDA(At, 0, 0); PG8_STAGE(PG8_SA(1, 1), a1 + hstep, voffA);
            PG8_WAIT_L(8); PG8_BAR; PG8_WAIT_L(0); PG8_MMA(0, 0, At, B0); PG8_BAR; PG8_SCHED;
            PG8_LDB(B1, 0, 1); PG8_STAGE(PG8_SB(0, 0), b2, voffB);
            PG8_BAR; PG8_WAIT_L(0); PG8_MMA(0, 1, At, B1); PG8_BAR;
            PG8_LDA(At, 0, 1); PG8_STAGE(PG8_SA(0, 0), a2, voffA);
            PG8_BAR; PG8_WAIT_L(0); PG8_MMA(1, 0, At, B0); PG8_BAR; PG8_SCHED;
            PG8_STAGE(PG8_SB(0, 1), b2 + hstep, voffB);
            PG8_WAIT_V(6); PG8_BAR; PG8_MMA(1, 1, At, B1); PG8_BAR;
            PG8_LDB(B0, 1, 0); PG8_SCHED; PG8_LDA(At, 1, 0); PG8_STAGE(PG8_SA(0, 1), a2 + hstep, voffA);
            PG8_WAIT_L(8); PG8_BAR; PG8_WAIT_L(0); PG8_MMA(0, 0, At, B0); PG8_BAR; PG8_SCHED;
            PG8_LDB(B1, 1, 1); PG8_STAGE(PG8_SB(1, 0), b3, voffB);
            PG8_BAR; PG8_WAIT_L(0); PG8_MMA(0, 1, At, B1); PG8_BAR;
            PG8_LDA(At, 1, 1); PG8_STAGE(PG8_SA(1, 0), a3, voffA);
            PG8_BAR; PG8_WAIT_L(0); PG8_MMA(1, 0, At, B0); PG8_BAR; PG8_SCHED;
            PG8_STAGE(PG8_SB(1, 1), b3 + hstep, voffB);
            PG8_WAIT_V(6); PG8_BAR; PG8_MMA(1, 1, At, B1); PG8_BAR;
            }
        }
        if constexpr (F8W != 0) asm volatile("s_nop 15\n\ts_nop 15" ::: "memory");
        if constexpr (ALIGN_EPI) { if (wr == 0) PG8_BAR; }
        if constexpr (!Epi::AFTER_DRAIN) { E(acc, cur, wr, wc, fr, fq); S.done(cur); }
        if (!has_next) break;
#pragma unroll
        for (int a = 0; a < 2; ++a)
#pragma unroll
            for (int b = 0; b < 2; ++b)
#pragma unroll
                for (int m = 0; m < 4; ++m)
#pragma unroll
                    for (int n = 0; n < 2; ++n) acc[a][b][m][n] = (f32x4){0.f, 0.f, 0.f, 0.f};
        cur = nxt; cA = nA; cB = nB; ++ui;
        if constexpr (ALIGN_EPI) { if (wr == 1) PG8_BAR; }
    }
    PG8_WAIT_V(0);
    if constexpr (!ALIGN_EPI) { if (wr == 0) PG8_BAR; }
    PG8_BAR;
    if constexpr (Epi::AFTER_DRAIN) { E.fused(acc, cur, wr, wc, fr, fq, lds, wid, lane); S.done(cur); }
#undef PG8_SA
#undef PG8_SB
#undef PG8_STAGE
#undef PG8_LDA
#undef PG8_LDB
#undef PG8_MMA
#undef PG8_CAT8
#undef PG8_WAIT_V
#undef PG8_WAIT_L
#undef PG8_BAR
#undef PG8_SCHED
}
}
#define GAS __attribute__((address_space(1)))
#define LAS __attribute__((address_space(3)))
namespace mk {
using pg8::bf16_t; using pg8::bf16x8; using pg8::f32x4; using pg8::u32x4; using pg8::Unit; using pg8::cvt_pk_bf16;
typedef float f32x16 __attribute__((ext_vector_type(16)));
typedef float f32x2 __attribute__((ext_vector_type(2)));
typedef unsigned u32x2 __attribute__((ext_vector_type(2)));
typedef GAS unsigned gu32;
typedef __bf16 bf16x2_t __attribute__((ext_vector_type(2)));
__device__ __forceinline__ unsigned cvt_pk(float lo, float hi) { f32x2 v = {lo, hi}; bf16x2_t b = __builtin_convertvector(v, bf16x2_t); return __builtin_bit_cast(unsigned, b); }
#define RLX_AGENT __ATOMIC_RELAXED, __HIP_MEMORY_SCOPE_AGENT
#define LDS_WAIT() asm volatile("s_waitcnt lgkmcnt(0)" ::: "memory")
#define VM_WAIT() asm volatile("s_waitcnt vmcnt(0)" ::: "memory")

constexpr int T = 8192, D = 2048, DIN = 10752, DC = 1024, NH = 12, HD = 128, AW = 1536, AO = 512, NE = 32, DE = 2048, TOPK = 4;
constexpr float EPS = 1e-5f;
constexpr float QSCALE = 0.12751743082459868f;
constexpr float LN2 = 0.6931471805599453f;
constexpr int MAXRT = 160, NROWS = MAXRT * 256;
constexpr int NWAVES = 8;

constexpr size_t MiB = 1u << 20;
constexpr size_t WS_CTL = 0, CTL_ZERO_BYTES = 64 * 1024;
constexpr size_t WS_WIN = 1 * MiB;
constexpr size_t WS_WCO = 43 * MiB;
constexpr size_t WS_WAO = 47 * MiB;
constexpr size_t WS_WOUT = 49 * MiB;
constexpr size_t WS_WE1 = 57 * MiB;
constexpr size_t WS_WE2 = 569 * MiB;
constexpr size_t WS_H = 825 * MiB;
constexpr size_t WS_U = 857 * MiB;
constexpr size_t WS_Q = 873 * MiB, WS_K = 897 * MiB, WS_V = 921 * MiB;
constexpr size_t WS_GATE = 945 * MiB;
constexpr size_t WS_UC = 1009 * MiB;
constexpr size_t WS_OG = 1025 * MiB;
constexpr size_t WS_LSE = 1073 * MiB;
constexpr size_t WS_OC = 1074 * MiB;
constexpr size_t WS_M1 = 1082 * MiB;
constexpr size_t WS_MG = 1146 * MiB;
constexpr size_t WS_X1 = 1178 * MiB;
constexpr size_t WS_H2 = 1242 * MiB;
constexpr size_t WS_AE = 1274 * MiB, WS_APOS = 1275 * MiB, WS_AGATE = 1276 * MiB, WS_ASLOT = 1277 * MiB;
constexpr size_t WS_HIST = WS_ASLOT + 512 * 1024;
constexpr size_t WS_XG = 1278 * MiB;
constexpr size_t WS_ACT = 1438 * MiB;
constexpr size_t WS_Y = 1598 * MiB;
constexpr size_t WS_END = 1758 * MiB;
constexpr int CW_CNT = 64;
constexpr int CW_BAR = 4096;

constexpr int RING_BYTES = 131072;
constexpr int LDSCTL_OFF = RING_BYTES, MISC_OFF = LDSCTL_OFF + 320, TAB_OFF = LDSCTL_OFF + 1024;
constexpr int LDS_BYTES = 147456;

__device__ __forceinline__ unsigned f2bf(float f) { unsigned u = __builtin_bit_cast(unsigned, f); return (u + 0x7fffu + ((u >> 16) & 1u)) >> 16; }
__device__ __forceinline__ unsigned pk2(float lo, float hi) { return f2bf(lo) | (f2bf(hi) << 16); }
__device__ __forceinline__ float bflo(unsigned w) { return __builtin_bit_cast(float, w << 16); }
__device__ __forceinline__ float bfhi(unsigned w) { return __builtin_bit_cast(float, w & 0xffff0000u); }
__device__ __forceinline__ unsigned pk4_fp8(float a, float b, float c, float d) { int w = __builtin_amdgcn_cvt_pk_fp8_f32(a, b, 0, false); w = __builtin_amdgcn_cvt_pk_fp8_f32(c, d, w, true); return (unsigned)w; }
constexpr float S_W = 128.0f, S_X = 16.0f, S_ACT = 4.0f;
constexpr int E8_W = 127 - 7, E8_X = 127 - 4, E8_ACT = 127 - 2;
__device__ __forceinline__ float sigm(float x) { return __builtin_amdgcn_rcpf(1.0f + __expf(-x)); }
__device__ __forceinline__ float wave_sum(float v) {
#pragma unroll
    for (int o = 1; o < 64; o <<= 1) v += __shfl_xor(v, o);
    return v;
}
__device__ __forceinline__ float wave_max(float v) {
#pragma unroll
    for (int o = 1; o < 64; o <<= 1) v = fmaxf(v, __shfl_xor(v, o));
    return v;
}

struct EpiProj {
    static constexpr bool PERM = true, AFTER_DRAIN = false;
    bf16_t *U, *Q, *G; const float* bgate;
    __device__ __forceinline__ void operator()(const f32x4 (&acc)[2][2][4][2], const Unit& u, int wr, int wc, int fr, int fq) const {
        const int row0 = u.pm * 256 + wr * 64 + fr, cl = wc * 32 + 8 * fq;
        if (u.pn < 8) {
#pragma unroll
            for (int ai = 0; ai < 2; ++ai)
#pragma unroll
                for (int m = 0; m < 4; ++m) {
                    const f32x4 a0 = acc[ai][0][m][0], a1 = acc[ai][0][m][1], g0 = acc[ai][1][m][0], g1 = acc[ai][1][m][1];
                    u32x4 w; w.x = cvt_pk(a0[0] * sigm(g0[0]), a0[1] * sigm(g0[1])); w.y = cvt_pk(a0[2] * sigm(g0[2]), a0[3] * sigm(g0[3]));
                    w.z = cvt_pk(a1[0] * sigm(g1[0]), a1[1] * sigm(g1[1])); w.w = cvt_pk(a1[2] * sigm(g1[2]), a1[3] * sigm(g1[3]));
                    *(u32x4*)(U + (size_t)(row0 + ai * 128 + m * 16) * DC + u.pn * 128 + cl) = w; }
        } else if (u.pn < 26) {
            const int s = (u.pn - 8) / 6, pl = (u.pn - 8) % 6; bf16_t* base = Q + (size_t)s * ((WS_K - WS_Q) / 2); const float sc = (s == 0) ? QSCALE : 1.0f;
#pragma unroll
            for (int ai = 0; ai < 2; ++ai)
#pragma unroll
                for (int m = 0; m < 4; ++m) { bf16_t* rowp = base + (size_t)(row0 + ai * 128 + m * 16) * AW + pl * 256 + cl;
#pragma unroll
                    for (int bj = 0; bj < 2; ++bj) { const f32x4 v0 = acc[ai][bj][m][0] * sc, v1 = acc[ai][bj][m][1] * sc;
                        u32x4 w; w.x = cvt_pk(v0[0], v0[1]); w.y = cvt_pk(v0[2], v0[3]); w.z = cvt_pk(v1[0], v1[1]); w.w = cvt_pk(v1[2], v1[3]);
                        *(u32x4*)(rowp + bj * 128) = w; } }
        } else {
            const int c0 = (u.pn - 26) * 256 + cl;
            f32x4 bv[2][2];
#pragma unroll
            for (int bj = 0; bj < 2; ++bj)
#pragma unroll
                for (int n = 0; n < 2; ++n) bv[bj][n] = *(const f32x4*)(bgate + c0 + bj * 128 + 4 * n);
#pragma unroll
            for (int ai = 0; ai < 2; ++ai)
#pragma unroll
                for (int m = 0; m < 4; ++m) { bf16_t* rowp = G + (size_t)(row0 + ai * 128 + m * 16) * (2 * D) + c0;
#pragma unroll
                    for (int bj = 0; bj < 2; ++bj) { const f32x4 v0 = acc[ai][bj][m][0] + bv[bj][0], v1 = acc[ai][bj][m][1] + bv[bj][1];
                        u32x4 w; w.x = cvt_pk(sigm(v0[0]), sigm(v0[1])); w.y = cvt_pk(sigm(v0[2]), sigm(v0[3])); w.z = cvt_pk(sigm(v1[0]), sigm(v1[1])); w.w = cvt_pk(sigm(v1[2]), sigm(v1[3]));
                        *(u32x4*)(rowp + bj * 128) = w; } }
        }
    }
};
struct EpiConvOut {
    static constexpr bool PERM = false, AFTER_DRAIN = false;
    float* M1; const bf16_t* G; const float* bco;
    __device__ __forceinline__ void operator()(const f32x4 (&acc)[2][2][4][2], const Unit& u, int wr, int wc, int fr, int fq) const {
        const int row0 = u.pm * 256 + wr * 64 + fr, col0 = u.pn * 256 + wc * 32 + 4 * fq;
        f32x4 bv[2][2];
#pragma unroll
        for (int bj = 0; bj < 2; ++bj)
#pragma unroll
            for (int n = 0; n < 2; ++n) bv[bj][n] = *(const f32x4*)(bco + col0 + bj * 128 + n * 16);
#pragma unroll
        for (int ai = 0; ai < 2; ++ai)
#pragma unroll
            for (int m = 0; m < 4; ++m) { const size_t row = (size_t)(row0 + ai * 128 + m * 16);
#pragma unroll
                for (int bj = 0; bj < 2; ++bj)
#pragma unroll
                    for (int n = 0; n < 2; ++n) { const int col = col0 + bj * 128 + n * 16;
                        const u32x2 gw = *(const u32x2*)(G + row * (2 * D) + col); const f32x4 v = acc[ai][bj][m][n] + bv[bj][n];
                        f32x4 o; o[0] = bflo(gw.x) * v[0]; o[1] = bfhi(gw.x) * v[1]; o[2] = bflo(gw.y) * v[2]; o[3] = bfhi(gw.y) * v[3];
                        *(f32x4*)(M1 + row * D + col) = o; } }
    }
};
struct EpiAttnOut {
    static constexpr bool PERM = false, AFTER_DRAIN = false;
    const float* M1; const bf16_t* G; bf16_t* MG;
    __device__ __forceinline__ void operator()(const f32x4 (&acc)[2][2][4][2], const Unit& u, int wr, int wc, int fr, int fq) const {
        const int row0 = u.pm * 256 + wr * 64 + fr, col0 = u.pn * 256 + wc * 32 + 4 * fq;
#pragma unroll
        for (int ai = 0; ai < 2; ++ai)
#pragma unroll
            for (int m = 0; m < 4; ++m) { const size_t row = (size_t)(row0 + ai * 128 + m * 16);
#pragma unroll
                for (int bj = 0; bj < 2; ++bj)
#pragma unroll
                    for (int n = 0; n < 2; ++n) { const int col = col0 + bj * 128 + n * 16;
                        const u32x2 gw = *(const u32x2*)(G + row * (2 * D) + D + col); const f32x4 v = acc[ai][bj][m][n]; const f32x4 m1 = *(const f32x4*)(M1 + row * D + col);
                        u32x2 w; w.x = cvt_pk(m1[0] + bflo(gw.x) * v[0], m1[1] + bfhi(gw.x) * v[1]); w.y = cvt_pk(m1[2] + bflo(gw.y) * v[2], m1[3] + bfhi(gw.y) * v[3]);
                        *(u32x2*)(MG + row * D + col) = w; } }
    }
};
struct EpiResid {
    static constexpr bool PERM = false, AFTER_DRAIN = false;
    const float* X; float* X1;
    __device__ __forceinline__ void operator()(const f32x4 (&acc)[2][2][4][2], const Unit& u, int wr, int wc, int fr, int fq) const {
        const int row0 = u.pm * 256 + wr * 64 + fr, col0 = u.pn * 256 + wc * 32 + 4 * fq;
#pragma unroll
        for (int ai = 0; ai < 2; ++ai)
#pragma unroll
            for (int m = 0; m < 4; ++m) { const size_t off = (size_t)(row0 + ai * 128 + m * 16) * D + col0;
#pragma unroll
                for (int bj = 0; bj < 2; ++bj)
#pragma unroll
                    for (int n = 0; n < 2; ++n) { const f32x4 xv = *(const f32x4*)(X + off + bj * 128 + n * 16); *(f32x4*)(X1 + off + bj * 128 + n * 16) = xv + acc[ai][bj][m][n]; } }
    }
};
struct EpiSwiGLU {
    static constexpr bool PERM = true, AFTER_DRAIN = false;
    unsigned char* ACT; const float* bin;
    __device__ __forceinline__ void operator()(const f32x4 (&acc)[2][2][4][2], const Unit& u, int wr, int wc, int fr, int fq) const {
        const int e = u.pn >> 4, pl = u.pn & 15;
        const int row0 = u.pm * 256 + wr * 64 + fr, cl = pl * 128 + wc * 32 + 8 * fq;
        f32x4 bg[2], bu[2];
#pragma unroll
        for (int n = 0; n < 2; ++n) { bg[n] = *(const f32x4*)(bin + (size_t)e * (2 * DE) + cl + 4 * n); bu[n] = *(const f32x4*)(bin + (size_t)e * (2 * DE) + DE + cl + 4 * n); }
#pragma unroll
        for (int ai = 0; ai < 2; ++ai)
#pragma unroll
            for (int m = 0; m < 4; ++m) {
                float o[8];
#pragma unroll
                for (int n = 0; n < 2; ++n) { const f32x4 gv = acc[ai][0][m][n] + bg[n], uv = acc[ai][1][m][n] + bu[n];
#pragma unroll
                    for (int q = 0; q < 4; ++q) { const float gg = fminf(gv[q], 7.0f), uu = fminf(fmaxf(uv[q], -7.0f), 7.0f); o[4 * n + q] = (uu + 1.0f) * (gg * sigm(1.702f * gg)); } }
                u32x2 w; w.x = pk4_fp8(o[0] * S_ACT, o[1] * S_ACT, o[2] * S_ACT, o[3] * S_ACT); w.y = pk4_fp8(o[4] * S_ACT, o[5] * S_ACT, o[6] * S_ACT, o[7] * S_ACT);
                *(u32x2*)(ACT + (size_t)(row0 + ai * 128 + m * 16) * DE + cl) = w; }
    }
};
template <int VAR = 0> struct EpiExpOutT {
    static constexpr bool PERM = true, AFTER_DRAIN = false;
    bf16_t* Y; const float* bout;
    __device__ __forceinline__ void operator()(const f32x4 (&acc)[2][2][4][2], const Unit& u, int wr, int wc, int fr, int fq) const {
        const int e = u.pn >> 3, pl = u.pn & 7;
        const int row0 = u.pm * 256 + wr * 64 + fr, c0 = pl * 256 + wc * 32 + 8 * fq;
        f32x4 bv[2][2];
#pragma unroll
        for (int bj = 0; bj < 2; ++bj)
#pragma unroll
            for (int n = 0; n < 2; ++n) bv[bj][n] = (VAR == 1) ? (f32x4){0.f, 0.f, 0.f, 0.f} : *(const f32x4*)(bout + (size_t)e * D + c0 + bj * 128 + 4 * n);
#pragma unroll
        for (int ai = 0; ai < 2; ++ai)
#pragma unroll
            for (int m = 0; m < 4; ++m) { bf16_t* rowp = Y + (size_t)(row0 + ai * 128 + m * 16) * D + c0;
#pragma unroll
                for (int bj = 0; bj < 2; ++bj) { const f32x4 v0 = acc[ai][bj][m][0] + bv[bj][0], v1 = acc[ai][bj][m][1] + bv[bj][1];
                    u32x4 w; w.x = cvt_pk(v0[0], v0[1]); w.y = cvt_pk(v0[2], v0[3]); w.z = cvt_pk(v1[0], v1[1]); w.w = cvt_pk(v1[2], v1[3]);
                    if (VAR == 2) asm volatile("" :: "v"(w)); else *(u32x4*)(rowp + bj * 128) = w; } }
    }
};
typedef EpiExpOutT<0> EpiExpOut;

struct EpiNull { static constexpr bool PERM = true, AFTER_DRAIN = false; __device__ __forceinline__ void operator()(const f32x4 (&acc)[2][2][4][2], const Unit& u, int wr, int wc, int fr, int fq) const {} };
struct MoeOrder {
    const LAS unsigned* tab; int total, G, c;
    __device__ __forceinline__ bool next(int i, Unit& u) const {
        const int L = i * G + c; if (L >= total) return false;
        const unsigned w = tab[L];
        u.pn = __builtin_amdgcn_readfirstlane((int)(w >> 16)); u.pm = __builtin_amdgcn_readfirstlane((int)(w & 0xffffu)); return true;
    }
    __device__ __forceinline__ void a_ready(const Unit&) const {}
    __device__ __forceinline__ void done(const Unit&) const {}
};
__device__ __forceinline__ int moe_build_tab(LAS unsigned* tab, LAS int* myexp, const LAS int* rt0, int NT, int tid, int myx, int NX) {
    if (tid < NE) { const int mte = rt0[tid + 1] - rt0[tid]; int rank = 0;
        for (int q = 0; q < NE; ++q) { const int mq = rt0[q + 1] - rt0[q]; rank += (mq > mte || (mq == mte && q < tid)) ? 1 : 0; }
        const int row = rank / NX, col = rank % NX, x = (row & 1) ? (NX - 1 - col) : col;
        if (x == myx) myexp[row] = tid; }
    __syncthreads();
    const int nmy = NE / NX; int total = 0;
    for (int j = 0; j < nmy; ++j) { const int e = myexp[j]; total += (rt0[e + 1] - rt0[e]) * NT; }
    for (int L = tid; L < total; L += NWAVES * 64) { int base = 0, e = myexp[0];
        for (int j = 0; j < nmy; ++j) { const int ej = myexp[j], uj = (rt0[ej + 1] - rt0[ej]) * NT; if (L >= base + uj) { base += uj; } else { e = ej; break; } }
        const int b = rt0[e], mt = rt0[e + 1] - b, idx = L - base;
        tab[L] = ((unsigned)(e * NT + idx / mt) << 16) | (unsigned)(b + idx % mt); }
    __syncthreads();
    return total;
}

#define XB_TMO      128
#define XB_XCNT(j)  (256  + 64 * (j))
#define XB_XSUB(j)  (1280 + 64 * (j))
#define XB_XGEN(j)  (2304 + 64 * (j))
#define XB_TOP      3328
#define XB_TOPGEN   3392
#define XCD_BAR_WORDS 3456
#define XB_SPIN_CAP (1u << 18)

__device__ __forceinline__ unsigned xb_ld(unsigned* p)              { return __hip_atomic_load(p, __ATOMIC_RELAXED, __HIP_MEMORY_SCOPE_AGENT); }
__device__ __forceinline__ unsigned xb_add(unsigned* p, unsigned v) { return __hip_atomic_fetch_add(p, v, __ATOMIC_RELAXED, __HIP_MEMORY_SCOPE_AGENT); }
__device__ __forceinline__ unsigned xb_xcc_id() { return (unsigned)__builtin_amdgcn_s_getreg((3 << 11) | 20) & 0xFu; }
#define XB_SPIN(cond, bar) do { unsigned _sp = 0; while (cond) { __builtin_amdgcn_s_sleep(1); \
    if ((++_sp & 255u) == 0u) { if (xb_ld(&(bar)[XB_TMO])) break; if (_sp > XB_SPIN_CAP) { atomicAdd(&(bar)[XB_TMO], 1u); break; } } } } while (0)

struct XcdBarrier {
    unsigned* bar; unsigned x;
    volatile LAS unsigned* st;
};

__device__ __forceinline__ XcdBarrier xcd_barrier_post(unsigned* bar, volatile LAS unsigned* st) {
    XcdBarrier b; b.bar = bar; b.x = xb_xcc_id(); b.st = st;
    if (threadIdx.x == 0) (void)xb_add(&bar[XB_XCNT(b.x)], 1u);
    return b;
}
__device__ __forceinline__ void xcd_barrier_complete(unsigned* bar, unsigned x, unsigned& nloc, unsigned& nx) {
    const unsigned G = gridDim.x * gridDim.y * gridDim.z;
    unsigned sum, cnt, mine, sp = 0u;
    for (;;) {
        sum = 0u; cnt = 0u; mine = 0u;
#pragma unroll
        for (unsigned j = 0; j < 16; ++j) { const unsigned c = xb_ld(&bar[XB_XCNT(j)]); sum += c; cnt += (c > 0u) ? 1u : 0u; mine = (j == x) ? c : mine; }
        if (sum == G) break;
        __builtin_amdgcn_s_sleep(1);
        if ((++sp & 255u) == 0u) { if (xb_ld(&bar[XB_TMO])) break; if (sp > XB_SPIN_CAP) { atomicAdd(&bar[XB_TMO], 1u); break; } }
    }
    nloc = mine > 0u ? mine : 1u; nx = cnt > 0u ? cnt : 1u;
}

__device__ __forceinline__ void xcd_barrier(const XcdBarrier& b) {
    asm volatile("s_waitcnt vmcnt(0)" ::: "memory");
    __syncthreads();
    if (threadIdx.x == 0) {
        unsigned* bar = b.bar;
        __builtin_amdgcn_s_waitcnt(0);
        unsigned nloc = b.st[0], nx = b.st[1];
        if (nloc == 0u) { xcd_barrier_complete(bar, b.x, nloc, nx); b.st[0] = nloc; b.st[1] = nx; }
        const unsigned old = xb_add(&bar[XB_XSUB(b.x)], 1u);
        const unsigned gen = old / nloc;
        if (old + 1u == (gen + 1u) * nloc) {
            __builtin_amdgcn_fence(__ATOMIC_RELEASE, "agent");
            asm volatile("s_waitcnt vmcnt(0)" ::: "memory");
            const unsigned og = xb_add(&bar[XB_TOP], 1u);
            const unsigned tg = og / nx;
            if (og + 1u == (tg + 1u) * nx) xb_add(&bar[XB_TOPGEN], 1u);
            else XB_SPIN(xb_ld(&bar[XB_TOPGEN]) == tg, bar);
            __builtin_amdgcn_fence(__ATOMIC_ACQUIRE, "agent");
            xb_add(&bar[XB_XGEN(b.x)], 1u);
            asm volatile("s_waitcnt vmcnt(0)" ::: "memory");
        } else {
            XB_SPIN(xb_ld(&bar[XB_XGEN(b.x)]) == gen, bar);
            __builtin_amdgcn_fence(__ATOMIC_ACQUIRE, "agent");
            asm volatile("s_waitcnt vmcnt(0)" ::: "memory");
        }
    }
    __syncthreads();
}

struct Frame {
    LAS unsigned char* lds; volatile LAS unsigned* MISC; gu32* ctl;
    int tid, lane, wave, vcu, G;
};
struct Args { const float* in[20]; float* out; unsigned char* ws; int ph_lo, ph_hi, li, pad; };

__device__ __forceinline__ void p0_transpose_item(const float* W, int K, int N, bf16_t* WT, int k0, int n0, int drow0, LAS float* scr, int lane) {
#pragma unroll 8
    for (int i = 0; i < 32; ++i) { const int kk = 2 * i + (lane >> 5); scr[kk * 33 + (lane & 31)] = W[(size_t)(k0 + kk) * N + n0 + (lane & 31)]; }
    LDS_WAIT(); asm volatile("" ::: "memory");
    const int c = lane & 7;
#pragma unroll
    for (int j = 0; j < 4; ++j) { const int n = (lane >> 3) + 8 * j; const LAS float* s = scr + (8 * c) * 33 + n;
        u32x4 o; o.x = pk2(s[0 * 33], s[1 * 33]); o.y = pk2(s[2 * 33], s[3 * 33]); o.z = pk2(s[4 * 33], s[5 * 33]); o.w = pk2(s[6 * 33], s[7 * 33]);
        *(GAS u32x4*)(WT + (size_t)(drow0 + n) * K + k0 + 8 * c) = o; }
    LDS_WAIT(); asm volatile("" ::: "memory");
}
__device__ __forceinline__ void p0_transpose_item_fp8(const float* W, int K, int N, unsigned char* WT, int k0, int n0, int drow0, LAS float* scr, int lane) {
#pragma unroll 8
    for (int i = 0; i < 32; ++i) { const int kk = 2 * i + (lane >> 5); scr[kk * 33 + (lane & 31)] = W[(size_t)(k0 + kk) * N + n0 + (lane & 31)]; }
    LDS_WAIT(); asm volatile("" ::: "memory");
    const int c = lane & 3;
#pragma unroll
    for (int j = 0; j < 2; ++j) { const int n = (lane >> 2) + 16 * j; const LAS float* s = scr + (16 * c) * 33 + n;
        u32x4 o; o.x = pk4_fp8(s[0 * 33] * S_W, s[1 * 33] * S_W, s[2 * 33] * S_W, s[3 * 33] * S_W); o.y = pk4_fp8(s[4 * 33] * S_W, s[5 * 33] * S_W, s[6 * 33] * S_W, s[7 * 33] * S_W);
        o.z = pk4_fp8(s[8 * 33] * S_W, s[9 * 33] * S_W, s[10 * 33] * S_W, s[11 * 33] * S_W); o.w = pk4_fp8(s[12 * 33] * S_W, s[13 * 33] * S_W, s[14 * 33] * S_W, s[15 * 33] * S_W);
        *(GAS u32x4*)(WT + (size_t)(drow0 + n) * K + k0 + 16 * c) = o; }
    LDS_WAIT(); asm volatile("" ::: "memory");
}
#ifndef MK_KGL
#define MK_KGL 3
#endif
constexpr int KGL = MK_KGL, KG = 1 << KGL, CV_K8 = 16 * KG, CV_K16 = 8 * KG, CV_N = 4 * (64 >> KGL);
template <int PMODE> __device__ __forceinline__ void cvt_task_fp8(const float* W, int N, unsigned char* WT, int K, int k0, int n0, int halfN, int lane) {
    const int n = n0 + 4 * (lane >> KGL), k = k0 + 16 * (lane & (KG - 1));
    const GAS f32x4* src = (const GAS f32x4*)(W + (size_t)k * N + n);
    f32x4 v[16];
#pragma unroll
    for (int i = 0; i < 16; ++i) v[i] = __builtin_nontemporal_load(src + (size_t)i * (N / 4));
    int dr = n;
    if (PMODE == 1 || (PMODE == 2 && n < 2 * halfN)) dr = (n < halfN) ? ((n >> 7) * 256 + (n & 127)) : (((n - halfN) >> 7) * 256 + 128 + ((n - halfN) & 127));
#pragma unroll
    for (int j = 0; j < 4; ++j) { u32x4 o;
        o.x = pk4_fp8(v[0][j] * S_W, v[1][j] * S_W, v[2][j] * S_W, v[3][j] * S_W); o.y = pk4_fp8(v[4][j] * S_W, v[5][j] * S_W, v[6][j] * S_W, v[7][j] * S_W);
        o.z = pk4_fp8(v[8][j] * S_W, v[9][j] * S_W, v[10][j] * S_W, v[11][j] * S_W); o.w = pk4_fp8(v[12][j] * S_W, v[13][j] * S_W, v[14][j] * S_W, v[15][j] * S_W);
        *(GAS u32x4*)(WT + (size_t)(dr + j) * K + k) = o; }
}
template <int PMODE> __device__ __forceinline__ void cvt_task_bf16(const float* W, int N, bf16_t* WT, int K, int k0, int n0, int halfN, int lane) {
    const int n = n0 + 4 * (lane >> KGL), k = k0 + 8 * (lane & (KG - 1));
    const GAS f32x4* src = (const GAS f32x4*)(W + (size_t)k * N + n);
    f32x4 v[8];
#pragma unroll
    for (int i = 0; i < 8; ++i) v[i] = src[(size_t)i * (N / 4)];
    int dr = n;
    if (PMODE == 1 || (PMODE == 2 && n < 2 * halfN)) dr = (n < halfN) ? ((n >> 7) * 256 + (n & 127)) : (((n - halfN) >> 7) * 256 + 128 + ((n - halfN) & 127));
#pragma unroll
    for (int j = 0; j < 4; ++j) { u32x4 o; o.x = cvt_pk(v[0][j], v[1][j]); o.y = cvt_pk(v[2][j], v[3][j]); o.z = cvt_pk(v[4][j], v[5][j]); o.w = cvt_pk(v[6][j], v[7][j]);
        *(GAS u32x4*)(WT + (size_t)(dr + j) * K + k) = o; }
}
struct CvDesc { const GAS f32x4* src; size_t stride4; unsigned char* dst; int K; };
__device__ __forceinline__ CvDesc cv_desc(int it, const float* w_ei, const float* w_eo, unsigned char* WE1, unsigned char* WE2, int lane) {
    constexpr int CVT1 = (D / CV_K8) * (2 * DE / CV_N), CVT2 = (DE / CV_K8) * (D / CV_N), CVTE = CVT1 + CVT2;
    const int e = it / CVTE, q = it % CVTE; CvDesc d;
    if (q < CVT1) { const int k = CV_K8 * (q / (2 * DE / CV_N)) + 16 * (lane & (KG - 1)), n = CV_N * (q % (2 * DE / CV_N)) + 4 * (lane >> KGL);
        const int dr = (n < DE) ? ((n >> 7) * 256 + (n & 127)) : (((n - DE) >> 7) * 256 + 128 + ((n - DE) & 127));
        d.src = (const GAS f32x4*)(w_ei + (size_t)e * D * 2 * DE + (size_t)k * (2 * DE) + n); d.stride4 = 2 * DE / 4; d.dst = WE1 + (size_t)e * 2 * DE * D + (size_t)dr * D + k; d.K = D; }
    else { const int r = q - CVT1; const int k = CV_K8 * (r / (D / CV_N)) + 16 * (lane & (KG - 1)), n = CV_N * (r % (D / CV_N)) + 4 * (lane >> KGL);
        d.src = (const GAS f32x4*)(w_eo + (size_t)e * DE * D + (size_t)k * D + n); d.stride4 = D / 4; d.dst = WE2 + (size_t)e * D * DE + (size_t)n * DE + k; d.K = DE; }
    return d;
}
__device__ __forceinline__ void cv_load(f32x4 (&v)[16], const CvDesc& d) {
#pragma unroll
    for (int i = 0; i < 16; ++i) v[i] = __builtin_nontemporal_load(d.src + (size_t)i * d.stride4);
}
__device__ __forceinline__ void cv_store(const f32x4 (&v)[16], const CvDesc& d) {
#pragma unroll
    for (int j = 0; j < 4; ++j) { u32x4 o;
        o.x = pk4_fp8(v[0][j] * S_W, v[1][j] * S_W, v[2][j] * S_W, v[3][j] * S_W); o.y = pk4_fp8(v[4][j] * S_W, v[5][j] * S_W, v[6][j] * S_W, v[7][j] * S_W);
        o.z = pk4_fp8(v[8][j] * S_W, v[9][j] * S_W, v[10][j] * S_W, v[11][j] * S_W); o.w = pk4_fp8(v[12][j] * S_W, v[13][j] * S_W, v[14][j] * S_W, v[15][j] * S_W);
        *(GAS u32x4*)(d.dst + (size_t)j * d.K) = o; }
}
__device__ __forceinline__ void cv_run(int lo, int hi, int w0, int wn, const float* w_ei, const float* w_eo, unsigned char* WE1, unsigned char* WE2, int lane) {
#if defined(MK_CV_PIPE)
    int it = lo + w0; if (it >= hi) return;
    f32x4 va[16], vb[16];
    CvDesc da = cv_desc(it, w_ei, w_eo, WE1, WE2, lane), db = da;
    cv_load(va, da);
    for (;;) {
        const int it2 = it + wn; const bool h2 = it2 < hi;
        db = cv_desc(h2 ? it2 : it, w_ei, w_eo, WE1, WE2, lane); cv_load(vb, db);
        cv_store(va, da);
        if (!h2) break;
        const int it3 = it2 + wn; const bool h3 = it3 < hi;
        da = cv_desc(h3 ? it3 : it2, w_ei, w_eo, WE1, WE2, lane); cv_load(va, da);
        cv_store(vb, db);
        if (!h3) break;
        it = it3;
    }
#else
    for (int it = lo + w0; it < hi; it += wn) { f32x4 v[16]; const CvDesc d = cv_desc(it, w_ei, w_eo, WE1, WE2, lane); cv_load(v, d); cv_store(v, d); }
#endif
}
__device__ __forceinline__ int paired_row(int n0, int halfN) { return (n0 < halfN) ? ((n0 >> 7) * 256 + (n0 & 127)) : (((n0 - halfN) >> 7) * 256 + 128 + ((n0 - halfN) & 127)); }

__device__ __forceinline__ void rms_row_to_bf16(const float* xrow, const float* g, bf16_t* orow, int lane) {
    const GAS f32x4* xr = (const GAS f32x4*)xrow + lane;
    f32x4 v[8]; float ss = 0.f;
#pragma unroll
    for (int j = 0; j < 8; ++j) { v[j] = xr[64 * j]; ss += (v[j][0] * v[j][0] + v[j][1] * v[j][1]) + (v[j][2] * v[j][2] + v[j][3] * v[j][3]); }
    const float rs = rsqrtf(wave_sum(ss) * (1.0f / D) + EPS);
    GAS u32x2* o8 = (GAS u32x2*)orow + lane;
#pragma unroll
    for (int j = 0; j < 8; ++j) { const f32x4 gg = ((const GAS f32x4*)g)[lane + 64 * j]; u32x2 w; w.x = pk2(v[j][0] * rs * gg[0], v[j][1] * rs * gg[1]); w.y = pk2(v[j][2] * rs * gg[2], v[j][3] * rs * gg[3]); o8[64 * j] = w; }
}

__device__ __forceinline__ void rms_row_to_fp8(const float* xrow, const float* g, unsigned char* orow, int lane) {
    const GAS f32x4* xr = (const GAS f32x4*)xrow + lane;
    f32x4 v[8]; float ss = 0.f;
#pragma unroll
    for (int j = 0; j < 8; ++j) { v[j] = xr[64 * j]; ss += (v[j][0] * v[j][0] + v[j][1] * v[j][1]) + (v[j][2] * v[j][2] + v[j][3] * v[j][3]); }
    const float rs = rsqrtf(wave_sum(ss) * (1.0f / D) + EPS) * S_X;
    GAS unsigned* o4 = (GAS unsigned*)orow + lane;
#pragma unroll
    for (int j = 0; j < 8; ++j) { const f32x4 gg = ((const GAS f32x4*)g)[lane + 64 * j]; o4[64 * j] = pk4_fp8(v[j][0] * rs * gg[0], v[j][1] * rs * gg[1], v[j][2] * rs * gg[2], v[j][3] * rs * gg[3]); }
}

__device__ __forceinline__ void conv_tile(Frame& F, int tile, const bf16_t* U, const float* cw, const float* cb, const float* lg, const float* lb, bf16_t* UC) {
    const int t0 = tile * 32, c = 2 * F.tid;
    LAS float* ys = (LAS float*)F.lds;
    f32x2 w[31];
#pragma unroll
    for (int k = 0; k < 31; ++k) w[k] = *(const f32x2*)(cw + k * DC + c);
    const f32x2 bias = *(const f32x2*)(cb + c);
    f32x2 win[31];
#pragma unroll
    for (int p = 0; p < 30; ++p) { const int tt = t0 - 30 + p; unsigned v = 0u; if (tt >= 0) v = *(const unsigned*)(U + (size_t)tt * DC + c); win[p] = (f32x2){bflo(v), bfhi(v)}; }
    win[30] = (f32x2){0.f, 0.f};
#pragma unroll 1
    for (int jb = 0; jb < 32; jb += 31) {
#pragma unroll
        for (int p = 0; p < 31; ++p) {
            const int j = jb + p;
            if (j < 32) {
                const unsigned v = *(const unsigned*)(U + (size_t)(t0 + j) * DC + c);
                win[(30 + p) % 31] = (f32x2){bflo(v), bfhi(v)};
                f32x2 a = bias;
#pragma unroll
                for (int k = 0; k < 31; ++k) a += w[k] * win[(p + k) % 31];
                *(LAS f32x2*)(ys + j * DC + c) = a;
            }
        }
    }
    __syncthreads();
#pragma unroll 1
    for (int jj = 0; jj < 4; ++jj) {
        const int j = F.wave * 4 + jj;
        f32x4 v[4]; float s = 0.f;
#pragma unroll
        for (int q = 0; q < 4; ++q) { v[q] = *(const LAS f32x4*)(ys + j * DC + 4 * F.lane + 256 * q); s += (v[q][0] + v[q][1]) + (v[q][2] + v[q][3]); }
        const float mu = wave_sum(s) * (1.0f / DC); float qq = 0.f;
#pragma unroll
        for (int q = 0; q < 4; ++q) { v[q] = v[q] - mu; qq += (v[q][0] * v[q][0] + v[q][1] * v[q][1]) + (v[q][2] * v[q][2] + v[q][3] * v[q][3]); }
        const float rstd = rsqrtf(wave_sum(qq) * (1.0f / DC) + EPS);
#pragma unroll
        for (int q = 0; q < 4; ++q) { const int cc = 4 * F.lane + 256 * q; const f32x4 g4 = *(const f32x4*)(lg + cc), b4 = *(const f32x4*)(lb + cc);
            float y[4];
#pragma unroll
            for (int z = 0; z < 4; ++z) { const float t = v[q][z] * rstd * g4[z] + b4[z]; y[z] = t * sigm(t); }
            u32x2 o; o.x = cvt_pk(y[0], y[1]); o.y = cvt_pk(y[2], y[3]);
            *(u32x2*)(UC + (size_t)(t0 + j) * DC + cc) = o; }
    }
    __syncthreads();
}

__device__ __forceinline__ void attn_task(const bf16_t* __restrict__ Q, const bf16_t* __restrict__ Kb, const bf16_t* __restrict__ Vb, float* OG, float* LSE, int task, int lane) {
    const int h = task >> 8, rem = task & 255;
    const int dsh = 2 * (h >> 2), dil = 1 << dsh;
    const int r = rem & (dil - 1), mc = rem >> dsh;
    const int i = lane & 31, hh = lane >> 5;
    const int m0 = mc * 32;
    const int tq = ((m0 + i) << dsh) + r;
    bf16x8 qf[8];
    { const bf16_t* qp = Q + (size_t)tq * AW + h * HD + 8 * hh;
#pragma unroll
      for (int s = 0; s < 8; ++s) qf[s] = *(const bf16x8*)(qp + 16 * s); }
    const int jt0 = (mc < 4) ? (4 - mc) : 0;
    const float NEG = -__builtin_inff();
    f32x16 sacc[5];
#pragma unroll
    for (int jt = 0; jt < 5; ++jt) {
        f32x16 a;
#pragma unroll
        for (int q = 0; q < 16; ++q) a[q] = 0.f;
        if (jt >= jt0) {
            const int mk = m0 - 128 + 32 * jt + i;
            const bf16_t* kp = Kb + (size_t)((mk << dsh) + r) * AW + h * HD + 8 * hh;
#pragma unroll
            for (int s = 0; s < 8; ++s) { const bf16x8 kf = *(const bf16x8*)(kp + 16 * s); a = __builtin_amdgcn_mfma_f32_32x32x16_bf16(kf, qf[s], a, 0, 0, 0); }
#pragma unroll
            for (int q = 0; q < 16; ++q) { const int kk = (q & 3) + 8 * (q >> 2) + 4 * hh;
                if (jt == 0 && kk < i) a[q] = NEG;
                if (jt == 4 && kk > i) a[q] = NEG; }
        } else {
#pragma unroll
            for (int q = 0; q < 16; ++q) a[q] = NEG;
        }
        sacc[jt] = a;
        __builtin_amdgcn_sched_barrier(0);
    }
    float mx = NEG;
#pragma unroll
    for (int jt = 0; jt < 5; ++jt)
#pragma unroll
        for (int q = 0; q < 16; ++q) mx = fmaxf(mx, sacc[jt][q]);
    mx = fmaxf(mx, __shfl_xor(mx, 32));
    float l = 0.f;
#pragma unroll
    for (int jt = 0; jt < 5; ++jt)
#pragma unroll
        for (int q = 0; q < 16; ++q) { const float e = __builtin_amdgcn_exp2f(sacc[jt][q] - mx); sacc[jt][q] = e; l += e; }
    l += __shfl_xor(l, 32);
    const float inv = 1.0f / l;
    if (hh == 0) LSE[(size_t)tq * NH + h] = (mx + __log2f(l)) * LN2;
    bf16x8 pf[5][2];
#pragma unroll
    for (int jt = 0; jt < 5; ++jt)
#pragma unroll
        for (int s2 = 0; s2 < 2; ++s2) { u32x4 w;
            w.x = cvt_pk(sacc[jt][8 * s2 + 0] * inv, sacc[jt][8 * s2 + 1] * inv); w.y = cvt_pk(sacc[jt][8 * s2 + 2] * inv, sacc[jt][8 * s2 + 3] * inv);
            w.z = cvt_pk(sacc[jt][8 * s2 + 4] * inv, sacc[jt][8 * s2 + 5] * inv); w.w = cvt_pk(sacc[jt][8 * s2 + 6] * inv, sacc[jt][8 * s2 + 7] * inv);
            pf[jt][s2] = __builtin_bit_cast(bf16x8, w); }
    f32x16 o[4];
#pragma unroll
    for (int z = 0; z < 4; ++z)
#pragma unroll
        for (int q = 0; q < 16; ++q) o[z][q] = 0.f;
    const bf16_t* vcol = Vb + h * HD + 2 * i;
#pragma unroll
    for (int jt = 0; jt < 5; ++jt) {
        if (jt >= jt0) {
#pragma unroll
            for (int s2 = 0; s2 < 2; ++s2) {
                unsigned wa[8], wb[8];
#pragma unroll
                for (int j = 0; j < 8; ++j) { const int mk = m0 - 128 + 32 * jt + 16 * s2 + 8 * (j >> 2) + 4 * hh + (j & 3); const bf16_t* vp = vcol + (size_t)((mk << dsh) + r) * AW;
                    wa[j] = *(const unsigned*)vp; wb[j] = *(const unsigned*)(vp + 64); }
                u32x4 f0, f1, f2, f3;
                f0.x = (wa[0] & 0xffffu) | (wa[1] << 16); f0.y = (wa[2] & 0xffffu) | (wa[3] << 16); f0.z = (wa[4] & 0xffffu) | (wa[5] << 16); f0.w = (wa[6] & 0xffffu) | (wa[7] << 16);
                f1.x = (wa[0] >> 16) | (wa[1] & 0xffff0000u); f1.y = (wa[2] >> 16) | (wa[3] & 0xffff0000u); f1.z = (wa[4] >> 16) | (wa[5] & 0xffff0000u); f1.w = (wa[6] >> 16) | (wa[7] & 0xffff0000u);
                f2.x = (wb[0] & 0xffffu) | (wb[1] << 16); f2.y = (wb[2] & 0xffffu) | (wb[3] << 16); f2.z = (wb[4] & 0xffffu) | (wb[5] << 16); f2.w = (wb[6] & 0xffffu) | (wb[7] << 16);
                f3.x = (wb[0] >> 16) | (wb[1] & 0xffff0000u); f3.y = (wb[2] >> 16) | (wb[3] & 0xffff0000u); f3.z = (wb[4] >> 16) | (wb[5] & 0xffff0000u); f3.w = (wb[6] >> 16) | (wb[7] & 0xffff0000u);
                o[0] = __builtin_amdgcn_mfma_f32_32x32x16_bf16(pf[jt][s2], __builtin_bit_cast(bf16x8, f0), o[0], 0, 0, 0);
                o[1] = __builtin_amdgcn_mfma_f32_32x32x16_bf16(pf[jt][s2], __builtin_bit_cast(bf16x8, f1), o[1], 0, 0, 0);
                o[2] = __builtin_amdgcn_mfma_f32_32x32x16_bf16(pf[jt][s2], __builtin_bit_cast(bf16x8, f2), o[2], 0, 0, 0);
                o[3] = __builtin_amdgcn_mfma_f32_32x32x16_bf16(pf[jt][s2], __builtin_bit_cast(bf16x8, f3), o[3], 0, 0, 0);
                __builtin_amdgcn_sched_barrier(0);
            }
        }
    }
#pragma unroll
    for (int q = 0; q < 16; ++q) { const int qi = (q & 3) + 8 * (q >> 2) + 4 * hh; const int tt = ((m0 + qi) << dsh) + r;
        float* op = OG + ((size_t)tt * NH + h) * HD + 2 * i;
        *(f32x2*)op = (f32x2){o[0][q], o[1][q]}; *(f32x2*)(op + 64) = (f32x2){o[2][q], o[3][q]}; }
}

__global__ void __launch_bounds__(NWAVES * 64, 2) mk_fwd(Args args) {
    extern __shared__ __attribute__((aligned(16))) unsigned char lds[];
    Frame F;
    F.lds = (LAS unsigned char*)lds;
    F.MISC = (volatile LAS unsigned*)(F.lds + MISC_OFF);
    F.tid = threadIdx.x; F.lane = F.tid & 63; F.wave = __builtin_amdgcn_readfirstlane(F.tid >> 6);
    F.G = gridDim.x; { const int bx = blockIdx.x; F.vcu = (F.G % 8 == 0) ? (bx % 8) * (F.G / 8) + bx / 8 : bx; }
    unsigned char* ws = args.ws;
    F.ctl = (gu32*)(ws + WS_CTL);
    for (int u = F.tid; u < (LDS_BYTES - LDSCTL_OFF) / 4; u += NWAVES * 64) ((LAS unsigned*)(F.lds + LDSCTL_OFF))[u] = 0u;
    __syncthreads();
    const bool one_launch = (args.ph_hi - args.ph_lo) > 1;
    XcdBarrier bar; bar.bar = (unsigned*)(F.ctl + CW_BAR) + args.li * XCD_BAR_WORDS; bar.x = 0; bar.st = nullptr;
    if (one_launch) bar = xcd_barrier_post((unsigned*)(F.ctl + CW_BAR) + args.li * XCD_BAR_WORDS, F.MISC + 8);
    const int lo = args.ph_lo, hi = args.ph_hi;
#ifndef MK_PHASE_MASK
#define MK_PHASE_MASK 0xfff
#endif
#define IN(k) ((((MK_PHASE_MASK) >> (k)) & 1) && lo <= (k) && (k) < hi)
#define SEAM(k) do { if (IN(k) && IN((k) + 1)) xcd_barrier(bar); } while (0)
#ifndef MK_REPEAT
#define MK_REPEAT (-1)
#endif
#define REPS(k) for (int rep_ = 0; rep_ < ((k) == MK_REPEAT ? 2 : 1); ++rep_)

    const float* x = args.in[0]; const float* n1g = args.in[1]; const float* w_in = args.in[2]; const float* b_gate = args.in[3];
    const float* conv_w = args.in[4]; const float* conv_b = args.in[5]; const float* ln_g = args.in[6]; const float* ln_b = args.in[7];
    const float* w_co = args.in[8]; const float* b_co = args.in[9]; const float* w_ao = args.in[10]; const float* w_out = args.in[11];
    const float* n2g = args.in[12]; const float* w_r = args.in[13]; const float* b_r = args.in[14];
    const float* w_ei = args.in[15]; const float* b_ei = args.in[16]; const float* w_eo = args.in[17]; const float* b_eo = args.in[18]; const float* nfg = args.in[19];
    bf16_t* WIN = (bf16_t*)(ws + WS_WIN); bf16_t* WCO = (bf16_t*)(ws + WS_WCO); bf16_t* WAO = (bf16_t*)(ws + WS_WAO); bf16_t* WOUT = (bf16_t*)(ws + WS_WOUT);
    unsigned char* WE1 = ws + WS_WE1; unsigned char* WE2 = ws + WS_WE2;
    bf16_t* Hb = (bf16_t*)(ws + WS_H); bf16_t* Ub = (bf16_t*)(ws + WS_U); bf16_t* Qb = (bf16_t*)(ws + WS_Q); bf16_t* Kb = (bf16_t*)(ws + WS_K); bf16_t* Vb = (bf16_t*)(ws + WS_V);
    bf16_t* Gb = (bf16_t*)(ws + WS_GATE); bf16_t* UCb = (bf16_t*)(ws + WS_UC); float* OG = (float*)(ws + WS_OG); float* LSE = (float*)(ws + WS_LSE); bf16_t* OCb = (bf16_t*)(ws + WS_OC);
    float* M1 = (float*)(ws + WS_M1); bf16_t* MGb = (bf16_t*)(ws + WS_MG); float* X1 = (float*)(ws + WS_X1); unsigned char* H2f = ws + WS_H2;
    int* a_e = (int*)(ws + WS_AE); int* a_pos = (int*)(ws + WS_APOS); float* a_gate = (float*)(ws + WS_AGATE); int* a_slot = (int*)(ws + WS_ASLOT);
    unsigned char* XG = ws + WS_XG; unsigned char* ACT = ws + WS_ACT; bf16_t* Yb = (bf16_t*)(ws + WS_Y);
    int* hist = (int*)(ws + WS_HIST);
    const int gw = F.vcu * NWAVES + F.wave, NGW = F.G * NWAVES;
#ifndef MK_NCV
#define MK_NCV 8
#endif
    const int bx = (int)blockIdx.x;
    const bool grp = (MK_NCV > 0) && (F.G % 8 == 0) && (F.G / 8 > MK_NCV);
    const int cgG = grp ? F.G - 8 * MK_NCV : F.G;
    const bool is_cv = grp && bx >= cgG;
    const int cg_vcu = grp ? (bx % 8) * (cgG / 8) + bx / 8 : F.vcu;
    const int cg_gw = cg_vcu * NWAVES + F.wave, cg_NGW = cgG * NWAVES;
    const int cv_gw = (bx - cgG) * NWAVES + F.wave, cv_NGW = 8 * MK_NCV * NWAVES;
    constexpr int CVT1 = (D / CV_K8) * (2 * DE / CV_N), CVT2 = (DE / CV_K8) * (D / CV_N), CVTE = CVT1 + CVT2, CVTOT = NE * CVTE;
#ifndef MK_CVSPLIT
#define MK_CVSPLIT 49152, 70656, 82432, 84480, 95232
#endif
    constexpr int cvs_[5] = {MK_CVSPLIT};
    const int CV_C0 = grp ? cvs_[0] : CVTOT, CV_C1 = grp ? cvs_[1] : CVTOT, CV_C2 = grp ? cvs_[2] : CVTOT, CV_C3 = grp ? cvs_[3] : CVTOT, CV_C4 = grp ? cvs_[4] : CVTOT;
#define CV_RUN(lo_, hi_, w0_, wn_) cv_run((lo_), (hi_), (w0_), (wn_), w_ei, w_eo, WE1, WE2, F.lane)

    REPS(0) if (IN(0)) {
        if (rep_) xcd_barrier(bar);
        { constexpr int NB_IN = DIN / CV_N, T_IN = (D / CV_K8) * NB_IN, NB = D / CV_N, T_CO = (DC / CV_K16) * NB, T_AO = (AO / CV_K16) * NB, T_OUT = (D / CV_K16) * NB;
          for (int it = gw; it < T_IN; it += NGW) cvt_task_fp8<2>(w_in, DIN, (unsigned char*)WIN, D, CV_K8 * (it / NB_IN), CV_N * (it % NB_IN), 1024, F.lane);
          for (int it = gw; it < T_CO + T_AO + T_OUT; it += NGW) { int q = it;
              if (q < T_CO) { cvt_task_bf16<0>(w_co, D, WCO, DC, CV_K16 * (q / NB), CV_N * (q % NB), 0, F.lane); continue; } q -= T_CO;
              if (q < T_AO) { cvt_task_bf16<0>(w_ao, D, WAO, AO, CV_K16 * (q / NB), CV_N * (q % NB), 0, F.lane); continue; } q -= T_AO;
              cvt_task_bf16<0>(w_out, D, WOUT, D, CV_K16 * (q / NB), CV_N * (q % NB), 0, F.lane); } }
        CV_RUN(0, CV_C0, gw, NGW);
        for (int m = gw; m < T; m += NGW) rms_row_to_fp8(x + (size_t)m * D, n1g, (unsigned char*)Hb + (size_t)m * D, F.lane);
    }
    SEAM(0);
    if (IN(1)) {
        if (!is_cv) {
            pg8::Gemm g{Hb, WIN, T, DIN, D / 2}; pg8::StaticOrder S; S.init(T, DIN, cgG, bx);
            static_assert(WS_V - WS_K == WS_K - WS_Q, "q|k|v strides"); EpiProj E{Ub, Qb, Gb, b_gate};
            pg8::gemm_phase<EpiProj, pg8::StaticOrder, true, true, E8_W, E8_X>(F.lds, g, S, E);
        } else CV_RUN(CV_C0, CV_C1, cv_gw, cv_NGW);
    }
    SEAM(1);
    REPS(2) if (IN(2)) {
        if (rep_) xcd_barrier(bar);
#ifndef MK_NO_CONV
        if (!is_cv) for (int tile = cg_vcu; tile < T / 32; tile += cgG) conv_tile(F, tile, Ub, conv_w, conv_b, ln_g, ln_b, UCb);
#endif
#ifndef MK_NO_ATTN
        if (!is_cv) for (int task = cg_gw; task < NH * 256; task += cg_NGW) attn_task(Qb, Kb, Vb, OG, LSE, task, F.lane);
        if (is_cv) CV_RUN(CV_C1, CV_C2, cv_gw, cv_NGW);
#endif
    }
    SEAM(2);
#ifdef MK_EXTRA_BARRIERS
    for (int xb_ = 0; xb_ < MK_EXTRA_BARRIERS; ++xb_) xcd_barrier(bar);
#endif
    REPS(3) if (IN(3)) {
        if (rep_) xcd_barrier(bar);
        if (is_cv) CV_RUN(CV_C2, CV_C3, cv_gw, cv_NGW);
        if (!is_cv) for (int it = cg_gw; it < T * 4; it += cg_NGW) { const int t = it >> 2, hg = it & 3;
            const float l0 = LSE[(size_t)t * NH + hg], l1 = LSE[(size_t)t * NH + 4 + hg], l2 = LSE[(size_t)t * NH + 8 + hg];
            const float m = fmaxf(l0, fmaxf(l1, l2)); const float w0 = __expf(l0 - m), w1 = __expf(l1 - m), w2 = __expf(l2 - m), inv = 1.0f / (w0 + w1 + w2);
            const f32x2 a = *(const f32x2*)(OG + ((size_t)t * NH + hg) * HD + 2 * F.lane), b = *(const f32x2*)(OG + ((size_t)t * NH + 4 + hg) * HD + 2 * F.lane), c = *(const f32x2*)(OG + ((size_t)t * NH + 8 + hg) * HD + 2 * F.lane);
            const f32x2 o = (a * w0 + b * w1 + c * w2) * inv;
            *(unsigned*)(OCb + (size_t)t * AO + hg * HD + 2 * F.lane) = cvt_pk(o[0], o[1]); }
    }
    if (IN(4)) {
        pg8::Gemm g{UCb, WCO, T, D, DC}; pg8::StaticOrder S; S.init(T, D, F.G, (int)blockIdx.x);
        EpiConvOut E{M1, Gb, b_co};
        pg8::gemm_phase<EpiConvOut, pg8::StaticOrder, false, true>(F.lds, g, S, E);
        if (MK_REPEAT == 4) {
            xcd_barrier(bar);
            pg8::Gemm g{UCb, WCO, T, D, DC}; pg8::StaticOrder S; S.init(T, D, F.G, (int)blockIdx.x);
        EpiConvOut E{M1, Gb, b_co};
        pg8::gemm_phase<EpiConvOut, pg8::StaticOrder, false, true>(F.lds, g, S, E);
        }
    }
    SEAM(4);
    if (IN(5)) {
        pg8::Gemm g{OCb, WAO, T, D, AO}; pg8::StaticOrder S; S.init(T, D, F.G, (int)blockIdx.x);
        EpiAttnOut E{M1, Gb, MGb};
        pg8::gemm_phase<EpiAttnOut, pg8::StaticOrder, false, true>(F.lds, g, S, E);
    }
    SEAM(5);
    if (IN(6)) {
        pg8::Gemm g{MGb, WOUT, T, D, D}; pg8::StaticOrder S; S.init(T, D, F.G, (int)blockIdx.x);
        EpiResid E{x, X1};
        pg8::gemm_phase<EpiResid, pg8::StaticOrder, false, true>(F.lds, g, S, E);
        if (MK_REPEAT == 6) {
            xcd_barrier(bar);
            pg8::Gemm g{MGb, WOUT, T, D, D}; pg8::StaticOrder S; S.init(T, D, F.G, (int)blockIdx.x);
        EpiResid E{x, X1};
        pg8::gemm_phase<EpiResid, pg8::StaticOrder, false, true>(F.lds, g, S, E);
        }
    }
    SEAM(6);
    REPS(7) if (IN(7)) {
        if (rep_) xcd_barrier(bar);
        LAS float* xs = (LAS float*)F.lds;
        LAS int* ue = (LAS int*)(F.lds + TAB_OFF + 256);
        float wreg[128];
        { const int e = F.lane & 31, i0 = 256 * F.wave + 128 * (F.lane >> 5);
#pragma unroll
          for (int ii = 0; ii < 128; ++ii) wreg[ii] = w_r[(size_t)(i0 + ii) * NE + e]; }
        if (is_cv) CV_RUN(CV_C3, CV_C4, cv_gw, cv_NGW);
        if (!is_cv) for (int unit = cg_vcu; unit < T / 16; unit += cgG) {
            const int t0 = unit * 16;
#pragma unroll 1
            for (int tt = 2 * F.wave; tt < 2 * F.wave + 2; ++tt) {
                const GAS f32x4* xr = (const GAS f32x4*)(X1 + (size_t)(t0 + tt) * D) + F.lane;
                f32x4 v[8]; float ss = 0.f;
#pragma unroll
                for (int j = 0; j < 8; ++j) { v[j] = xr[64 * j]; ss += (v[j][0] * v[j][0] + v[j][1] * v[j][1]) + (v[j][2] * v[j][2] + v[j][3] * v[j][3]); }
                const float rs = rsqrtf(wave_sum(ss) * (1.0f / D) + EPS);
                GAS unsigned* o4 = (GAS unsigned*)(H2f + (size_t)(t0 + tt) * D) + F.lane;
#pragma unroll
                for (int j = 0; j < 8; ++j) { const f32x4 gg = ((const GAS f32x4*)n2g)[F.lane + 64 * j]; const f32x4 y = v[j] * rs * gg;
                    *(LAS f32x4*)(xs + tt * D + 4 * (F.lane + 64 * j)) = y; o4[64 * j] = pk4_fp8(y[0] * S_X, y[1] * S_X, y[2] * S_X, y[3] * S_X); }
            }
            __syncthreads();
            float pacc[16];
#pragma unroll
            for (int tt = 0; tt < 16; ++tt) pacc[tt] = 0.f;
            { const int i0 = 256 * F.wave + 128 * (F.lane >> 5);
#pragma unroll
              for (int ii = 0; ii < 128; ii += 4) {
#pragma unroll
                  for (int tt = 0; tt < 16; ++tt) { const f32x4 xv = *(const LAS f32x4*)(xs + tt * D + i0 + ii); pacc[tt] += (xv[0] * wreg[ii] + xv[1] * wreg[ii + 1]) + (xv[2] * wreg[ii + 2] + xv[3] * wreg[ii + 3]); }
              } }
#pragma unroll
            for (int tt = 0; tt < 16; ++tt) pacc[tt] += __shfl_xor(pacc[tt], 32);
            __syncthreads();
            if (F.lane < 32) {
#pragma unroll
                for (int tt = 0; tt < 16; ++tt) xs[(F.wave * 16 + tt) * 32 + F.lane] = pacc[tt];
            }
            __syncthreads();
#pragma unroll 1
            for (int tt = 2 * F.wave; tt < 2 * F.wave + 2; ++tt) {
                float lg = -__builtin_inff();
                if (F.lane < 32) { float s = b_r[F.lane];
#pragma unroll
                    for (int w = 0; w < 8; ++w) s += xs[(w * 16 + tt) * 32 + F.lane];
                    lg = s; }
                int sel_e[4]; float sel_v[4];
#pragma unroll
                for (int k = 0; k < 4; ++k) { const float m = wave_max(lg); const unsigned long long b = __ballot(lg == m); const int e = __ffsll((long long)b) - 1; sel_e[k] = e; sel_v[k] = m; if (F.lane == e) lg = -__builtin_inff(); }
                const float e1 = __expf(sel_v[1] - sel_v[0]), e2 = __expf(sel_v[2] - sel_v[0]), e3 = __expf(sel_v[3] - sel_v[0]);
                const float inv = 1.0f / (1.0f + e1 + e2 + e3);
                if (F.lane < 4) {
                    const int e = F.lane == 0 ? sel_e[0] : F.lane == 1 ? sel_e[1] : F.lane == 2 ? sel_e[2] : sel_e[3];
                    const float gt = (F.lane == 0 ? 1.0f : F.lane == 1 ? e1 : F.lane == 2 ? e2 : e3) * inv;
                    const int a = (t0 + tt) * 4 + F.lane; a_e[a] = e; a_gate[a] = gt; ue[tt * 4 + F.lane] = e;
                }
            }
            __syncthreads();
            if (F.wave == 0) {
                const int e = ue[F.lane]; int rank = 0, mycount = 0;
#pragma unroll 4
                for (int q = 0; q < NE; ++q) { const unsigned long long mq = __ballot(e == q); if (e == q) rank = __popcll(mq & ((1ull << F.lane) - 1ull)); if (F.lane == q) mycount = __popcll(mq); }
                a_pos[t0 * 4 + F.lane] = rank;
                if (F.lane < NE) hist[unit * NE + F.lane] = mycount;
            }
            __syncthreads();
        }
    }
    SEAM(7);
    LAS int* rt0 = (LAS int*)(F.lds + TAB_OFF);
    LAS int* cntl = (LAS int*)(F.lds + TAB_OFF + 512);
    LAS int* ubase = (LAS int*)(F.lds + TAB_OFF + 768);
    LAS int* myexp = (LAS int*)(F.lds + TAB_OFF + 896);
    LAS int* part = (LAS int*)(F.lds + TAB_OFF + 1024);
    if (hi > 8 && lo <= 10) {
        { const int e = F.tid & 31, p = F.tid >> 5; int sacc_ = 0;
#pragma unroll 8
          for (int u = 32 * p; u < 32 * p + 32; ++u) sacc_ += hist[u * NE + e];
          part[p * NE + e] = sacc_; }
        __syncthreads();
        if (F.tid < NE) { int c = 0;
#pragma unroll
            for (int p = 0; p < 16; ++p) c += part[p * NE + F.tid];
            cntl[F.tid] = c; }
        __syncthreads();
        if (F.tid == 0) { int a = 0; for (int e = 0; e < NE; ++e) { rt0[e] = a; a += (cntl[e] + 255) >> 8; } rt0[NE] = a; }
        __syncthreads();
    }
    REPS(8) if (IN(8)) {
        if (rep_) xcd_barrier(bar);
        if (is_cv) CV_RUN(CV_C4, CVTOT, cv_gw, cv_NGW);
        if (!is_cv) for (int unit = cg_vcu; unit < T / 16; unit += cgG) {
            if (F.tid < NE) { int b = 0; const int p0 = unit >> 5;
                for (int p = 0; p < p0; ++p) b += part[p * NE + F.tid];
                for (int u = 32 * p0; u < unit; ++u) b += hist[u * NE + F.tid];
                ubase[F.tid] = b; }
            __syncthreads();
#pragma unroll 1
            for (int j = 0; j < 8; ++j) { const int a = unit * 64 + F.wave * 8 + j; const int e = a_e[a], slot = 256 * rt0[e] + ubase[e] + a_pos[a];
                if (F.lane == 0) a_slot[a] = slot;
                const GAS u32x4* src = (const GAS u32x4*)(H2f + (size_t)(a >> 2) * D) + F.lane; GAS u32x4* dst = (GAS u32x4*)(XG + (size_t)slot * D) + F.lane;
#pragma unroll
                for (int q = 0; q < 2; ++q) dst[64 * q] = src[64 * q]; }
            __syncthreads();
        }
        if (!is_cv) for (int it = cg_gw; it < NE * 256; it += cg_NGW) { const int e = it >> 8, j = it & 255; const int row = 256 * rt0[e] + cntl[e] + j;
            if (row < 256 * rt0[e + 1]) { GAS u32x4* dst = (GAS u32x4*)(XG + (size_t)row * D) + F.lane;
#pragma unroll
                for (int j2 = 0; j2 < 2; ++j2) dst[64 * j2] = (u32x4){0u, 0u, 0u, 0u}; } }
    }
    SEAM(8);
    if (IN(9)) {
        pg8::Gemm g{(const bf16_t*)XG, (const bf16_t*)WE1, NROWS, NE * 2 * DE, D / 2}; LAS unsigned* utab = (LAS unsigned*)(F.lds + TAB_OFF + 4096); const int NX = (F.G % 8 == 0) ? 8 : 1; const int utot = moe_build_tab(utab, myexp, rt0, 16, F.tid, (int)blockIdx.x % NX, NX); MoeOrder S{utab, utot, F.G / NX, (int)blockIdx.x / NX};
        EpiSwiGLU E{ACT, b_ei};
        pg8::gemm_phase<EpiSwiGLU, MoeOrder, true, true, E8_W, E8_X>(F.lds, g, S, E);
        if (MK_REPEAT == 9) {
            xcd_barrier(bar);
            pg8::Gemm g{(const bf16_t*)XG, (const bf16_t*)WE1, NROWS, NE * 2 * DE, D / 2}; LAS unsigned* utab = (LAS unsigned*)(F.lds + TAB_OFF + 4096); const int NX = (F.G % 8 == 0) ? 8 : 1; const int utot = moe_build_tab(utab, myexp, rt0, 16, F.tid, (int)blockIdx.x % NX, NX); MoeOrder S{utab, utot, F.G / NX, (int)blockIdx.x / NX};
        EpiSwiGLU E{ACT, b_ei};

#ifdef MK_REPEAT_NOEPI
            { EpiNull EN; pg8::gemm_phase<EpiNull, MoeOrder, true, true, E8_W, E8_X>(F.lds, g, S, EN); }
#else
            pg8::gemm_phase<EpiSwiGLU, MoeOrder, true, true, E8_W, E8_X>(F.lds, g, S, E);
#endif

        }
    }
    SEAM(9);
    if (IN(10)) {
        pg8::Gemm g{(const bf16_t*)ACT, (const bf16_t*)WE2, NROWS, NE * D, DE / 2}; LAS unsigned* utab = (LAS unsigned*)(F.lds + TAB_OFF + 4096); const int NX = (F.G % 8 == 0) ? 8 : 1; const int utot = moe_build_tab(utab, myexp, rt0, 8, F.tid, (int)blockIdx.x % NX, NX); MoeOrder S{utab, utot, F.G / NX, (int)blockIdx.x / NX};
        EpiExpOut E{Yb, b_eo};
        pg8::gemm_phase<EpiExpOut, MoeOrder, true, true, E8_W, E8_ACT>(F.lds, g, S, E);
        if (MK_REPEAT == 10) {
            xcd_barrier(bar);
            pg8::Gemm g{(const bf16_t*)ACT, (const bf16_t*)WE2, NROWS, NE * D, DE / 2}; LAS unsigned* utab = (LAS unsigned*)(F.lds + TAB_OFF + 4096); const int NX = (F.G % 8 == 0) ? 8 : 1; const int utot = moe_build_tab(utab, myexp, rt0, 8, F.tid, (int)blockIdx.x % NX, NX); MoeOrder S{utab, utot, F.G / NX, (int)blockIdx.x / NX};
        EpiExpOut E{Yb, b_eo};

#ifdef MK_REPEAT_NOEPI
            { typedef EpiExpOutT<MK_REPEAT_NOEPI> EV; EV EN{Yb, b_eo}; pg8::gemm_phase<EV, MoeOrder, true, true, E8_W, E8_ACT>(F.lds, g, S, EN); }
#else
            pg8::gemm_phase<EpiExpOut, MoeOrder, true, true, E8_W, E8_ACT>(F.lds, g, S, E);
#endif

        }
    }
    SEAM(10);
    REPS(11) if (IN(11)) {
        if (rep_) xcd_barrier(bar);
        for (int t = gw; t < T; t += NGW) {
            f32x4 v[8];
#pragma unroll
            for (int j = 0; j < 8; ++j) v[j] = ((const GAS f32x4*)(X1 + (size_t)t * D))[F.lane + 64 * j];
#pragma unroll
            for (int k = 0; k < 4; ++k) { const int s = a_slot[t * 4 + k]; const float gt = a_gate[t * 4 + k]; const GAS u32x2* yr = (const GAS u32x2*)(Yb + (size_t)s * D) + F.lane;
#pragma unroll
                for (int j = 0; j < 8; ++j) { const u32x2 w = yr[64 * j]; v[j][0] += gt * bflo(w.x); v[j][1] += gt * bfhi(w.x); v[j][2] += gt * bflo(w.y); v[j][3] += gt * bfhi(w.y); } }
            float ss = 0.f;
#pragma unroll
            for (int j = 0; j < 8; ++j) ss += (v[j][0] * v[j][0] + v[j][1] * v[j][1]) + (v[j][2] * v[j][2] + v[j][3] * v[j][3]);
            const float rs = rsqrtf(wave_sum(ss) * (1.0f / D) + EPS);
            GAS f32x4* o = (GAS f32x4*)(args.out + (size_t)t * D);
#pragma unroll
            for (int j = 0; j < 8; ++j) { const f32x4 gg = ((const GAS f32x4*)nfg)[F.lane + 64 * j]; o[F.lane + 64 * j] = v[j] * rs * gg; }
        }
    }
#undef IN
#undef SEAM
}
constexpr int N_PHASES = 12;
}

#ifndef MK_CUTS
#define MK_CUTS 0
#endif
extern "C" void kernel_launch(void* const* d_in, const int* in_sizes, int n_in, void* d_out, int out_size, void* d_ws, size_t ws_size, hipStream_t stream) {
    using namespace mk;
    static int grid = 0;
    if (grid == 0) {
        int dev = 0, cus = 0;
        if (hipGetDevice(&dev) != hipSuccess || hipDeviceGetAttribute(&cus, hipDeviceAttributeMultiprocessorCount, dev) != hipSuccess) { grid = -1; return; }
        if (hipFuncSetAttribute((const void*)mk_fwd, hipFuncAttributeMaxDynamicSharedMemorySize, LDS_BYTES) != hipSuccess) { grid = -1; return; }
        int per_cu = 0;
        if (hipOccupancyMaxActiveBlocksPerMultiprocessor(&per_cu, (const void*)mk_fwd, NWAVES * 64, LDS_BYTES) != hipSuccess || per_cu < 1) { fprintf(stderr, "kernel_launch: occupancy query says %d\n", per_cu); }
        (void)hipGetLastError();
        grid = cus;
    }
    if (grid < 0) return;
    (void)hipMemsetAsync((char*)d_ws + WS_CTL, 0, CTL_ZERO_BYTES, stream);
    Args a{};
    for (int i = 0; i < 20; ++i) a.in[i] = (const float*)d_in[i];
    a.out = (float*)d_out; a.ws = (unsigned char*)d_ws;
#if MK_CUTS == 0
    a.ph_lo = 0; a.ph_hi = N_PHASES; a.li = 0; a.pad = 0;
    hipLaunchKernelGGL(mk_fwd, dim3(grid), dim3(NWAVES * 64), LDS_BYTES, stream, a);
#else
    for (int p = 0; p < N_PHASES; ++p) { a.ph_lo = p; a.ph_hi = p + 1; a.li = 0; a.pad = 0; hipLaunchKernelGGL(mk_fwd, dim3(grid), dim3(NWAVES * 64), LDS_BYTES, stream, a); }
#endif
}
```

```cpp
#include <hip/hip_runtime.h>
#include <cstdio>
#include <cstdint>
namespace pg8 {
#define PG8_LAS __attribute__((address_space(3)))
typedef unsigned short bf16_t;
typedef short bf16x8 __attribute__((ext_vector_type(8)));
typedef float f32x4 __attribute__((ext_vector_type(4)));
typedef unsigned u32x4 __attribute__((ext_vector_type(4)));
typedef int pg8_v4i __attribute__((ext_vector_type(4)));
constexpr int BM = 256, BK = 64, HALF = 128, HTB = HALF * BK * 2  , STAGE_BYTES = 8 * HTB, NXCD = 8, WGM = 8;

__host__ __device__ __forceinline__ int lds_byte(int r, int c) { const int st = (r >> 4) * 2 + (c >> 5), rr = r & 15, cc = c & 31, ob = rr * 64 + cc * 2; return st * 1024 + (ob ^ (((ob >> 9) & 1) << 5)); }
__host__ __device__ __forceinline__ void stage_rc(int b, int& R, int& C) { const int st = b / 1024, sb = b % 1024, swz = sb ^ (((sb >> 9) & 1) << 5); R = (st >> 1) * 16 + swz / 64; C = (st & 1) * 32 + (swz % 64) / 2; }
__host__ __device__ __forceinline__ int perm32(int rho) { const int n = rho >> 4, i = rho & 15; return 8 * (i >> 2) + 4 * n + (i & 3); }

struct Unit { int pm, pn; };
struct Gemm { const bf16_t* A; const bf16_t* Bt; int M, N, K; };

struct StaticOrder {
    int nM, nN, nwg, G, c;
    __host__ __device__ void init(int M, int N, int G_, int c_) { nM = M / BM; nN = N / BM; nwg = nM * nN; G = G_; c = c_; }
    __host__ __device__ bool next(int i, Unit& u) const {
        const long L = (long)i * G + c; if (L >= nwg) return false;
        int wgid = (int)L; { const int q = nwg / NXCD, r = nwg % NXCD, xcd = wgid % NXCD, off = wgid / NXCD; wgid = (xcd < r ? xcd * (q + 1) : r * (q + 1) + (xcd - r) * q) + off; }
        const int nig = WGM * nN, gid = wgid / nig, fm = gid * WGM, gsz = (nM - fm) < WGM ? (nM - fm) : WGM;
        u.pm = fm + ((wgid % nig) % gsz); u.pn = (wgid % nig) / gsz; return true;
    }
    __device__ __forceinline__ void a_ready(const Unit&) const {}
    __device__ __forceinline__ void done(const Unit&) const {}
};

__device__ __forceinline__ unsigned cvt_pk_bf16(float lo, float hi) { unsigned r; asm volatile("v_cvt_pk_bf16_f32 %0, %1, %2" : "=v"(r) : "v"(lo), "v"(hi)); return r; }
template <class Epi, class Sched, bool ALIGN_EPI = false, bool SP2 = false, int F8W = 0, int F8X = 0, int HOOK_T = 0>
__device__ __forceinline__ void gemm_phase(PG8_LAS unsigned char* lds, const Gemm g, const Sched& S, const Epi& E) {
    const int tid = threadIdx.x, wid = __builtin_amdgcn_readfirstlane(tid >> 6), lane = tid & 63, wr = wid >> 2, wc = wid & 3, fr = lane & 15, fq = lane >> 4;
    const int K = g.K, nt = K / BK;
    int f8w_ = F8W, f8x_ = F8X; asm volatile("" : "+v"(f8w_), "+v"(f8x_));
    unsigned voffA[2], voffB[2];
#pragma unroll
    for (int i = 0; i < 2; ++i) { int R, C; stage_rc(tid * 16 + i * 8192, R, C); const int Rb = Epi::PERM ? ((R & ~31) + perm32(R & 31)) : R;
        voffA[i] = (unsigned)(R * K + C) * 2u; voffB[i] = (unsigned)(Rb * K + C) * 2u; }
    const size_t kstep = (size_t)(BK * 2);
    const size_t hstep = (size_t)HALF * K * 2;
    const size_t tstep = 2 * hstep;
    const unsigned ldsw = (unsigned)wid * 1024u;
    const int aoff = lds_byte(wr * 64 + fr, fq * 8), boff = lds_byte(wc * 32 + fr, fq * 8);
#define PG8_SA(b, h) (((b) * 2 + (h)) * HTB)
#define PG8_SB(b, h) ((4 + (b) * 2 + (h)) * HTB)
#define PG8_STAGE(bufoff, gbase, voff) do { _Pragma("unroll") for (int _i = 0; _i < 2; ++_i) \
        __builtin_amdgcn_global_load_lds((const unsigned*)((const char*)(gbase) + (voff)[_i]), (PG8_LAS unsigned*)(lds + (bufoff) + ldsw + _i * 8192), 16, 0, 0); } while (0)
#define PG8_LDA(dst, b, h) do { _Pragma("unroll") for (int m = 0; m < 4; ++m) _Pragma("unroll") for (int k = 0; k < 2; ++k) dst[m][k] = *(const PG8_LAS bf16x8*)(lds + PG8_SA(b, h) + aoff + m * 2048 + k * 1024); } while (0)
#define PG8_LDB(dst, b, h) do { _Pragma("unroll") for (int n = 0; n < 2; ++n) _Pragma("unroll") for (int k = 0; k < 2; ++k) dst[n][k] = *(const PG8_LAS bf16x8*)(lds + PG8_SB(b, h) + boff + n * 2048 + k * 1024); } while (0)
#define PG8_CAT8(lo, hi) __builtin_shufflevector(__builtin_bit_cast(pg8_v4i, lo), __builtin_bit_cast(pg8_v4i, hi), 0, 1, 2, 3, 4, 5, 6, 7)
#define PG8_MMA(ai, bj, At, Bt) do { __builtin_amdgcn_s_setprio(1); if constexpr (F8W != 0) { _Pragma("unroll") for (int m = 0; m < 4; ++m) _Pragma("unroll") for (int n = 0; n < 2; ++n) \
        asm volatile("v_mfma_scale_f32_16x16x128_f8f6f4 %0, %1, %2, %0, %3, %4 op_sel_hi:[0,0,0]" : "+v"(acc[ai][bj][m][n]) : "v"(PG8_CAT8(Bt[n][0], Bt[n][1])), "v"(PG8_CAT8(At[m][0], At[m][1])), "v"(f8w_), "v"(f8x_)); } else { \
        _Pragma("unroll") for (int m = 0; m < 4; ++m) _Pragma("unroll") for (int n = 0; n < 2; ++n) _Pragma("unroll") for (int k = 0; k < 2; ++k) \
        acc[ai][bj][m][n] = __builtin_amdgcn_mfma_f32_16x16x32_bf16(Bt[n][k], At[m][k], acc[ai][bj][m][n], 0, 0, 0); } __builtin_amdgcn_s_setprio(0); } while (0)
#define PG8_WAIT_V(n) asm volatile("s_waitcnt vmcnt(" #n ")" ::: "memory")
#define PG8_WAIT_L(n) asm volatile("s_waitcnt lgkmcnt(" #n ")" ::: "memory")
#define PG8_BAR __builtin_amdgcn_s_barrier()
#define PG8_SCHED __builtin_amdgcn_sched_barrier(0)
    Unit cur, nxt; int ui = 0;
    typename Epi::Pre pre;
    if (!S.next(0, cur)) return;
    f32x4 acc[2][2][4][2];
#pragma unroll
    for (int a = 0; a < 2; ++a)
#pragma unroll
        for (int b = 0; b < 2; ++b)
#pragma unroll
            for (int m = 0; m < 4; ++m)
#pragma unroll
                for (int n = 0; n < 2; ++n) acc[a][b][m][n] = (f32x4){0.f, 0.f, 0.f, 0.f};
    bf16x8 At[4][2], B0[2][2], B1[2][2];
    const char* cA = (const char*)g.A + (size_t)cur.pm * tstep; const char* cB = (const char*)g.Bt + (size_t)cur.pn * tstep;
    S.a_ready(cur);
    if constexpr (SP2) {
        PG8_STAGE(PG8_SB(0, 0), cB, voffB); PG8_STAGE(PG8_SB(0, 1), cB + hstep, voffB); PG8_STAGE(PG8_SA(0, 0), cA, voffA); PG8_STAGE(PG8_SA(0, 1), cA + hstep, voffA);
        if (wr == 1) PG8_BAR;
        PG8_WAIT_V(2); PG8_BAR;
        PG8_STAGE(PG8_SB(1, 0), cB + kstep, voffB); PG8_STAGE(PG8_SA(1, 0), cA + kstep, voffA); PG8_STAGE(PG8_SB(1, 1), cB + hstep + kstep, voffB);
        PG8_WAIT_V(6); PG8_BAR;
    } else {
        PG8_STAGE(PG8_SB(0, 0), cB, voffB); PG8_STAGE(PG8_SA(0, 0), cA, voffA); PG8_STAGE(PG8_SB(0, 1), cB + hstep, voffB); PG8_STAGE(PG8_SA(0, 1), cA + hstep, voffA);
        if (wr == 1) PG8_BAR;
        PG8_WAIT_V(4); PG8_BAR;
        PG8_STAGE(PG8_SB(1, 0), cB + kstep, voffB); PG8_STAGE(PG8_SA(1, 0), cA + kstep, voffA); PG8_STAGE(PG8_SB(1, 1), cB + hstep + kstep, voffB);
        PG8_WAIT_V(6); PG8_BAR;
    }
    for (;;) {
        const bool has_next = S.next(ui + 1, nxt);
        const char* nA = has_next ? (const char*)g.A + (size_t)nxt.pm * tstep : cA; const char* nB = has_next ? (const char*)g.Bt + (size_t)nxt.pn * tstep : cB;
        for (int t = 0; t < nt; t += 2) {
            if constexpr (HOOK_T > 0) { if (t == HOOK_T) E.mid(acc, cur, wr, wc, fr, fq); }
            const bool last = (t == nt - 2);
            const char* a1 = cA + (size_t)(t + 1) * kstep;
            const char* a2 = last ? nA : cA + (size_t)(t + 2) * kstep; const char* b2 = last ? nB : cB + (size_t)(t + 2) * kstep;
            const char* a3 = a2 + kstep; const char* b3 = b2 + kstep;
            if (last && has_next) S.a_ready(nxt);
            if (last) E.preload(pre, cur, wr, wc, fr, fq);
            if constexpr (SP2) {
            PG8_LDB(B0, 0, 0); PG8_LDB(B1, 0, 1); PG8_SCHED; PG8_LDA(At, 0, 0); PG8_STAGE(PG8_SA(1, 1), a1 + hstep, voffA);
            PG8_WAIT_V(8); PG8_WAIT_L(0); PG8_BAR; PG8_MMA(0, 0, At, B0); PG8_MMA(0, 1, At, B1); PG8_BAR; PG8_SCHED;
            PG8_LDA(At, 0, 1); PG8_STAGE(PG8_SB(0, 0), b2, voffB); PG8_STAGE(PG8_SB(0, 1), b2 + hstep, voffB); PG8_STAGE(PG8_SA(0, 0), a2, voffA);
            PG8_WAIT_V(8); PG8_WAIT_L(0); PG8_BAR; PG8_MMA(1, 0, At, B0); PG8_MMA(1, 1, At, B1); PG8_BAR; PG8_SCHED;
            PG8_LDB(B0, 1, 0); PG8_LDB(B1, 1, 1); PG8_SCHED; PG8_LDA(At, 1, 0); PG8_STAGE(PG8_SA(0, 1), a2 + hstep, voffA);
            PG8_WAIT_V(8); PG8_WAIT_L(0); PG8_BAR; PG8_MMA(0, 0, At, B0); PG8_MMA(0, 1, At, B1); PG8_BAR; PG8_SCHED;
            PG8_LDA(At, 1, 1); PG8_STAGE(PG8_SB(1, 0), b3, voffB); PG8_STAGE(PG8_SB(1, 1), b3 + hstep, voffB); PG8_STAGE(PG8_SA(1, 0), a3, voffA);
            PG8_WAIT_V(8); PG8_WAIT_L(0); PG8_BAR; PG8_MMA(1, 0, At, B0); PG8_MMA(1, 1, At, B1); PG8_BAR; PG8_SCHED;
            } else {
            PG8_LDB(B0, 0, 0); PG8_SCHED; PG8_LDA(At, 0, 0); PG8_STAGE(PG8_SA(1, 1), a1 + hstep, voffA);
            PG8_WAIT_L(8); PG8_BAR; PG8_WAIT_L(0); PG8_MMA(0, 0, At, B0); PG8_BAR; PG8_SCHED;
            PG8_LDB(B1, 0, 1); PG8_STAGE(PG8_SB(0, 0), b2, voffB);
            PG8_BAR; PG8_WAIT_L(0); PG8_MMA(0, 1, At, B1); PG8_BAR;
            PG8_LDA(At, 0, 1); PG8_STAGE(PG8_SA(0, 0), a2, voffA);
            PG8_BAR; PG8_WAIT_L(0); PG8_MMA(1, 0, At, B0); PG8_BAR; PG8_SCHED;
            PG8_STAGE(PG8_SB(0, 1), b2 + hstep, voffB);
            PG8_WAIT_V(6); PG8_BAR; PG8_MMA(1, 1, At, B1); PG8_BAR;
            PG8_LDB(B0, 1, 0); PG8_SCHED; PG8_LDA(At, 1, 0); PG8_STAGE(PG8_SA(0, 1), a2 + hstep, voffA);
            PG8_WAIT_L(8); PG8_BAR; PG8_WAIT_L(0); PG8_MMA(0, 0, At, B0); PG8_BAR; PG8_SCHED;
            PG8_LDB(B1, 1, 1); PG8_STAGE(PG8_SB(1, 0), b3, voffB);
            PG8_BAR; PG8_WAIT_L(0); PG8_MMA(0, 1, At, B1); PG8_BAR;
            PG8_LDA(At, 1, 1); PG8_STAGE(PG8_SA(1, 0), a3, voffA);
            PG8_BAR; PG8_WAIT_L(0); PG8_MMA(1, 0, At, B0); PG8_BAR; PG8_SCHED;
            PG8_STAGE(PG8_SB(1, 1), b3 + hstep, voffB);
            PG8_WAIT_V(6); PG8_BAR; PG8_MMA(1, 1, At, B1); PG8_BAR;
            }
        }
        if constexpr (F8W != 0) asm volatile("s_nop 15\n\ts_nop 15" ::: "memory");
        if constexpr (ALIGN_EPI) { if (wr == 0) PG8_BAR; }
        if constexpr (!Epi::AFTER_DRAIN) { E(acc, cur, wr, wc, fr, fq, pre); S.done(cur); }
        if (!has_next) break;
#pragma unroll
        for (int a = 0; a < 2; ++a)
#pragma unroll
            for (int b = 0; b < 2; ++b)
#pragma unroll
                for (int m = 0; m < 4; ++m)
#pragma unroll
                    for (int n = 0; n < 2; ++n) acc[a][b][m][n] = (f32x4){0.f, 0.f, 0.f, 0.f};
        cur = nxt; cA = nA; cB = nB; ++ui;
        if constexpr (ALIGN_EPI) { if (wr == 1) PG8_BAR; }
    }
    PG8_WAIT_V(0);
    if constexpr (!ALIGN_EPI) { if (wr == 0) PG8_BAR; }
    PG8_BAR;
    if constexpr (Epi::AFTER_DRAIN) { E.fused(acc, cur, wr, wc, fr, fq, lds, wid, lane); S.done(cur); }
#undef PG8_SA
#undef PG8_SB
#undef PG8_STAGE
#undef PG8_LDA
#undef PG8_LDB
#undef PG8_MMA
#undef PG8_CAT8
#undef PG8_WAIT_V
#undef PG8_WAIT_L
#undef PG8_BAR
#undef PG8_SCHED
}
}
#define GAS __attribute__((address_space(1)))
#define LAS __attribute__((address_space(3)))
namespace mk {
using pg8::bf16_t; using pg8::bf16x8; using pg8::f32x4; using pg8::u32x4; using pg8::Unit; using pg8::cvt_pk_bf16;
typedef float f32x16 __attribute__((ext_vector_type(16)));
typedef float f32x2 __attribute__((ext_vector_type(2)));
typedef unsigned u32x2 __attribute__((ext_vector_type(2)));
typedef GAS unsigned gu32;
typedef __bf16 bf16x2_t __attribute__((ext_vector_type(2)));
__device__ __forceinline__ unsigned cvt_pk(float lo, float hi) { f32x2 v = {lo, hi}; bf16x2_t b = __builtin_convertvector(v, bf16x2_t); return __builtin_bit_cast(unsigned, b); }
#define RLX_AGENT __ATOMIC_RELAXED, __HIP_MEMORY_SCOPE_AGENT
#define LDS_WAIT() asm volatile("s_waitcnt lgkmcnt(0)" ::: "memory")
#define VM_WAIT() asm volatile("s_waitcnt vmcnt(0)" ::: "memory")

constexpr int T = 8192, D = 2048, DIN = 10752, DC = 1024, NH = 12, HD = 128, AW = 1536, AO = 512, NE = 32, DE = 2048, TOPK = 4;
constexpr float EPS = 1e-5f;
constexpr float QSCALE = 0.12751743082459868f;
constexpr float LN2 = 0.6931471805599453f;
constexpr int MAXRT = 160, NROWS = MAXRT * 256;
constexpr int NWAVES = 8;

constexpr size_t MiB = 1u << 20;
constexpr size_t WS_CTL = 0, CTL_ZERO_BYTES = 64 * 1024;
constexpr size_t WS_WIN = 1 * MiB;
constexpr size_t WS_WCO = 43 * MiB;
constexpr size_t WS_WAO = 47 * MiB;
constexpr size_t WS_WOUT = 49 * MiB;
constexpr size_t WS_WE1 = 57 * MiB;
constexpr size_t WS_WE2 = 569 * MiB;
constexpr size_t WS_H = 825 * MiB;
constexpr size_t WS_U = 857 * MiB;
constexpr size_t WS_Q = 873 * MiB, WS_K = 897 * MiB, WS_V = 921 * MiB;
constexpr size_t WS_GATE = 945 * MiB;
constexpr size_t WS_UC = 1009 * MiB;
constexpr size_t WS_OG = 1025 * MiB;
constexpr size_t WS_LSE = 1073 * MiB;
constexpr size_t WS_OC = 1074 * MiB;
constexpr size_t WS_M1 = 1082 * MiB;
constexpr int KCAT = DC + AO;
constexpr size_t WS_MG = 1146 * MiB;
constexpr size_t WS_X1 = 1178 * MiB;
constexpr size_t WS_H2 = 1242 * MiB;
constexpr size_t WS_AE = 1274 * MiB, WS_APOS = 1275 * MiB, WS_AGATE = 1276 * MiB, WS_ASLOT = 1277 * MiB;
constexpr size_t WS_HIST = WS_ASLOT + 512 * 1024;
constexpr size_t WS_XG = 1278 * MiB;
constexpr size_t WS_ACT = 1438 * MiB;
constexpr size_t WS_Y = 1598 * MiB;
constexpr size_t WS_END = 1758 * MiB;
constexpr int CW_CNT = 64;
constexpr int CW_BAR = 4096;

constexpr int RING_BYTES = 131072;
constexpr int LDSCTL_OFF = RING_BYTES, MISC_OFF = LDSCTL_OFF + 320, TAB_OFF = LDSCTL_OFF + 1024;
constexpr int LDS_BYTES = 147456;

__device__ __forceinline__ unsigned f2bf(float f) { unsigned u = __builtin_bit_cast(unsigned, f); return (u + 0x7fffu + ((u >> 16) & 1u)) >> 16; }
__device__ __forceinline__ unsigned pk2(float lo, float hi) { return f2bf(lo) | (f2bf(hi) << 16); }
__device__ __forceinline__ float bflo(unsigned w) { return __builtin_bit_cast(float, w << 16); }
__device__ __forceinline__ float bfhi(unsigned w) { return __builtin_bit_cast(float, w & 0xffff0000u); }
__device__ __forceinline__ unsigned pk4_fp8(float a, float b, float c, float d) { int w = __builtin_amdgcn_cvt_pk_fp8_f32(a, b, 0, false); w = __builtin_amdgcn_cvt_pk_fp8_f32(c, d, w, true); return (unsigned)w; }
constexpr float S_Y = 16.0f;
constexpr float S_W = 128.0f, S_X = 16.0f, S_ACT = 4.0f;
constexpr int E8_W = 127 - 7, E8_X = 127 - 4, E8_ACT = 127 - 2;
__device__ __forceinline__ float sigm(float x) { return __builtin_amdgcn_rcpf(1.0f + __expf(-x)); }
__device__ __forceinline__ float wave_sum(float v) {
#pragma unroll
    for (int o = 1; o < 64; o <<= 1) v += __shfl_xor(v, o);
    return v;
}
__device__ __forceinline__ float wave_max(float v) {
#pragma unroll
    for (int o = 1; o < 64; o <<= 1) v = fmaxf(v, __shfl_xor(v, o));
    return v;
}

struct EpiProj {
    static constexpr bool PERM = true, AFTER_DRAIN = false;
    bf16_t *U, *Q, *G; const float* bgate;
    struct Pre { f32x4 bv[2][2]; };
    __device__ __forceinline__ void preload(Pre& p, const Unit& u, int wr, int wc, int fr, int fq) const { if (u.pn >= 26) { const int c0 = (u.pn - 26) * 256 + wc * 32 + 8 * fq;
#pragma unroll
        for (int bj = 0; bj < 2; ++bj)
#pragma unroll
            for (int n = 0; n < 2; ++n) p.bv[bj][n] = *(const f32x4*)(bgate + c0 + bj * 128 + 4 * n); } }
    __device__ __forceinline__ void operator()(const f32x4 (&acc)[2][2][4][2], const Unit& u, int wr, int wc, int fr, int fq, const Pre& pre) const {
        const int row0 = u.pm * 256 + wr * 64 + fr, cl = wc * 32 + 8 * fq;
        if (u.pn < 8) {
#pragma unroll
            for (int ai = 0; ai < 2; ++ai)
#pragma unroll
                for (int m = 0; m < 4; ++m) {
                    const f32x4 a0 = acc[ai][0][m][0], a1 = acc[ai][0][m][1], g0 = acc[ai][1][m][0], g1 = acc[ai][1][m][1];
                    u32x4 w; w.x = cvt_pk(a0[0] * sigm(g0[0]), a0[1] * sigm(g0[1])); w.y = cvt_pk(a0[2] * sigm(g0[2]), a0[3] * sigm(g0[3]));
                    w.z = cvt_pk(a1[0] * sigm(g1[0]), a1[1] * sigm(g1[1])); w.w = cvt_pk(a1[2] * sigm(g1[2]), a1[3] * sigm(g1[3]));
                    *(u32x4*)(U + (size_t)(row0 + ai * 128 + m * 16) * DC + u.pn * 128 + cl) = w; }
        } else if (u.pn < 26) {
            const int s = (u.pn - 8) / 6, pl = (u.pn - 8) % 6; bf16_t* base = Q + (size_t)s * ((WS_K - WS_Q) / 2); const float sc = (s == 0) ? QSCALE : 1.0f;
#pragma unroll
            for (int ai = 0; ai < 2; ++ai)
#pragma unroll
                for (int m = 0; m < 4; ++m) { bf16_t* rowp = base + (size_t)(row0 + ai * 128 + m * 16) * AW + pl * 256 + cl;
#pragma unroll
                    for (int bj = 0; bj < 2; ++bj) { const f32x4 v0 = acc[ai][bj][m][0] * sc, v1 = acc[ai][bj][m][1] * sc;
                        u32x4 w; w.x = cvt_pk(v0[0], v0[1]); w.y = cvt_pk(v0[2], v0[3]); w.z = cvt_pk(v1[0], v1[1]); w.w = cvt_pk(v1[2], v1[3]);
                        *(u32x4*)(rowp + bj * 128) = w; } }
        } else {
            const int c0 = (u.pn - 26) * 256 + cl;
            const f32x4 (&bv)[2][2] = pre.bv;
#pragma unroll
            for (int ai = 0; ai < 2; ++ai)
#pragma unroll
                for (int m = 0; m < 4; ++m) { bf16_t* rowp = G + (size_t)(row0 + ai * 128 + m * 16) * (2 * D) + c0;
#pragma unroll
                    for (int bj = 0; bj < 2; ++bj) { const f32x4 v0 = acc[ai][bj][m][0] + bv[bj][0], v1 = acc[ai][bj][m][1] + bv[bj][1];
                        u32x4 w; w.x = cvt_pk(sigm(v0[0]), sigm(v0[1])); w.y = cvt_pk(sigm(v0[2]), sigm(v0[3])); w.z = cvt_pk(sigm(v1[0]), sigm(v1[1])); w.w = cvt_pk(sigm(v1[2]), sigm(v1[3]));
                        *(u32x4*)(rowp + bj * 128) = w; } }
        }
    }
};
struct EpiConvOut {
    static constexpr bool PERM = false, AFTER_DRAIN = false;
    float* M1; const bf16_t* G; const float* bco;
    struct Pre {}; __device__ __forceinline__ void preload(Pre&, const Unit&, int, int, int, int) const {}
    __device__ __forceinline__ void operator()(const f32x4 (&acc)[2][2][4][2], const Unit& u, int wr, int wc, int fr, int fq, const Pre& pre) const {
        const int row0 = u.pm * 256 + wr * 64 + fr, col0 = u.pn * 256 + wc * 32 + 4 * fq;
        f32x4 bv[2][2];
#pragma unroll
        for (int bj = 0; bj < 2; ++bj)
#pragma unroll
            for (int n = 0; n < 2; ++n) bv[bj][n] = *(const f32x4*)(bco + col0 + bj * 128 + n * 16);
#pragma unroll
        for (int ai = 0; ai < 2; ++ai)
#pragma unroll
            for (int m = 0; m < 4; ++m) { const size_t row = (size_t)(row0 + ai * 128 + m * 16);
#pragma unroll
                for (int bj = 0; bj < 2; ++bj)
#pragma unroll
                    for (int n = 0; n < 2; ++n) { const int col = col0 + bj * 128 + n * 16;
                        const u32x2 gw = *(const u32x2*)(G + row * (2 * D) + col); const f32x4 v = acc[ai][bj][m][n] + bv[bj][n];
                        f32x4 o; o[0] = bflo(gw.x) * v[0]; o[1] = bfhi(gw.x) * v[1]; o[2] = bflo(gw.y) * v[2]; o[3] = bfhi(gw.y) * v[3];
                        *(f32x4*)(M1 + row * D + col) = o; } }
    }
};
struct EpiAttnOut {
    static constexpr bool PERM = false, AFTER_DRAIN = false;
    const float* M1; const bf16_t* G; bf16_t* MG;
    struct Pre {}; __device__ __forceinline__ void preload(Pre&, const Unit&, int, int, int, int) const {}
    __device__ __forceinline__ void operator()(const f32x4 (&acc)[2][2][4][2], const Unit& u, int wr, int wc, int fr, int fq, const Pre& pre) const {
        const int row0 = u.pm * 256 + wr * 64 + fr, col0 = u.pn * 256 + wc * 32 + 4 * fq;
#pragma unroll
        for (int ai = 0; ai < 2; ++ai)
#pragma unroll
            for (int m = 0; m < 4; ++m) { const size_t row = (size_t)(row0 + ai * 128 + m * 16);
#pragma unroll
                for (int bj = 0; bj < 2; ++bj)
#pragma unroll
                    for (int n = 0; n < 2; ++n) { const int col = col0 + bj * 128 + n * 16;
                        const u32x2 gw = *(const u32x2*)(G + row * (2 * D) + D + col); const f32x4 v = acc[ai][bj][m][n]; const f32x4 m1 = *(const f32x4*)(M1 + row * D + col);
                        u32x2 w; w.x = cvt_pk(m1[0] + bflo(gw.x) * v[0], m1[1] + bfhi(gw.x) * v[1]); w.y = cvt_pk(m1[2] + bflo(gw.y) * v[2], m1[3] + bfhi(gw.y) * v[3]);
                        *(u32x2*)(MG + row * D + col) = w; } }
    }
};
struct EpiMerge {
    static constexpr bool PERM = true, AFTER_DRAIN = false;
    const bf16_t* G; const float* bco; bf16_t* MG;
    struct Pre {}; __device__ __forceinline__ void preload(Pre&, const Unit&, int, int, int, int) const {}
    __device__ __forceinline__ void mid(f32x4 (&acc)[2][2][4][2], const Unit& u, int wr, int wc, int fr, int fq) const {
        int zo = 0; asm volatile("" : "+v"(zo));
        const int row0 = u.pm * 256 + wr * 64 + fr + zo, c0 = u.pn * 256 + wc * 32 + 8 * fq + zo;
        f32x4 bv[2][2];
#pragma unroll
        for (int bj = 0; bj < 2; ++bj) { bv[bj][0] = *(const f32x4*)(bco + c0 + bj * 128); bv[bj][1] = *(const f32x4*)(bco + c0 + bj * 128 + 4); }
#pragma unroll
        for (int ai = 0; ai < 2; ++ai)
#pragma unroll
            for (int m = 0; m < 4; ++m) { const bf16_t* gp = G + (size_t)(row0 + ai * 128 + m * 16) * (2 * D) + c0;
#pragma unroll
                for (int bj = 0; bj < 2; ++bj) { const u32x4 gc = *(const u32x4*)(gp + bj * 128), ga = *(const u32x4*)(gp + bj * 128 + D);
                    f32x4 r0, r1;
                    r0[0] = bflo(gc.x) * __builtin_amdgcn_rcpf(bflo(ga.x)); r0[1] = bfhi(gc.x) * __builtin_amdgcn_rcpf(bfhi(ga.x)); r0[2] = bflo(gc.y) * __builtin_amdgcn_rcpf(bflo(ga.y)); r0[3] = bfhi(gc.y) * __builtin_amdgcn_rcpf(bfhi(ga.y));
                    r1[0] = bflo(gc.z) * __builtin_amdgcn_rcpf(bflo(ga.z)); r1[1] = bfhi(gc.z) * __builtin_amdgcn_rcpf(bfhi(ga.z)); r1[2] = bflo(gc.w) * __builtin_amdgcn_rcpf(bflo(ga.w)); r1[3] = bfhi(gc.w) * __builtin_amdgcn_rcpf(bfhi(ga.w));
                    acc[ai][bj][m][0] = (acc[ai][bj][m][0] + bv[bj][0]) * r0; acc[ai][bj][m][1] = (acc[ai][bj][m][1] + bv[bj][1]) * r1; }
                asm volatile("" : "+v"(acc[ai][0][m][0]), "+v"(acc[ai][0][m][1]), "+v"(acc[ai][1][m][0]), "+v"(acc[ai][1][m][1]));
                asm volatile("" ::: "memory"); }
    }
    __device__ __forceinline__ void operator()(const f32x4 (&acc)[2][2][4][2], const Unit& u, int wr, int wc, int fr, int fq, const Pre& pre) const {
        const int row0 = u.pm * 256 + wr * 64 + fr, c0 = u.pn * 256 + wc * 32 + 8 * fq;
#pragma unroll
        for (int ai = 0; ai < 2; ++ai)
#pragma unroll
            for (int m = 0; m < 4; ++m) { const size_t row = (size_t)(row0 + ai * 128 + m * 16);
#pragma unroll
                for (int bj = 0; bj < 2; ++bj) { const u32x4 ga = *(const u32x4*)(G + row * (2 * D) + D + c0 + bj * 128); const f32x4 v0 = acc[ai][bj][m][0], v1 = acc[ai][bj][m][1];
                    u32x4 w; w.x = cvt_pk(v0[0] * bflo(ga.x), v0[1] * bfhi(ga.x)); w.y = cvt_pk(v0[2] * bflo(ga.y), v0[3] * bfhi(ga.y)); w.z = cvt_pk(v1[0] * bflo(ga.z), v1[1] * bfhi(ga.z)); w.w = cvt_pk(v1[2] * bflo(ga.w), v1[3] * bfhi(ga.w));
                    *(u32x4*)(MG + row * D + c0 + bj * 128) = w; } }
    }
};
struct EpiResid {
    static constexpr bool PERM = false, AFTER_DRAIN = false;
    const float* X; float* X1;
    struct Pre {}; __device__ __forceinline__ void preload(Pre&, const Unit&, int, int, int, int) const {}
    __device__ __forceinline__ void operator()(const f32x4 (&acc)[2][2][4][2], const Unit& u, int wr, int wc, int fr, int fq, const Pre& pre) const {
        const int row0 = u.pm * 256 + wr * 64 + fr, col0 = u.pn * 256 + wc * 32 + 4 * fq;
#pragma unroll
        for (int ai = 0; ai < 2; ++ai)
#pragma unroll
            for (int m = 0; m < 4; ++m) { const size_t off = (size_t)(row0 + ai * 128 + m * 16) * D + col0;
#pragma unroll
                for (int bj = 0; bj < 2; ++bj)
#pragma unroll
                    for (int n = 0; n < 2; ++n) { const f32x4 xv = *(const f32x4*)(X + off + bj * 128 + n * 16); *(f32x4*)(X1 + off + bj * 128 + n * 16) = xv + acc[ai][bj][m][n]; } }
    }
};
struct EpiSwiGLU {
    static constexpr bool PERM = true, AFTER_DRAIN = false;
    unsigned char* ACT; const float* bin;
    struct Pre { f32x4 bg[2], bu[2]; };
    __device__ __forceinline__ void preload(Pre& p, const Unit& u, int wr, int wc, int fr, int fq) const { const int e = u.pn >> 4, cl = (u.pn & 15) * 128 + wc * 32 + 8 * fq;
#pragma unroll
        for (int n = 0; n < 2; ++n) { p.bg[n] = *(const f32x4*)(bin + (size_t)e * (2 * DE) + cl + 4 * n); p.bu[n] = *(const f32x4*)(bin + (size_t)e * (2 * DE) + DE + cl + 4 * n); } }
    __device__ __forceinline__ void operator()(const f32x4 (&acc)[2][2][4][2], const Unit& u, int wr, int wc, int fr, int fq, const Pre& pre) const {
        const int e = u.pn >> 4, pl = u.pn & 15;
        const int row0 = u.pm * 256 + wr * 64 + fr, cl = pl * 128 + wc * 32 + 8 * fq;
        const f32x4 (&bg)[2] = pre.bg; const f32x4 (&bu)[2] = pre.bu; (void)e;
#pragma unroll
        for (int ai = 0; ai < 2; ++ai)
#pragma unroll
            for (int m = 0; m < 4; ++m) {
                float o[8];
#pragma unroll
                for (int n = 0; n < 2; ++n) { const f32x4 gv = acc[ai][0][m][n] + bg[n], uv = acc[ai][1][m][n] + bu[n];
#pragma unroll
                    for (int q = 0; q < 4; ++q) { const float gg = fminf(gv[q], 7.0f), uu = fminf(fmaxf(uv[q], -7.0f), 7.0f); o[4 * n + q] = (uu + 1.0f) * (gg * sigm(1.702f * gg)); } }
                u32x2 w; w.x = pk4_fp8(o[0] * S_ACT, o[1] * S_ACT, o[2] * S_ACT, o[3] * S_ACT); w.y = pk4_fp8(o[4] * S_ACT, o[5] * S_ACT, o[6] * S_ACT, o[7] * S_ACT);
                *(u32x2*)(ACT + (size_t)(row0 + ai * 128 + m * 16) * DE + cl) = w; }
    }
};
template <int VAR = 0> struct EpiExpOutT {
    static constexpr bool PERM = true, AFTER_DRAIN = false;
    unsigned char* Y; const float* bout;
    struct Pre { f32x4 bv[2][2]; };
    __device__ __forceinline__ void preload(Pre& p, const Unit& u, int wr, int wc, int fr, int fq) const { const int e = u.pn >> 3, c0 = (u.pn & 7) * 256 + wc * 32 + 8 * fq;
#pragma unroll
        for (int bj = 0; bj < 2; ++bj)
#pragma unroll
            for (int n = 0; n < 2; ++n) p.bv[bj][n] = (VAR == 1) ? (f32x4){0.f, 0.f, 0.f, 0.f} : *(const f32x4*)(bout + (size_t)e * D + c0 + bj * 128 + 4 * n); }
    __device__ __forceinline__ void operator()(const f32x4 (&acc)[2][2][4][2], const Unit& u, int wr, int wc, int fr, int fq, const Pre& pre) const {
        const int e = u.pn >> 3, pl = u.pn & 7;
        const int row0 = u.pm * 256 + wr * 64 + fr, c0 = pl * 256 + wc * 32 + 8 * fq;
        const f32x4 (&bv)[2][2] = pre.bv; (void)e;
#pragma unroll
        for (int ai = 0; ai < 2; ++ai)
#pragma unroll
            for (int m = 0; m < 4; ++m) { unsigned char* rowp = Y + (size_t)(row0 + ai * 128 + m * 16) * D + c0;
#pragma unroll
                for (int bj = 0; bj < 2; ++bj) { const f32x4 v0 = acc[ai][bj][m][0] + bv[bj][0], v1 = acc[ai][bj][m][1] + bv[bj][1];
                    u32x2 w; w.x = pk4_fp8(v0[0] * S_Y, v0[1] * S_Y, v0[2] * S_Y, v0[3] * S_Y); w.y = pk4_fp8(v1[0] * S_Y, v1[1] * S_Y, v1[2] * S_Y, v1[3] * S_Y);
                    if (VAR == 2) asm volatile("" :: "v"(w)); else *(u32x2*)(rowp + bj * 128) = w; } }
    }
};
typedef EpiExpOutT<0> EpiExpOut;

struct EpiNull { static constexpr bool PERM = true, AFTER_DRAIN = false; struct Pre {}; __device__ __forceinline__ void preload(Pre&, const Unit&, int, int, int, int) const {} __device__ __forceinline__ void operator()(const f32x4 (&acc)[2][2][4][2], const Unit& u, int wr, int wc, int fr, int fq, const Pre& pre) const {} };
struct MoeOrder {
    const LAS unsigned* tab; int total, G, c;
    __device__ __forceinline__ bool next(int i, Unit& u) const {
        const int L = i * G + c; if (L >= total) return false;
        const unsigned w = tab[L];
        u.pn = __builtin_amdgcn_readfirstlane((int)(w >> 16)); u.pm = __builtin_amdgcn_readfirstlane((int)(w & 0xffffu)); return true;
    }
    __device__ __forceinline__ void a_ready(const Unit&) const {}
    __device__ __forceinline__ void done(const Unit&) const {}
};
__device__ __forceinline__ int moe_build_tab(LAS unsigned* tab, LAS int* myexp, const LAS int* rt0, int NT, int tid, int myx, int NX) {
    if (tid < NE) { const int mte = rt0[tid + 1] - rt0[tid]; int rank = 0;
        for (int q = 0; q < NE; ++q) { const int mq = rt0[q + 1] - rt0[q]; rank += (mq > mte || (mq == mte && q < tid)) ? 1 : 0; }
        const int row = rank / NX, col = rank % NX, x = (row & 1) ? (NX - 1 - col) : col;
        if (x == myx) myexp[row] = tid; }
    __syncthreads();
    const int nmy = NE / NX; int total = 0;
    for (int j = 0; j < nmy; ++j) { const int e = myexp[j]; total += (rt0[e + 1] - rt0[e]) * NT; }
    for (int L = tid; L < total; L += NWAVES * 64) { int base = 0, e = myexp[0];
        for (int j = 0; j < nmy; ++j) { const int ej = myexp[j], uj = (rt0[ej + 1] - rt0[ej]) * NT; if (L >= base + uj) { base += uj; } else { e = ej; break; } }
        const int b = rt0[e], mt = rt0[e + 1] - b, idx = L - base;
        tab[L] = ((unsigned)(e * NT + idx / mt) << 16) | (unsigned)(b + idx % mt); }
    __syncthreads();
    return total;
}

#define XB_TMO      128
#define XB_XCNT(j)  (256  + 64 * (j))
#define XB_XSUB(j)  (1280 + 64 * (j))
#define XB_XGEN(j)  (2304 + 64 * (j))
#define XB_TOP      3328
#define XB_TOPGEN   3392
#define XCD_BAR_WORDS 3456
#define XB_SPIN_CAP (1u << 18)

__device__ __forceinline__ unsigned xb_ld(unsigned* p)              { return __hip_atomic_load(p, __ATOMIC_RELAXED, __HIP_MEMORY_SCOPE_AGENT); }
__device__ __forceinline__ unsigned xb_add(unsigned* p, unsigned v) { return __hip_atomic_fetch_add(p, v, __ATOMIC_RELAXED, __HIP_MEMORY_SCOPE_AGENT); }
__device__ __forceinline__ unsigned xb_xcc_id() { return (unsigned)__builtin_amdgcn_s_getreg((3 << 11) | 20) & 0xFu; }
#define XB_SPIN(cond, bar) do { unsigned _sp = 0; while (cond) { __builtin_amdgcn_s_sleep(1); \
    if ((++_sp & 255u) == 0u) { if (xb_ld(&(bar)[XB_TMO])) break; if (_sp > XB_SPIN_CAP) { atomicAdd(&(bar)[XB_TMO], 1u); break; } } } } while (0)

struct XcdBarrier {
    unsigned* bar; unsigned x;
    volatile LAS unsigned* st;
};

__device__ __forceinline__ XcdBarrier xcd_barrier_post(unsigned* bar, volatile LAS unsigned* st) {
    XcdBarrier b; b.bar = bar; b.x = xb_xcc_id(); b.st = st;
    if (threadIdx.x == 0) (void)xb_add(&bar[XB_XCNT(b.x)], 1u);
    return b;
}
__device__ __forceinline__ void xcd_barrier_complete(unsigned* bar, unsigned x, unsigned& nloc, unsigned& nx) {
    const unsigned G = gridDim.x * gridDim.y * gridDim.z;
    unsigned sum, cnt, mine, sp = 0u;
    for (;;) {
        sum = 0u; cnt = 0u; mine = 0u;
#pragma unroll
        for (unsigned j = 0; j < 16; ++j) { const unsigned c = xb_ld(&bar[XB_XCNT(j)]); sum += c; cnt += (c > 0u) ? 1u : 0u; mine = (j == x) ? c : mine; }
        if (sum == G) break;
        __builtin_amdgcn_s_sleep(1);
        if ((++sp & 255u) == 0u) { if (xb_ld(&bar[XB_TMO])) break; if (sp > XB_SPIN_CAP) { atomicAdd(&bar[XB_TMO], 1u); break; } }
    }
    nloc = mine > 0u ? mine : 1u; nx = cnt > 0u ? cnt : 1u;
}

__device__ __forceinline__ void xcd_barrier(const XcdBarrier& b) {
    asm volatile("s_waitcnt vmcnt(0)" ::: "memory");
    __syncthreads();
    if (threadIdx.x == 0) {
        unsigned* bar = b.bar;
        __builtin_amdgcn_s_waitcnt(0);
        unsigned nloc = b.st[0], nx = b.st[1];
        if (nloc == 0u) { xcd_barrier_complete(bar, b.x, nloc, nx); b.st[0] = nloc; b.st[1] = nx; }
        const unsigned old = xb_add(&bar[XB_XSUB(b.x)], 1u);
        const unsigned gen = old / nloc;
        if (old + 1u == (gen + 1u) * nloc) {
            __builtin_amdgcn_fence(__ATOMIC_RELEASE, "agent");
            asm volatile("s_waitcnt vmcnt(0)" ::: "memory");
            const unsigned og = xb_add(&bar[XB_TOP], 1u);
            const unsigned tg = og / nx;
            if (og + 1u == (tg + 1u) * nx) xb_add(&bar[XB_TOPGEN], 1u);
            else XB_SPIN(xb_ld(&bar[XB_TOPGEN]) == tg, bar);
            __builtin_amdgcn_fence(__ATOMIC_ACQUIRE, "agent");
            xb_add(&bar[XB_XGEN(b.x)], 1u);
            asm volatile("s_waitcnt vmcnt(0)" ::: "memory");
        } else {
            XB_SPIN(xb_ld(&bar[XB_XGEN(b.x)]) == gen, bar);
            __builtin_amdgcn_fence(__ATOMIC_ACQUIRE, "agent");
            asm volatile("s_waitcnt vmcnt(0)" ::: "memory");
        }
    }
    __syncthreads();
}

struct Frame {
    LAS unsigned char* lds; volatile LAS unsigned* MISC; gu32* ctl;
    int tid, lane, wave, vcu, G;
};
struct Args { const float* in[20]; float* out; unsigned char* ws; int ph_lo, ph_hi, li, pad; };

__device__ __forceinline__ void p0_transpose_item(const float* W, int K, int N, bf16_t* WT, int k0, int n0, int drow0, LAS float* scr, int lane) {
#pragma unroll 8
    for (int i = 0; i < 32; ++i) { const int kk = 2 * i + (lane >> 5); scr[kk * 33 + (lane & 31)] = W[(size_t)(k0 + kk) * N + n0 + (lane & 31)]; }
    LDS_WAIT(); asm volatile("" ::: "memory");
    const int c = lane & 7;
#pragma unroll
    for (int j = 0; j < 4; ++j) { const int n = (lane >> 3) + 8 * j; const LAS float* s = scr + (8 * c) * 33 + n;
        u32x4 o; o.x = pk2(s[0 * 33], s[1 * 33]); o.y = pk2(s[2 * 33], s[3 * 33]); o.z = pk2(s[4 * 33], s[5 * 33]); o.w = pk2(s[6 * 33], s[7 * 33]);
        *(GAS u32x4*)(WT + (size_t)(drow0 + n) * K + k0 + 8 * c) = o; }
    LDS_WAIT(); asm volatile("" ::: "memory");
}
__device__ __forceinline__ void p0_transpose_item_fp8(const float* W, int K, int N, unsigned char* WT, int k0, int n0, int drow0, LAS float* scr, int lane) {
#pragma unroll 8
    for (int i = 0; i < 32; ++i) { const int kk = 2 * i + (lane >> 5); scr[kk * 33 + (lane & 31)] = W[(size_t)(k0 + kk) * N + n0 + (lane & 31)]; }
    LDS_WAIT(); asm volatile("" ::: "memory");
    const int c = lane & 3;
#pragma unroll
    for (int j = 0; j < 2; ++j) { const int n = (lane >> 2) + 16 * j; const LAS float* s = scr + (16 * c) * 33 + n;
        u32x4 o; o.x = pk4_fp8(s[0 * 33] * S_W, s[1 * 33] * S_W, s[2 * 33] * S_W, s[3 * 33] * S_W); o.y = pk4_fp8(s[4 * 33] * S_W, s[5 * 33] * S_W, s[6 * 33] * S_W, s[7 * 33] * S_W);
        o.z = pk4_fp8(s[8 * 33] * S_W, s[9 * 33] * S_W, s[10 * 33] * S_W, s[11 * 33] * S_W); o.w = pk4_fp8(s[12 * 33] * S_W, s[13 * 33] * S_W, s[14 * 33] * S_W, s[15 * 33] * S_W);
        *(GAS u32x4*)(WT + (size_t)(drow0 + n) * K + k0 + 16 * c) = o; }
    LDS_WAIT(); asm volatile("" ::: "memory");
}
#ifndef MK_KGL
#define MK_KGL 3
#endif
constexpr int KGL = MK_KGL, KG = 1 << KGL, CV_K8 = 16 * KG, CV_K16 = 8 * KG, CV_N = 4 * (64 >> KGL);
template <int PMODE> __device__ __forceinline__ void cvt_task_fp8(const float* W, int N, unsigned char* WT, int K, int k0, int n0, int halfN, int lane) {
    const int n = n0 + 4 * (lane >> KGL), k = k0 + 16 * (lane & (KG - 1));
    const GAS f32x4* src = (const GAS f32x4*)(W + (size_t)k * N + n);
    f32x4 v[16];
#pragma unroll
    for (int i = 0; i < 16; ++i) v[i] = __builtin_nontemporal_load(src + (size_t)i * (N / 4));
    int dr = n;
    if (PMODE == 1 || (PMODE == 2 && n < 2 * halfN)) dr = (n < halfN) ? ((n >> 7) * 256 + (n & 127)) : (((n - halfN) >> 7) * 256 + 128 + ((n - halfN) & 127));
#pragma unroll
    for (int j = 0; j < 4; ++j) { u32x4 o;
        o.x = pk4_fp8(v[0][j] * S_W, v[1][j] * S_W, v[2][j] * S_W, v[3][j] * S_W); o.y = pk4_fp8(v[4][j] * S_W, v[5][j] * S_W, v[6][j] * S_W, v[7][j] * S_W);
        o.z = pk4_fp8(v[8][j] * S_W, v[9][j] * S_W, v[10][j] * S_W, v[11][j] * S_W); o.w = pk4_fp8(v[12][j] * S_W, v[13][j] * S_W, v[14][j] * S_W, v[15][j] * S_W);
        *(GAS u32x4*)(WT + (size_t)(dr + j) * K + k) = o; }
}
template <int PMODE> __device__ __forceinline__ void cvt_task_bf16(const float* W, int N, bf16_t* WT, int K, int k0, int n0, int halfN, int lane) {
    const int n = n0 + 4 * (lane >> KGL), k = k0 + 8 * (lane & (KG - 1));
    const GAS f32x4* src = (const GAS f32x4*)(W + (size_t)k * N + n);
    f32x4 v[8];
#pragma unroll
    for (int i = 0; i < 8; ++i) v[i] = src[(size_t)i * (N / 4)];
    int dr = n;
    if (PMODE == 1 || (PMODE == 2 && n < 2 * halfN)) dr = (n < halfN) ? ((n >> 7) * 256 + (n & 127)) : (((n - halfN) >> 7) * 256 + 128 + ((n - halfN) & 127));
#pragma unroll
    for (int j = 0; j < 4; ++j) { u32x4 o; o.x = cvt_pk(v[0][j], v[1][j]); o.y = cvt_pk(v[2][j], v[3][j]); o.z = cvt_pk(v[4][j], v[5][j]); o.w = cvt_pk(v[6][j], v[7][j]);
        *(GAS u32x4*)(WT + (size_t)(dr + j) * K + k) = o; }
}
struct CvDesc { const GAS f32x4* src; size_t stride4; unsigned char* dst; int K; };
__device__ __forceinline__ CvDesc cv_desc(int it, const float* w_ei, const float* w_eo, unsigned char* WE1, unsigned char* WE2, int lane) {
    constexpr int CVT1 = (D / CV_K8) * (2 * DE / CV_N), CVT2 = (DE / CV_K8) * (D / CV_N), CVTE = CVT1 + CVT2;
    const int e = it / CVTE, q = it % CVTE; CvDesc d;
    if (q < CVT1) { const int k = CV_K8 * (q / (2 * DE / CV_N)) + 16 * (lane & (KG - 1)), n = CV_N * (q % (2 * DE / CV_N)) + 4 * (lane >> KGL);
        const int dr = (n < DE) ? ((n >> 7) * 256 + (n & 127)) : (((n - DE) >> 7) * 256 + 128 + ((n - DE) & 127));
        d.src = (const GAS f32x4*)(w_ei + (size_t)e * D * 2 * DE + (size_t)k * (2 * DE) + n); d.stride4 = 2 * DE / 4; d.dst = WE1 + (size_t)e * 2 * DE * D + (size_t)dr * D + k; d.K = D; }
    else { const int r = q - CVT1; const int k = CV_K8 * (r / (D / CV_N)) + 16 * (lane & (KG - 1)), n = CV_N * (r % (D / CV_N)) + 4 * (lane >> KGL);
        d.src = (const GAS f32x4*)(w_eo + (size_t)e * DE * D + (size_t)k * D + n); d.stride4 = D / 4; d.dst = WE2 + (size_t)e * D * DE + (size_t)n * DE + k; d.K = DE; }
    return d;
}
__device__ __forceinline__ void cv_load(f32x4 (&v)[16], const CvDesc& d) {
#pragma unroll
    for (int i = 0; i < 16; ++i) v[i] = __builtin_nontemporal_load(d.src + (size_t)i * d.stride4);
}
__device__ __forceinline__ void cv_store(const f32x4 (&v)[16], const CvDesc& d) {
#pragma unroll
    for (int j = 0; j < 4; ++j) { u32x4 o;
        o.x = pk4_fp8(v[0][j] * S_W, v[1][j] * S_W, v[2][j] * S_W, v[3][j] * S_W); o.y = pk4_fp8(v[4][j] * S_W, v[5][j] * S_W, v[6][j] * S_W, v[7][j] * S_W);
        o.z = pk4_fp8(v[8][j] * S_W, v[9][j] * S_W, v[10][j] * S_W, v[11][j] * S_W); o.w = pk4_fp8(v[12][j] * S_W, v[13][j] * S_W, v[14][j] * S_W, v[15][j] * S_W);
        *(GAS u32x4*)(d.dst + (size_t)j * d.K) = o; }
}
template <bool PIPE> __device__ __forceinline__ void cv_run(int lo, int hi, int w0, int wn, const float* w_ei, const float* w_eo, unsigned char* WE1, unsigned char* WE2, int lane) {
  if constexpr (PIPE) {
    int it = lo + w0; if (it >= hi) return;
    f32x4 va[16], vb[16];
    CvDesc da = cv_desc(it, w_ei, w_eo, WE1, WE2, lane), db = da;
    cv_load(va, da);
    for (;;) {
        const int it2 = it + wn; const bool h2 = it2 < hi;
        db = cv_desc(h2 ? it2 : it, w_ei, w_eo, WE1, WE2, lane); cv_load(vb, db);
        cv_store(va, da);
        if (!h2) break;
        const int it3 = it2 + wn; const bool h3 = it3 < hi;
        da = cv_desc(h3 ? it3 : it2, w_ei, w_eo, WE1, WE2, lane); cv_load(va, da);
        cv_store(vb, db);
        if (!h3) break;
        it = it3;
    }
  } else {
    for (int it = lo + w0; it < hi; it += wn) { f32x4 v[16]; const CvDesc d = cv_desc(it, w_ei, w_eo, WE1, WE2, lane); cv_load(v, d); cv_store(v, d); }
  }
}
__device__ __forceinline__ int paired_row(int n0, int halfN) { return (n0 < halfN) ? ((n0 >> 7) * 256 + (n0 & 127)) : (((n0 - halfN) >> 7) * 256 + 128 + ((n0 - halfN) & 127)); }

__device__ __forceinline__ void rms_row_to_bf16(const float* xrow, const float* g, bf16_t* orow, int lane) {
    const GAS f32x4* xr = (const GAS f32x4*)xrow + lane;
    f32x4 v[8]; float ss = 0.f;
#pragma unroll
    for (int j = 0; j < 8; ++j) { v[j] = xr[64 * j]; ss += (v[j][0] * v[j][0] + v[j][1] * v[j][1]) + (v[j][2] * v[j][2] + v[j][3] * v[j][3]); }
    const float rs = rsqrtf(wave_sum(ss) * (1.0f / D) + EPS);
    GAS u32x2* o8 = (GAS u32x2*)orow + lane;
#pragma unroll
    for (int j = 0; j < 8; ++j) { const f32x4 gg = ((const GAS f32x4*)g)[lane + 64 * j]; u32x2 w; w.x = pk2(v[j][0] * rs * gg[0], v[j][1] * rs * gg[1]); w.y = pk2(v[j][2] * rs * gg[2], v[j][3] * rs * gg[3]); o8[64 * j] = w; }
}

__device__ __forceinline__ void rms_row_to_fp8(const float* xrow, const float* g, unsigned char* orow, int lane) {
    const GAS f32x4* xr = (const GAS f32x4*)xrow + lane;
    f32x4 v[8]; float ss = 0.f;
#pragma unroll
    for (int j = 0; j < 8; ++j) { v[j] = xr[64 * j]; ss += (v[j][0] * v[j][0] + v[j][1] * v[j][1]) + (v[j][2] * v[j][2] + v[j][3] * v[j][3]); }
    const float rs = rsqrtf(wave_sum(ss) * (1.0f / D) + EPS) * S_X;
    GAS unsigned* o4 = (GAS unsigned*)orow + lane;
#pragma unroll
    for (int j = 0; j < 8; ++j) { const f32x4 gg = ((const GAS f32x4*)g)[lane + 64 * j]; o4[64 * j] = pk4_fp8(v[j][0] * rs * gg[0], v[j][1] * rs * gg[1], v[j][2] * rs * gg[2], v[j][3] * rs * gg[3]); }
}

__device__ __forceinline__ void conv_tile(Frame& F, int tile, const bf16_t* U, const float* cw, const float* cb, const float* lg, const float* lb, bf16_t* UC) {
    const int t0 = tile * 32, c = 2 * F.tid;
    LAS float* ys = (LAS float*)F.lds;
    f32x2 w[31];
#pragma unroll
    for (int k = 0; k < 31; ++k) w[k] = *(const f32x2*)(cw + k * DC + c);
    const f32x2 bias = *(const f32x2*)(cb + c);
    f32x2 win[31];
#pragma unroll
    for (int p = 0; p < 30; ++p) { const int tt = t0 - 30 + p; unsigned v = 0u; if (tt >= 0) v = *(const unsigned*)(U + (size_t)tt * DC + c); win[p] = (f32x2){bflo(v), bfhi(v)}; }
    win[30] = (f32x2){0.f, 0.f};
#pragma unroll 1
    for (int jb = 0; jb < 32; jb += 31) {
#pragma unroll
        for (int p = 0; p < 31; ++p) {
            const int j = jb + p;
            if (j < 32) {
                const unsigned v = *(const unsigned*)(U + (size_t)(t0 + j) * DC + c);
                win[(30 + p) % 31] = (f32x2){bflo(v), bfhi(v)};
                f32x2 a = bias;
#pragma unroll
                for (int k = 0; k < 31; ++k) a += w[k] * win[(p + k) % 31];
                *(LAS f32x2*)(ys + j * DC + c) = a;
            }
        }
    }
    __syncthreads();
#pragma unroll 1
    for (int jj = 0; jj < 4; ++jj) {
        const int j = F.wave * 4 + jj;
        f32x4 v[4]; float s = 0.f;
#pragma unroll
        for (int q = 0; q < 4; ++q) { v[q] = *(const LAS f32x4*)(ys + j * DC + 4 * F.lane + 256 * q); s += (v[q][0] + v[q][1]) + (v[q][2] + v[q][3]); }
        const float mu = wave_sum(s) * (1.0f / DC); float qq = 0.f;
#pragma unroll
        for (int q = 0; q < 4; ++q) { v[q] = v[q] - mu; qq += (v[q][0] * v[q][0] + v[q][1] * v[q][1]) + (v[q][2] * v[q][2] + v[q][3] * v[q][3]); }
        const float rstd = rsqrtf(wave_sum(qq) * (1.0f / DC) + EPS);
#pragma unroll
        for (int q = 0; q < 4; ++q) { const int cc = 4 * F.lane + 256 * q; const f32x4 g4 = *(const f32x4*)(lg + cc), b4 = *(const f32x4*)(lb + cc);
            float y[4];
#pragma unroll
            for (int z = 0; z < 4; ++z) { const float t = v[q][z] * rstd * g4[z] + b4[z]; y[z] = t * sigm(t); }
            u32x2 o; o.x = cvt_pk(y[0], y[1]); o.y = cvt_pk(y[2], y[3]);
            *(u32x2*)(UC + (size_t)(t0 + j) * KCAT + cc) = o; }
    }
    __syncthreads();
}

__device__ __forceinline__ void attn_task(const bf16_t* __restrict__ Q, const bf16_t* __restrict__ Kb, const bf16_t* __restrict__ Vb, bf16_t* OG, float* LSE, int task, int lane) {
    const int h = task >> 8, rem = task & 255;
    const int dsh = 2 * (h >> 2), dil = 1 << dsh;
    const int r = rem & (dil - 1), mc = rem >> dsh;
    const int i = lane & 31, hh = lane >> 5;
    const int m0 = mc * 32;
    const int tq = ((m0 + i) << dsh) + r;
    bf16x8 qf[8];
    { const bf16_t* qp = Q + (size_t)tq * AW + h * HD + 8 * hh;
#pragma unroll
      for (int s = 0; s < 8; ++s) qf[s] = *(const bf16x8*)(qp + 16 * s); }
    const int jt0 = (mc < 4) ? (4 - mc) : 0;
    const float NEG = -__builtin_inff();
    f32x16 sacc[5];
#pragma unroll
    for (int jt = 0; jt < 5; ++jt) {
        f32x16 a;
#pragma unroll
        for (int q = 0; q < 16; ++q) a[q] = 0.f;
        if (jt >= jt0) {
            const int mk = m0 - 128 + 32 * jt + i;
            const bf16_t* kp = Kb + (size_t)((mk << dsh) + r) * AW + h * HD + 8 * hh;
#pragma unroll
            for (int s = 0; s < 8; ++s) { const bf16x8 kf = *(const bf16x8*)(kp + 16 * s); a = __builtin_amdgcn_mfma_f32_32x32x16_bf16(kf, qf[s], a, 0, 0, 0); }
#pragma unroll
            for (int q = 0; q < 16; ++q) { const int kk = (q & 3) + 8 * (q >> 2) + 4 * hh;
                if (jt == 0 && kk < i) a[q] = NEG;
                if (jt == 4 && kk > i) a[q] = NEG; }
        } else {
#pragma unroll
            for (int q = 0; q < 16; ++q) a[q] = NEG;
        }
        sacc[jt] = a;
        __builtin_amdgcn_sched_barrier(0);
    }
    float mx = NEG;
#pragma unroll
    for (int jt = 0; jt < 5; ++jt)
#pragma unroll
        for (int q = 0; q < 16; ++q) mx = fmaxf(mx, sacc[jt][q]);
    mx = fmaxf(mx, __shfl_xor(mx, 32));
    float l = 0.f;
#pragma unroll
    for (int jt = 0; jt < 5; ++jt)
#pragma unroll
        for (int q = 0; q < 16; ++q) { const float e = __builtin_amdgcn_exp2f(sacc[jt][q] - mx); sacc[jt][q] = e; l += e; }
    l += __shfl_xor(l, 32);
    const float inv = 1.0f / l;
    if (hh == 0) LSE[(size_t)tq * NH + h] = (mx + __log2f(l)) * LN2;
    bf16x8 pf[5][2];
#pragma unroll
    for (int jt = 0; jt < 5; ++jt)
#pragma unroll
        for (int s2 = 0; s2 < 2; ++s2) { u32x4 w;
            w.x = cvt_pk(sacc[jt][8 * s2 + 0] * inv, sacc[jt][8 * s2 + 1] * inv); w.y = cvt_pk(sacc[jt][8 * s2 + 2] * inv, sacc[jt][8 * s2 + 3] * inv);
            w.z = cvt_pk(sacc[jt][8 * s2 + 4] * inv, sacc[jt][8 * s2 + 5] * inv); w.w = cvt_pk(sacc[jt][8 * s2 + 6] * inv, sacc[jt][8 * s2 + 7] * inv);
            pf[jt][s2] = __builtin_bit_cast(bf16x8, w); }
    f32x16 o[4];
#pragma unroll
    for (int z = 0; z < 4; ++z)
#pragma unroll
        for (int q = 0; q < 16; ++q) o[z][q] = 0.f;
    const bf16_t* vcol = Vb + h * HD + 2 * i;
#pragma unroll
    for (int jt = 0; jt < 5; ++jt) {
        if (jt >= jt0) {
#pragma unroll
            for (int s2 = 0; s2 < 2; ++s2) {
                unsigned wa[8], wb[8];
#pragma unroll
                for (int j = 0; j < 8; ++j) { const int mk = m0 - 128 + 32 * jt + 16 * s2 + 8 * (j >> 2) + 4 * hh + (j & 3); const bf16_t* vp = vcol + (size_t)((mk << dsh) + r) * AW;
                    wa[j] = *(const unsigned*)vp; wb[j] = *(const unsigned*)(vp + 64); }
                u32x4 f0, f1, f2, f3;
                f0.x = (wa[0] & 0xffffu) | (wa[1] << 16); f0.y = (wa[2] & 0xffffu) | (wa[3] << 16); f0.z = (wa[4] & 0xffffu) | (wa[5] << 16); f0.w = (wa[6] & 0xffffu) | (wa[7] << 16);
                f1.x = (wa[0] >> 16) | (wa[1] & 0xffff0000u); f1.y = (wa[2] >> 16) | (wa[3] & 0xffff0000u); f1.z = (wa[4] >> 16) | (wa[5] & 0xffff0000u); f1.w = (wa[6] >> 16) | (wa[7] & 0xffff0000u);
                f2.x = (wb[0] & 0xffffu) | (wb[1] << 16); f2.y = (wb[2] & 0xffffu) | (wb[3] << 16); f2.z = (wb[4] & 0xffffu) | (wb[5] << 16); f2.w = (wb[6] & 0xffffu) | (wb[7] << 16);
                f3.x = (wb[0] >> 16) | (wb[1] & 0xffff0000u); f3.y = (wb[2] >> 16) | (wb[3] & 0xffff0000u); f3.z = (wb[4] >> 16) | (wb[5] & 0xffff0000u); f3.w = (wb[6] >> 16) | (wb[7] & 0xffff0000u);
                o[0] = __builtin_amdgcn_mfma_f32_32x32x16_bf16(pf[jt][s2], __builtin_bit_cast(bf16x8, f0), o[0], 0, 0, 0);
                o[1] = __builtin_amdgcn_mfma_f32_32x32x16_bf16(pf[jt][s2], __builtin_bit_cast(bf16x8, f1), o[1], 0, 0, 0);
                o[2] = __builtin_amdgcn_mfma_f32_32x32x16_bf16(pf[jt][s2], __builtin_bit_cast(bf16x8, f2), o[2], 0, 0, 0);
                o[3] = __builtin_amdgcn_mfma_f32_32x32x16_bf16(pf[jt][s2], __builtin_bit_cast(bf16x8, f3), o[3], 0, 0, 0);
                __builtin_amdgcn_sched_barrier(0);
            }
        }
    }
#pragma unroll
    for (int q = 0; q < 16; ++q) { const int qi = (q & 3) + 8 * (q >> 2) + 4 * hh; const int tt = ((m0 + qi) << dsh) + r;
        bf16_t* op = OG + ((size_t)tt * NH + h) * HD + 2 * i;
        *(unsigned*)op = cvt_pk(o[0][q], o[1][q]); *(unsigned*)(op + 64) = cvt_pk(o[2][q], o[3][q]); }
}

__global__ void __launch_bounds__(NWAVES * 64, 2) mk_fwd(Args args) {
    extern __shared__ __attribute__((aligned(16))) unsigned char lds[];
    Frame F;
    F.lds = (LAS unsigned char*)lds;
    F.MISC = (volatile LAS unsigned*)(F.lds + MISC_OFF);
    F.tid = threadIdx.x; F.lane = F.tid & 63; F.wave = __builtin_amdgcn_readfirstlane(F.tid >> 6);
    F.G = gridDim.x; { const int bx = blockIdx.x; F.vcu = (F.G % 8 == 0) ? (bx % 8) * (F.G / 8) + bx / 8 : bx; }
    unsigned char* ws = args.ws;
    F.ctl = (gu32*)(ws + WS_CTL);
    for (int u = F.tid; u < (LDS_BYTES - LDSCTL_OFF) / 4; u += NWAVES * 64) ((LAS unsigned*)(F.lds + LDSCTL_OFF))[u] = 0u;
    __syncthreads();
    const bool one_launch = (args.ph_hi - args.ph_lo) > 1;
    XcdBarrier bar; bar.bar = (unsigned*)(F.ctl + CW_BAR) + args.li * XCD_BAR_WORDS; bar.x = 0; bar.st = nullptr;
    if (one_launch) bar = xcd_barrier_post((unsigned*)(F.ctl + CW_BAR) + args.li * XCD_BAR_WORDS, F.MISC + 8);
    const int lo = args.ph_lo, hi = args.ph_hi;
#ifndef MK_PHASE_MASK
#define MK_PHASE_MASK 0xfff
#endif
#define IN(k) ((((MK_PHASE_MASK) >> (k)) & 1) && lo <= (k) && (k) < hi)
#define SEAM(k) do { if (IN(k) && IN((k) + 1)) xcd_barrier(bar); } while (0)
#ifndef MK_REPEAT
#define MK_REPEAT (-1)
#endif
#define REPS(k) for (int rep_ = 0; rep_ < ((k) == MK_REPEAT ? 2 : 1); ++rep_)

    const float* x = args.in[0]; const float* n1g = args.in[1]; const float* w_in = args.in[2]; const float* b_gate = args.in[3];
    const float* conv_w = args.in[4]; const float* conv_b = args.in[5]; const float* ln_g = args.in[6]; const float* ln_b = args.in[7];
    const float* w_co = args.in[8]; const float* b_co = args.in[9]; const float* w_ao = args.in[10]; const float* w_out = args.in[11];
    const float* n2g = args.in[12]; const float* w_r = args.in[13]; const float* b_r = args.in[14];
    const float* w_ei = args.in[15]; const float* b_ei = args.in[16]; const float* w_eo = args.in[17]; const float* b_eo = args.in[18]; const float* nfg = args.in[19];
    bf16_t* WIN = (bf16_t*)(ws + WS_WIN); bf16_t* WCO = (bf16_t*)(ws + WS_WCO); bf16_t* WAO = (bf16_t*)(ws + WS_WAO); bf16_t* WOUT = (bf16_t*)(ws + WS_WOUT);
    unsigned char* WE1 = ws + WS_WE1; unsigned char* WE2 = ws + WS_WE2;
    bf16_t* Hb = (bf16_t*)(ws + WS_H); bf16_t* Ub = (bf16_t*)(ws + WS_U); bf16_t* Qb = (bf16_t*)(ws + WS_Q); bf16_t* Kb = (bf16_t*)(ws + WS_K); bf16_t* Vb = (bf16_t*)(ws + WS_V);
    bf16_t* Gb = (bf16_t*)(ws + WS_GATE); bf16_t* UCb = (bf16_t*)(ws + WS_M1);     bf16_t* OG = (bf16_t*)(ws + WS_OG); float* LSE = (float*)(ws + WS_LSE); bf16_t* OCb = (bf16_t*)(ws + WS_M1) + DC;
    float* M1 = (float*)(ws + WS_M1); bf16_t* MGb = (bf16_t*)(ws + WS_MG); float* X1 = (float*)(ws + WS_X1); unsigned char* H2f = ws + WS_H2;
    int* a_e = (int*)(ws + WS_AE); int* a_pos = (int*)(ws + WS_APOS); float* a_gate = (float*)(ws + WS_AGATE); int* a_slot = (int*)(ws + WS_ASLOT);
    unsigned char* XG = ws + WS_XG; unsigned char* ACT = ws + WS_ACT; unsigned char* Yb = ws + WS_Y;
    int* hist = (int*)(ws + WS_HIST);
    const int gw = F.vcu * NWAVES + F.wave, NGW = F.G * NWAVES;
#ifndef MK_NCV
#define MK_NCV 8
#endif
    const int bx = (int)blockIdx.x;
    const bool grp = (MK_NCV > 0) && (F.G % 8 == 0) && (F.G / 8 > MK_NCV);
    const int cgG = grp ? F.G - 8 * MK_NCV : F.G;
    const bool is_cv = grp && bx >= cgG;
    const int cg_vcu = grp ? (bx % 8) * (cgG / 8) + bx / 8 : F.vcu;
    const int cg_gw = cg_vcu * NWAVES + F.wave, cg_NGW = cgG * NWAVES;
    const int cv_gw = (bx - cgG) * NWAVES + F.wave, cv_NGW = 8 * MK_NCV * NWAVES;
    constexpr int CVT1 = (D / CV_K8) * (2 * DE / CV_N), CVT2 = (DE / CV_K8) * (D / CV_N), CVTE = CVT1 + CVT2, CVTOT = NE * CVTE;
#ifndef MK_CVSPLIT
#define MK_CVSPLIT 57344, 75776, 85504, 87040, 95744
#endif
    constexpr int cvs_[5] = {MK_CVSPLIT};
    const int CV_C0 = grp ? cvs_[0] : CVTOT, CV_C1 = grp ? cvs_[1] : CVTOT, CV_C2 = grp ? cvs_[2] : CVTOT, CV_C3 = grp ? cvs_[3] : CVTOT, CV_C4 = grp ? cvs_[4] : CVTOT;
#ifndef MK_PIPE_P0
#define MK_PIPE_P0 true
#endif
#ifndef MK_PIPE_CV
#define MK_PIPE_CV false
#endif
#define CV_RUN(lo_, hi_, w0_, wn_) cv_run<MK_PIPE_CV>((lo_), (hi_), (w0_), (wn_), w_ei, w_eo, WE1, WE2, F.lane)

    REPS(0) if (IN(0)) {
        if (rep_) xcd_barrier(bar);
        { constexpr int NB_IN = DIN / CV_N, T_IN = (D / CV_K8) * NB_IN, NB = D / CV_N, T_CO = (DC / CV_K16) * NB, T_AO = (AO / CV_K16) * NB, T_OUT = (D / CV_K16) * NB;
          for (int it = gw; it < T_IN; it += NGW) cvt_task_fp8<2>(w_in, DIN, (unsigned char*)WIN, D, CV_K8 * (it / NB_IN), CV_N * (it % NB_IN), 1024, F.lane);
          for (int it = gw; it < T_CO + T_AO + T_OUT; it += NGW) { int q = it;
              if (q < T_CO) { cvt_task_bf16<0>(w_co, D, WCO, KCAT, CV_K16 * (q / NB), CV_N * (q % NB), 0, F.lane); continue; } q -= T_CO;
              if (q < T_AO) { cvt_task_bf16<0>(w_ao, D, WCO + DC, KCAT, CV_K16 * (q / NB), CV_N * (q % NB), 0, F.lane); continue; } q -= T_AO;
              cvt_task_bf16<0>(w_out, D, WOUT, D, CV_K16 * (q / NB), CV_N * (q % NB), 0, F.lane); } }
        cv_run<MK_PIPE_P0>(0, CV_C0, gw, NGW, w_ei, w_eo, WE1, WE2, F.lane);
        for (int m = gw; m < T; m += NGW) rms_row_to_fp8(x + (size_t)m * D, n1g, (unsigned char*)Hb + (size_t)m * D, F.lane);
    }
    SEAM(0);
    if (IN(1)) {
        if (!is_cv) {
            pg8::Gemm g{Hb, WIN, T, DIN, D / 2}; pg8::StaticOrder S; S.init(T, DIN, cgG, bx);
            static_assert(WS_V - WS_K == WS_K - WS_Q, "q|k|v strides"); EpiProj E{Ub, Qb, Gb, b_gate};
            pg8::gemm_phase<EpiProj, pg8::StaticOrder, true, true, E8_W, E8_X>(F.lds, g, S, E);
        } else CV_RUN(CV_C0, CV_C1, cv_gw, cv_NGW);
    }
    SEAM(1);
    REPS(2) if (IN(2)) {
        if (rep_) xcd_barrier(bar);
#ifndef MK_NO_CONV
        if (!is_cv) for (int tile = cg_vcu; tile < T / 32; tile += cgG) conv_tile(F, tile, Ub, conv_w, conv_b, ln_g, ln_b, UCb);
#endif
#ifndef MK_NO_ATTN
        if (!is_cv) for (int task = cg_gw; task < NH * 256; task += cg_NGW) attn_task(Qb, Kb, Vb, OG, LSE, task, F.lane);
        if (is_cv) CV_RUN(CV_C1, CV_C2, cv_gw, cv_NGW);
#endif
    }
    SEAM(2);
#ifdef MK_EXTRA_BARRIERS
    for (int xb_ = 0; xb_ < MK_EXTRA_BARRIERS; ++xb_) xcd_barrier(bar);
#endif
    REPS(3) if (IN(3)) {
        if (rep_) xcd_barrier(bar);
        if (is_cv) CV_RUN(CV_C2, CV_C3, cv_gw, cv_NGW);
        if (!is_cv) for (int it = cg_gw; it < T * 4; it += cg_NGW) { const int t = it >> 2, hg = it & 3;
            const float l0 = LSE[(size_t)t * NH + hg], l1 = LSE[(size_t)t * NH + 4 + hg], l2 = LSE[(size_t)t * NH + 8 + hg];
            const float m = fmaxf(l0, fmaxf(l1, l2)); const float w0 = __expf(l0 - m), w1 = __expf(l1 - m), w2 = __expf(l2 - m), inv = 1.0f / (w0 + w1 + w2);
            const unsigned ua = *(const unsigned*)(OG + ((size_t)t * NH + hg) * HD + 2 * F.lane), ub = *(const unsigned*)(OG + ((size_t)t * NH + 4 + hg) * HD + 2 * F.lane), uc_ = *(const unsigned*)(OG + ((size_t)t * NH + 8 + hg) * HD + 2 * F.lane);
            const f32x2 a = {bflo(ua), bfhi(ua)}, b = {bflo(ub), bfhi(ub)}, c = {bflo(uc_), bfhi(uc_)};
            const f32x2 o = (a * w0 + b * w1 + c * w2) * inv;
            *(unsigned*)(OCb + (size_t)t * KCAT + hg * HD + 2 * F.lane) = cvt_pk(o[0], o[1]); }
    }
    SEAM(3);
    if (IN(4)) {
        pg8::Gemm g{UCb, WCO, T, D, KCAT}; pg8::StaticOrder S; S.init(T, D, F.G, (int)blockIdx.x);
        EpiMerge E{Gb, b_co, MGb};
        pg8::gemm_phase<EpiMerge, pg8::StaticOrder, false, true, 0, 0, DC / 64>(F.lds, g, S, E);
    }
    SEAM(4);
    if (IN(6)) {
        pg8::Gemm g{MGb, WOUT, T, D, D}; pg8::StaticOrder S; S.init(T, D, F.G, (int)blockIdx.x);
        EpiResid E{x, X1};
        pg8::gemm_phase<EpiResid, pg8::StaticOrder, false, true>(F.lds, g, S, E);
        if (MK_REPEAT == 6) {
            xcd_barrier(bar);
            pg8::Gemm g{MGb, WOUT, T, D, D}; pg8::StaticOrder S; S.init(T, D, F.G, (int)blockIdx.x);
        EpiResid E{x, X1};
        pg8::gemm_phase<EpiResid, pg8::StaticOrder, false, true>(F.lds, g, S, E);
        }
    }
    SEAM(6);
    REPS(7) if (IN(7)) {
        if (rep_) xcd_barrier(bar);
        LAS float* xs = (LAS float*)F.lds;
        LAS int* ue = (LAS int*)(F.lds + TAB_OFF + 256);
        float wreg[128];
        { const int e = F.lane & 31, i0 = 256 * F.wave + 128 * (F.lane >> 5);
#pragma unroll
          for (int ii = 0; ii < 128; ++ii) wreg[ii] = w_r[(size_t)(i0 + ii) * NE + e]; }
        if (is_cv) CV_RUN(CV_C3, CV_C4, cv_gw, cv_NGW);
        if (!is_cv) for (int unit = cg_vcu; unit < T / 16; unit += cgG) {
            const int t0 = unit * 16;
#pragma unroll 1
            for (int tt = 2 * F.wave; tt < 2 * F.wave + 2; ++tt) {
                const GAS f32x4* xr = (const GAS f32x4*)(X1 + (size_t)(t0 + tt) * D) + F.lane;
                f32x4 v[8]; float ss = 0.f;
#pragma unroll
                for (int j = 0; j < 8; ++j) { v[j] = xr[64 * j]; ss += (v[j][0] * v[j][0] + v[j][1] * v[j][1]) + (v[j][2] * v[j][2] + v[j][3] * v[j][3]); }
                const float rs = rsqrtf(wave_sum(ss) * (1.0f / D) + EPS);
                GAS unsigned* o4 = (GAS unsigned*)(H2f + (size_t)(t0 + tt) * D) + F.lane;
#pragma unroll
                for (int j = 0; j < 8; ++j) { const f32x4 gg = ((const GAS f32x4*)n2g)[F.lane + 64 * j]; const f32x4 y = v[j] * rs * gg;
                    *(LAS f32x4*)(xs + tt * D + 4 * (F.lane + 64 * j)) = y; o4[64 * j] = pk4_fp8(y[0] * S_X, y[1] * S_X, y[2] * S_X, y[3] * S_X); }
            }
            __syncthreads();
            float pacc[16];
#pragma unroll
            for (int tt = 0; tt < 16; ++tt) pacc[tt] = 0.f;
            { const int i0 = 256 * F.wave + 128 * (F.lane >> 5);
#pragma unroll
              for (int ii = 0; ii < 128; ii += 4) {
#pragma unroll
                  for (int tt = 0; tt < 16; ++tt) { const f32x4 xv = *(const LAS f32x4*)(xs + tt * D + i0 + ii); pacc[tt] += (xv[0] * wreg[ii] + xv[1] * wreg[ii + 1]) + (xv[2] * wreg[ii + 2] + xv[3] * wreg[ii + 3]); }
              } }
#pragma unroll
            for (int tt = 0; tt < 16; ++tt) pacc[tt] += __shfl_xor(pacc[tt], 32);
            __syncthreads();
            if (F.lane < 32) {
#pragma unroll
                for (int tt = 0; tt < 16; ++tt) xs[(F.wave * 16 + tt) * 32 + F.lane] = pacc[tt];
            }
            __syncthreads();
#pragma unroll 1
            for (int tt = 2 * F.wave; tt < 2 * F.wave + 2; ++tt) {
                float lg = -__builtin_inff();
                if (F.lane < 32) { float s = b_r[F.lane];
#pragma unroll
                    for (int w = 0; w < 8; ++w) s += xs[(w * 16 + tt) * 32 + F.lane];
                    lg = s; }
                int sel_e[4]; float sel_v[4];
#pragma unroll
                for (int k = 0; k < 4; ++k) { const float m = wave_max(lg); const unsigned long long b = __ballot(lg == m); const int e = __ffsll((long long)b) - 1; sel_e[k] = e; sel_v[k] = m; if (F.lane == e) lg = -__builtin_inff(); }
                const float e1 = __expf(sel_v[1] - sel_v[0]), e2 = __expf(sel_v[2] - sel_v[0]), e3 = __expf(sel_v[3] - sel_v[0]);
                const float inv = 1.0f / (1.0f + e1 + e2 + e3);
                if (F.lane < 4) {
                    const int e = F.lane == 0 ? sel_e[0] : F.lane == 1 ? sel_e[1] : F.lane == 2 ? sel_e[2] : sel_e[3];
                    const float gt = (F.lane == 0 ? 1.0f : F.lane == 1 ? e1 : F.lane == 2 ? e2 : e3) * inv;
                    const int a = (t0 + tt) * 4 + F.lane; a_e[a] = e; a_gate[a] = gt; ue[tt * 4 + F.lane] = e;
                }
            }
            __syncthreads();
            if (F.wave == 0) {
                const int e = ue[F.lane]; int rank = 0, mycount = 0;
#pragma unroll 4
                for (int q = 0; q < NE; ++q) { const unsigned long long mq = __ballot(e == q); if (e == q) rank = __popcll(mq & ((1ull << F.lane) - 1ull)); if (F.lane == q) mycount = __popcll(mq); }
                a_pos[t0 * 4 + F.lane] = rank;
                if (F.lane < NE) hist[unit * NE + F.lane] = mycount;
            }
            __syncthreads();
        }
    }
    SEAM(7);
    LAS int* rt0 = (LAS int*)(F.lds + TAB_OFF);
    LAS int* cntl = (LAS int*)(F.lds + TAB_OFF + 512);
    LAS int* ubase = (LAS int*)(F.lds + TAB_OFF + 768);
    LAS int* myexp = (LAS int*)(F.lds + TAB_OFF + 896);
    LAS int* part = (LAS int*)(F.lds + TAB_OFF + 1024);
    if (hi > 8 && lo <= 10) {
        { const int e = F.tid & 31, p = F.tid >> 5; int sacc_ = 0;
#pragma unroll 8
          for (int u = 32 * p; u < 32 * p + 32; ++u) sacc_ += hist[u * NE + e];
          part[p * NE + e] = sacc_; }
        __syncthreads();
        if (F.tid < NE) { int c = 0;
#pragma unroll
            for (int p = 0; p < 16; ++p) c += part[p * NE + F.tid];
            cntl[F.tid] = c; }
        __syncthreads();
        if (F.tid == 0) { int a = 0; for (int e = 0; e < NE; ++e) { rt0[e] = a; a += (cntl[e] + 255) >> 8; } rt0[NE] = a; }
        __syncthreads();
    }
    REPS(8) if (IN(8)) {
        if (rep_) xcd_barrier(bar);
        if (is_cv) CV_RUN(CV_C4, CVTOT, cv_gw, cv_NGW);
        if (!is_cv) for (int unit = cg_vcu; unit < T / 16; unit += cgG) {
            if (F.tid < NE) { int b = 0; const int p0 = unit >> 5;
                for (int p = 0; p < p0; ++p) b += part[p * NE + F.tid];
                for (int u = 32 * p0; u < unit; ++u) b += hist[u * NE + F.tid];
                ubase[F.tid] = b; }
            __syncthreads();
#pragma unroll 1
            for (int j = 0; j < 8; ++j) { const int a = unit * 64 + F.wave * 8 + j; const int e = a_e[a], slot = 256 * rt0[e] + ubase[e] + a_pos[a];
                if (F.lane == 0) a_slot[a] = slot;
                const GAS u32x4* src = (const GAS u32x4*)(H2f + (size_t)(a >> 2) * D) + F.lane; GAS u32x4* dst = (GAS u32x4*)(XG + (size_t)slot * D) + F.lane;
#pragma unroll
                for (int q = 0; q < 2; ++q) dst[64 * q] = src[64 * q]; }
            __syncthreads();
        }
        if (!is_cv) for (int it = cg_gw; it < NE * 256; it += cg_NGW) { const int e = it >> 8, j = it & 255; const int row = 256 * rt0[e] + cntl[e] + j;
            if (row < 256 * rt0[e + 1]) { GAS u32x4* dst = (GAS u32x4*)(XG + (size_t)row * D) + F.lane;
#pragma unroll
                for (int j2 = 0; j2 < 2; ++j2) dst[64 * j2] = (u32x4){0u, 0u, 0u, 0u}; } }
    }
    SEAM(8);
    if (IN(9)) {
        pg8::Gemm g{(const bf16_t*)XG, (const bf16_t*)WE1, NROWS, NE * 2 * DE, D / 2}; LAS unsigned* utab = (LAS unsigned*)(F.lds + TAB_OFF + 4096); const int NX = (F.G % 8 == 0) ? 8 : 1; const int utot = moe_build_tab(utab, myexp, rt0, 16, F.tid, (int)blockIdx.x % NX, NX); MoeOrder S{utab, utot, F.G / NX, (int)blockIdx.x / NX};
        EpiSwiGLU E{ACT, b_ei};
        pg8::gemm_phase<EpiSwiGLU, MoeOrder, true, true, E8_W, E8_X>(F.lds, g, S, E);
        if (MK_REPEAT == 9) {
            xcd_barrier(bar);
            pg8::Gemm g{(const bf16_t*)XG, (const bf16_t*)WE1, NROWS, NE * 2 * DE, D / 2}; LAS unsigned* utab = (LAS unsigned*)(F.lds + TAB_OFF + 4096); const int NX = (F.G % 8 == 0) ? 8 : 1; const int utot = moe_build_tab(utab, myexp, rt0, 16, F.tid, (int)blockIdx.x % NX, NX); MoeOrder S{utab, utot, F.G / NX, (int)blockIdx.x / NX};
        EpiSwiGLU E{ACT, b_ei};

#ifdef MK_REPEAT_NOEPI
            { EpiNull EN; pg8::gemm_phase<EpiNull, MoeOrder, true, true, E8_W, E8_X>(F.lds, g, S, EN); }
#else
            pg8::gemm_phase<EpiSwiGLU, MoeOrder, true, true, E8_W, E8_X>(F.lds, g, S, E);
#endif

        }
    }
    SEAM(9);
    if (IN(10)) {
        pg8::Gemm g{(const bf16_t*)ACT, (const bf16_t*)WE2, NROWS, NE * D, DE / 2}; LAS unsigned* utab = (LAS unsigned*)(F.lds + TAB_OFF + 4096); const int NX = (F.G % 8 == 0) ? 8 : 1; const int utot = moe_build_tab(utab, myexp, rt0, 8, F.tid, (int)blockIdx.x % NX, NX); MoeOrder S{utab, utot, F.G / NX, (int)blockIdx.x / NX};
        EpiExpOut E{Yb, b_eo};
        pg8::gemm_phase<EpiExpOut, MoeOrder, true, true, E8_W, E8_ACT>(F.lds, g, S, E);
        if (MK_REPEAT == 10) {
            xcd_barrier(bar);
            pg8::Gemm g{(const bf16_t*)ACT, (const bf16_t*)WE2, NROWS, NE * D, DE / 2}; LAS unsigned* utab = (LAS unsigned*)(F.lds + TAB_OFF + 4096); const int NX = (F.G % 8 == 0) ? 8 : 1; const int utot = moe_build_tab(utab, myexp, rt0, 8, F.tid, (int)blockIdx.x % NX, NX); MoeOrder S{utab, utot, F.G / NX, (int)blockIdx.x / NX};
        EpiExpOut E{Yb, b_eo};

#ifdef MK_REPEAT_NOEPI
            { typedef EpiExpOutT<MK_REPEAT_NOEPI> EV; EV EN{Yb, b_eo}; pg8::gemm_phase<EV, MoeOrder, true, true, E8_W, E8_ACT>(F.lds, g, S, EN); }
#else
            pg8::gemm_phase<EpiExpOut, MoeOrder, true, true, E8_W, E8_ACT>(F.lds, g, S, E);
#endif

        }
    }
    SEAM(10);
    REPS(11) if (IN(11)) {
        if (rep_) xcd_barrier(bar);
        for (int t = gw; t < T; t += NGW) {
            f32x4 v[8];
#pragma unroll
            for (int j = 0; j < 8; ++j) v[j] = ((const GAS f32x4*)(X1 + (size_t)t * D))[F.lane + 64 * j];
#pragma unroll
            for (int k = 0; k < 4; ++k) { const int s = a_slot[t * 4 + k]; const float gt = a_gate[t * 4 + k] * (1.0f / S_Y); const GAS unsigned* yr = (const GAS unsigned*)(Yb + (size_t)s * D) + F.lane;
#pragma unroll
                for (int j = 0; j < 8; ++j) { const unsigned w = yr[64 * j]; const f32x2 lo = __builtin_amdgcn_cvt_pk_f32_fp8((int)w, false), hi = __builtin_amdgcn_cvt_pk_f32_fp8((int)w, true);
                    v[j][0] += gt * lo[0]; v[j][1] += gt * lo[1]; v[j][2] += gt * hi[0]; v[j][3] += gt * hi[1]; } }
            float ss = 0.f;
#pragma unroll
            for (int j = 0; j < 8; ++j) ss += (v[j][0] * v[j][0] + v[j][1] * v[j][1]) + (v[j][2] * v[j][2] + v[j][3] * v[j][3]);
            const float rs = rsqrtf(wave_sum(ss) * (1.0f / D) + EPS);
            GAS f32x4* o = (GAS f32x4*)(args.out + (size_t)t * D);
#pragma unroll
            for (int j = 0; j < 8; ++j) { const f32x4 gg = ((const GAS f32x4*)nfg)[F.lane + 64 * j]; o[F.lane + 64 * j] = v[j] * rs * gg; }
        }
    }
#undef IN
#undef SEAM
}
constexpr int N_PHASES = 12;
}

#ifndef MK_CUTS
#define MK_CUTS 0
#endif
extern "C" void kernel_launch(void* const* d_in, const int* in_sizes, int n_in, void* d_out, int out_size, void* d_ws, size_t ws_size, hipStream_t stream) {
    using namespace mk;
    static int grid = 0;
    if (grid == 0) {
        int dev = 0, cus = 0;
        if (hipGetDevice(&dev) != hipSuccess || hipDeviceGetAttribute(&cus, hipDeviceAttributeMultiprocessorCount, dev) != hipSuccess) { grid = -1; return; }
        if (hipFuncSetAttribute((const void*)mk_fwd, hipFuncAttributeMaxDynamicSharedMemorySize, LDS_BYTES) != hipSuccess) { grid = -1; return; }
        int per_cu = 0;
        if (hipOccupancyMaxActiveBlocksPerMultiprocessor(&per_cu, (const void*)mk_fwd, NWAVES * 64, LDS_BYTES) != hipSuccess || per_cu < 1) { fprintf(stderr, "kernel_launch: occupancy query says %d\n", per_cu); }
        (void)hipGetLastError();
        grid = cus;
    }
    if (grid < 0) return;
    (void)hipMemsetAsync((char*)d_ws + WS_CTL, 0, CTL_ZERO_BYTES, stream);
    Args a{};
    for (int i = 0; i < 20; ++i) a.in[i] = (const float*)d_in[i];
    a.out = (float*)d_out; a.ws = (unsigned char*)d_ws;
#if MK_CUTS == 0
    a.ph_lo = 0; a.ph_hi = N_PHASES; a.li = 0; a.pad = 0;
    hipLaunchKernelGGL(mk_fwd, dim3(grid), dim3(NWAVES * 64), LDS_BYTES, stream, a);
#else
    for (int p = 0; p < N_PHASES; ++p) { a.ph_lo = p; a.ph_hi = p + 1; a.li = 0; a.pad = 0; hipLaunchKernelGGL(mk_fwd, dim3(grid), dim3(NWAVES * 64), LDS_BYTES, stream, a); }
#endif
}
```

```cpp
#include <hip/hip_runtime.h>
#include <cstdio>
#include <cstdint>
#define MK_NCV7 10
namespace pg8 {
#define PG8_LAS __attribute__((address_space(3)))
typedef unsigned short bf16_t;
typedef short bf16x8 __attribute__((ext_vector_type(8)));
typedef float f32x4 __attribute__((ext_vector_type(4)));
typedef unsigned u32x4 __attribute__((ext_vector_type(4)));
typedef int pg8_v4i __attribute__((ext_vector_type(4)));
constexpr int BM = 256, BK = 64, HALF = 128, HTB = HALF * BK * 2  , STAGE_BYTES = 8 * HTB, NXCD = 8, WGM = 8;

__host__ __device__ __forceinline__ int lds_byte(int r, int c) { const int st = (r >> 4) * 2 + (c >> 5), rr = r & 15, cc = c & 31, ob = rr * 64 + cc * 2; return st * 1024 + (ob ^ (((ob >> 9) & 1) << 5)); }
__host__ __device__ __forceinline__ void stage_rc(int b, int& R, int& C) { const int st = b / 1024, sb = b % 1024, swz = sb ^ (((sb >> 9) & 1) << 5); R = (st >> 1) * 16 + swz / 64; C = (st & 1) * 32 + (swz % 64) / 2; }
__host__ __device__ __forceinline__ int perm32(int rho) { const int n = rho >> 4, i = rho & 15; return 8 * (i >> 2) + 4 * n + (i & 3); }

struct Unit { int pm, pn, half; };
struct Gemm { const bf16_t* A; const bf16_t* Bt; int M, N, K; };

struct StaticOrder {
    int nM, nN, nwg, G, c;
    __host__ __device__ void init(int M, int N, int G_, int c_) { nM = M / BM; nN = N / BM; nwg = nM * nN; G = G_; c = c_; }
    __host__ __device__ bool next(int i, Unit& u) const {
        const long L = (long)i * G + c; if (L >= nwg) return false;
        int wgid = (int)L; { const int q = nwg / NXCD, r = nwg % NXCD, xcd = wgid % NXCD, off = wgid / NXCD; wgid = (xcd < r ? xcd * (q + 1) : r * (q + 1) + (xcd - r) * q) + off; }
        const int nig = WGM * nN, gid = wgid / nig, fm = gid * WGM, gsz = (nM - fm) < WGM ? (nM - fm) : WGM;
        u.pm = fm + ((wgid % nig) % gsz); u.pn = (wgid % nig) / gsz; u.half = 0; return true;
    }
    __device__ __forceinline__ void a_ready(const Unit&) const {}
    __device__ __forceinline__ void done(const Unit&) const {}
};

__device__ __forceinline__ unsigned cvt_pk_bf16(float lo, float hi) { unsigned r; asm volatile("v_cvt_pk_bf16_f32 %0, %1, %2" : "=v"(r) : "v"(lo), "v"(hi)); return r; }
template <class Epi, class Sched, bool ALIGN_EPI = false, bool SP2 = false, int F8W = 0, int F8X = 0, int HOOK_T = 0, int BAUX = 0, bool DEFER = false>
__device__ __forceinline__ void gemm_phase(PG8_LAS unsigned char* lds, const Gemm g, const Sched& S, const Epi& E) {
    const int tid = threadIdx.x, wid = __builtin_amdgcn_readfirstlane(tid >> 6), lane = tid & 63, wr = wid >> 2, wc = wid & 3, fr = lane & 15, fq = lane >> 4;
    const int K = g.K, nt = K / BK;
    int f8w_ = F8W, f8x_ = F8X; asm volatile("" : "+v"(f8w_), "+v"(f8x_));
    unsigned voffA[2], voffB[2];
#pragma unroll
    for (int i = 0; i < 2; ++i) { int R, C; stage_rc(tid * 16 + i * 8192, R, C); const int Rb = Epi::PERM ? ((R & ~31) + perm32(R & 31)) : R;
        voffA[i] = (unsigned)(R * K + C) * 2u; voffB[i] = (unsigned)(Rb * K + C) * 2u; }
    const size_t kstep = (size_t)(BK * 2);
    const size_t hstep = (size_t)HALF * K * 2;
    const size_t tstep = 2 * hstep;
    const unsigned ldsw = (unsigned)wid * 1024u;
    const int aoff = lds_byte(wr * 64 + fr, fq * 8), boff = lds_byte(wc * 32 + fr, fq * 8);
#define PG8_SA(b, h) (((b) * 2 + (h)) * HTB)
#define PG8_SB(b, h) ((4 + (b) * 2 + (h)) * HTB)
#define PG8_STAGE(bufoff, gbase, voff) do { _Pragma("unroll") for (int _i = 0; _i < 2; ++_i) \
        __builtin_amdgcn_global_load_lds((const unsigned*)((const char*)(gbase) + (voff)[_i]), (PG8_LAS unsigned*)(lds + (bufoff) + ldsw + _i * 8192), 16, 0, 0); } while (0)
#define PG8_STAGEB(bufoff, gbase, voff) do { _Pragma("unroll") for (int _i = 0; _i < 2; ++_i) \
        __builtin_amdgcn_global_load_lds((const unsigned*)((const char*)(gbase) + (voff)[_i]), (PG8_LAS unsigned*)(lds + (bufoff) + ldsw + _i * 8192), 16, 0, BAUX); } while (0)
#define PG8_LDA(dst, b, h) do { _Pragma("unroll") for (int m = 0; m < 4; ++m) _Pragma("unroll") for (int k = 0; k < 2; ++k) dst[m][k] = *(const PG8_LAS bf16x8*)(lds + PG8_SA(b, h) + aoff + m * 2048 + k * 1024); } while (0)
#define PG8_LDB(dst, b, h) do { _Pragma("unroll") for (int n = 0; n < 2; ++n) _Pragma("unroll") for (int k = 0; k < 2; ++k) dst[n][k] = *(const PG8_LAS bf16x8*)(lds + PG8_SB(b, h) + boff + n * 2048 + k * 1024); } while (0)
#define PG8_CAT8(lo, hi) __builtin_shufflevector(__builtin_bit_cast(pg8_v4i, lo), __builtin_bit_cast(pg8_v4i, hi), 0, 1, 2, 3, 4, 5, 6, 7)
#define PG8_MMA(ai, bj, At, Bt) do { __builtin_amdgcn_s_setprio(1); if constexpr (F8W != 0) { _Pragma("unroll") for (int m = 0; m < 4; ++m) _Pragma("unroll") for (int n = 0; n < 2; ++n) \
        asm volatile("v_mfma_scale_f32_16x16x128_f8f6f4 %0, %1, %2, %0, %3, %4 op_sel_hi:[0,0,0]" : "+v"(acc[ai][bj][m][n]) : "v"(PG8_CAT8(Bt[n][0], Bt[n][1])), "v"(PG8_CAT8(At[m][0], At[m][1])), "v"(f8w_), "v"(f8x_)); } else { \
        _Pragma("unroll") for (int m = 0; m < 4; ++m) _Pragma("unroll") for (int n = 0; n < 2; ++n) _Pragma("unroll") for (int k = 0; k < 2; ++k) \
        acc[ai][bj][m][n] = __builtin_amdgcn_mfma_f32_16x16x32_bf16(Bt[n][k], At[m][k], acc[ai][bj][m][n], 0, 0, 0); } __builtin_amdgcn_s_setprio(0); } while (0)
#define PG8_WAIT_V(n) asm volatile("s_waitcnt vmcnt(" #n ")" ::: "memory")
#define PG8_WAIT_L(n) asm volatile("s_waitcnt lgkmcnt(" #n ")" ::: "memory")
#define PG8_BAR __builtin_amdgcn_s_barrier()
#define PG8_SCHED __builtin_amdgcn_sched_barrier(0)
    Unit cur, nxt; int ui = 0;
    typename Epi::Pend pend; Unit pu = {0, 0, 0}; bool has_pend = false;
    typename Epi::Pre pre;
    if (!S.next(0, cur)) return;
    f32x4 acc[2][2][4][2];
#pragma unroll
    for (int a = 0; a < 2; ++a)
#pragma unroll
        for (int b = 0; b < 2; ++b)
#pragma unroll
            for (int m = 0; m < 4; ++m)
#pragma unroll
                for (int n = 0; n < 2; ++n) acc[a][b][m][n] = (f32x4){0.f, 0.f, 0.f, 0.f};
    bf16x8 At[4][2], B0[2][2], B1[2][2];
    const char* cA = (const char*)g.A + (size_t)cur.pm * tstep; const char* cB = (const char*)g.Bt + (size_t)cur.pn * tstep;
    S.a_ready(cur);
    if constexpr (SP2) {
        PG8_STAGEB(PG8_SB(0, 0), cB, voffB); PG8_STAGEB(PG8_SB(0, 1), cB + hstep, voffB); PG8_STAGE(PG8_SA(0, 0), cA, voffA); PG8_STAGE(PG8_SA(0, 1), cA + hstep, voffA);
        if (wr == 1) PG8_BAR;
        PG8_WAIT_V(2); PG8_BAR;
        PG8_STAGEB(PG8_SB(1, 0), cB + kstep, voffB); PG8_STAGE(PG8_SA(1, 0), cA + kstep, voffA); PG8_STAGEB(PG8_SB(1, 1), cB + hstep + kstep, voffB);
        PG8_WAIT_V(6); PG8_BAR;
    } else {
        PG8_STAGEB(PG8_SB(0, 0), cB, voffB); PG8_STAGE(PG8_SA(0, 0), cA, voffA); PG8_STAGEB(PG8_SB(0, 1), cB + hstep, voffB); PG8_STAGE(PG8_SA(0, 1), cA + hstep, voffA);
        if (wr == 1) PG8_BAR;
        PG8_WAIT_V(4); PG8_BAR;
        PG8_STAGEB(PG8_SB(1, 0), cB + kstep, voffB); PG8_STAGE(PG8_SA(1, 0), cA + kstep, voffA); PG8_STAGEB(PG8_SB(1, 1), cB + hstep + kstep, voffB);
        PG8_WAIT_V(6); PG8_BAR;
    }
    for (;;) {
        const bool has_next = S.next(ui + 1, nxt);
        const char* nA = has_next ? (const char*)g.A + (size_t)nxt.pm * tstep : cA; const char* nB = has_next ? (const char*)g.Bt + (size_t)nxt.pn * tstep : cB;
        for (int t = 0; t < nt; t += 2) {
            if constexpr (DEFER) { if (has_pend) E.store_step(pend, pu, t >> 1, wr, wc, fr, fq); }
            if constexpr (HOOK_T > 0) { if (t == HOOK_T) E.mid(acc, cur, wr, wc, fr, fq); }
            const bool last = (t == nt - 2);
            const char* a1 = cA + (size_t)(t + 1) * kstep;
            const char* a2 = last ? nA : cA + (size_t)(t + 2) * kstep; const char* b2 = last ? nB : cB + (size_t)(t + 2) * kstep;
            const char* a3 = a2 + kstep; const char* b3 = b2 + kstep;
            if (last && has_next) S.a_ready(nxt);
            if constexpr (!DEFER) { if (last) E.preload(pre, cur, wr, wc, fr, fq); }
            if constexpr (SP2) {
            PG8_LDB(B0, 0, 0); PG8_LDB(B1, 0, 1); PG8_SCHED; PG8_LDA(At, 0, 0); PG8_STAGE(PG8_SA(1, 1), a1 + hstep, voffA);
            PG8_WAIT_V(8); PG8_WAIT_L(0); PG8_BAR; PG8_MMA(0, 0, At, B0); PG8_MMA(0, 1, At, B1); PG8_BAR; PG8_SCHED;
            if (!cur.half) PG8_LDA(At, 0, 1); PG8_STAGEB(PG8_SB(0, 0), b2, voffB); PG8_STAGEB(PG8_SB(0, 1), b2 + hstep, voffB); PG8_STAGE(PG8_SA(0, 0), a2, voffA);
            PG8_WAIT_V(8); PG8_WAIT_L(0); PG8_BAR; if (!cur.half) { PG8_MMA(1, 0, At, B0); PG8_MMA(1, 1, At, B1); } PG8_BAR; PG8_SCHED;
            PG8_LDB(B0, 1, 0); PG8_LDB(B1, 1, 1); PG8_SCHED; PG8_LDA(At, 1, 0); PG8_STAGE(PG8_SA(0, 1), a2 + hstep, voffA);
            PG8_WAIT_V(8); PG8_WAIT_L(0); PG8_BAR; PG8_MMA(0, 0, At, B0); PG8_MMA(0, 1, At, B1); PG8_BAR; PG8_SCHED;
            if (!cur.half) PG8_LDA(At, 1, 1); PG8_STAGEB(PG8_SB(1, 0), b3, voffB); PG8_STAGEB(PG8_SB(1, 1), b3 + hstep, voffB); PG8_STAGE(PG8_SA(1, 0), a3, voffA);
            PG8_WAIT_V(8); PG8_WAIT_L(0); PG8_BAR; if (!cur.half) { PG8_MMA(1, 0, At, B0); PG8_MMA(1, 1, At, B1); } PG8_BAR; PG8_SCHED;
            } else {
            PG8_LDB(B0, 0, 0); PG8_SCHED; PG8_LDA(At, 0, 0); PG8_STAGE(PG8_SA(1, 1), a1 + hstep, voffA);
            PG8_WAIT_L(8); PG8_BAR; PG8_WAIT_L(0); PG8_MMA(0, 0, At, B0); PG8_BAR; PG8_SCHED;
            PG8_LDB(B1, 0, 1); PG8_STAGEB(PG8_SB(0, 0), b2, voffB);
            PG8_BAR; PG8_WAIT_L(0); PG8_MMA(0, 1, At, B1); PG8_BAR;
            PG8_LDA(At, 0, 1); PG8_STAGE(PG8_SA(0, 0), a2, voffA);
            PG8_BAR; PG8_WAIT_L(0); PG8_MMA(1, 0, At, B0); PG8_BAR; PG8_SCHED;
            PG8_STAGEB(PG8_SB(0, 1), b2 + hstep, voffB);
            PG8_WAIT_V(6); PG8_BAR; PG8_MMA(1, 1, At, B1); PG8_BAR;
            PG8_LDB(B0, 1, 0); PG8_SCHED; PG8_LDA(At, 1, 0); PG8_STAGE(PG8_SA(0, 1), a2 + hstep, voffA);
            PG8_WAIT_L(8); PG8_BAR; PG8_WAIT_L(0); PG8_MMA(0, 0, At, B0); PG8_BAR; PG8_SCHED;
            PG8_LDB(B1, 1, 1); PG8_STAGEB(PG8_SB(1, 0), b3, voffB);
            PG8_BAR; PG8_WAIT_L(0); PG8_MMA(0, 1, At, B1); PG8_BAR;
            PG8_LDA(At, 1, 1); PG8_STAGE(PG8_SA(1, 0), a3, voffA);
            PG8_BAR; PG8_WAIT_L(0); PG8_MMA(1, 0, At, B0); PG8_BAR; PG8_SCHED;
            PG8_STAGEB(PG8_SB(1, 1), b3 + hstep, voffB);
            PG8_WAIT_V(6); PG8_BAR; PG8_MMA(1, 1, At, B1); PG8_BAR;
            }
        }
        if constexpr (F8W != 0) asm volatile("s_nop 15\n\ts_nop 15" ::: "memory");
        if constexpr (ALIGN_EPI) { if (wr == 0) PG8_BAR; }
        if constexpr (DEFER) { E.preload(pre, cur, wr, wc, fr, fq); E.compute(acc, cur, wr, wc, fr, fq, pre, pend); pu = cur; has_pend = true; }
        else if constexpr (!Epi::AFTER_DRAIN) { E(acc, cur, wr, wc, fr, fq, pre); S.done(cur); }
        if (!has_next) break;
#pragma unroll
        for (int a = 0; a < 2; ++a)
#pragma unroll
            for (int b = 0; b < 2; ++b)
#pragma unroll
                for (int m = 0; m < 4; ++m)
#pragma unroll
                    for (int n = 0; n < 2; ++n) acc[a][b][m][n] = (f32x4){0.f, 0.f, 0.f, 0.f};
        cur = nxt; cA = nA; cB = nB; ++ui;
        if constexpr (ALIGN_EPI) { if (wr == 1) PG8_BAR; }
    }
    if constexpr (DEFER) { if (has_pend) { _Pragma("unroll") for (int s_ = 0; s_ < Epi::NPEND; ++s_) E.store_step(pend, pu, s_, wr, wc, fr, fq); } }
    PG8_WAIT_V(0);
    if constexpr (!ALIGN_EPI) { if (wr == 0) PG8_BAR; }
    PG8_BAR;
    if constexpr (Epi::AFTER_DRAIN) { E.fused(acc, cur, wr, wc, fr, fq, lds, wid, lane); S.done(cur); }
#undef PG8_SA
#undef PG8_SB
#undef PG8_STAGE
#undef PG8_STAGEB
#undef PG8_LDA
#undef PG8_LDB
#undef PG8_MMA
#undef PG8_CAT8
#undef PG8_WAIT_V
#undef PG8_WAIT_L
#undef PG8_BAR
#undef PG8_SCHED
}
}
#define GAS __attribute__((address_space(1)))
#define LAS __attribute__((address_space(3)))
namespace mk {
using pg8::bf16_t; using pg8::bf16x8; using pg8::f32x4; using pg8::u32x4; using pg8::Unit; using pg8::cvt_pk_bf16;
typedef float f32x16 __attribute__((ext_vector_type(16)));
typedef float f32x2 __attribute__((ext_vector_type(2)));
typedef unsigned u32x2 __attribute__((ext_vector_type(2)));
typedef GAS unsigned gu32;
typedef __bf16 bf16x2_t __attribute__((ext_vector_type(2)));
__device__ __forceinline__ unsigned cvt_pk(float lo, float hi) { f32x2 v = {lo, hi}; bf16x2_t b = __builtin_convertvector(v, bf16x2_t); return __builtin_bit_cast(unsigned, b); }
#define RLX_AGENT __ATOMIC_RELAXED, __HIP_MEMORY_SCOPE_AGENT
#define LDS_WAIT() asm volatile("s_waitcnt lgkmcnt(0)" ::: "memory")
#define VM_WAIT() asm volatile("s_waitcnt vmcnt(0)" ::: "memory")

constexpr int T = 8192, D = 2048, DIN = 10752, DC = 1024, NH = 12, HD = 128, AW = 1536, AO = 512, NE = 32, DE = 2048, TOPK = 4;
constexpr float EPS = 1e-5f;
constexpr float QSCALE = 0.12751743082459868f;
constexpr float LN2 = 0.6931471805599453f;
constexpr int MAXRT = 160, NROWS = MAXRT * 256;
constexpr int NWAVES = 8;

constexpr size_t MiB = 1u << 20;
constexpr size_t WS_CTL = 0, CTL_ZERO_BYTES = 64 * 1024;
constexpr size_t WS_WIN = 1 * MiB;
constexpr size_t WS_WCO = 43 * MiB;
constexpr size_t WS_WAO = 47 * MiB;
constexpr size_t WS_WOUT = 49 * MiB;
constexpr size_t WS_WE1 = 57 * MiB;
constexpr size_t WS_WE2 = 569 * MiB;
constexpr size_t WS_H = 825 * MiB;
constexpr size_t WS_U = 857 * MiB;
constexpr size_t WS_Q = 873 * MiB, WS_K = 897 * MiB, WS_V = 921 * MiB;
constexpr size_t WS_GATE = 945 * MiB;
constexpr size_t WS_UC = 1009 * MiB;
constexpr size_t WS_OG = 1025 * MiB;
constexpr size_t WS_LSE = 1073 * MiB;
constexpr size_t WS_OC = 1074 * MiB;
constexpr size_t WS_M1 = 1082 * MiB;
constexpr int KCAT = DC + AO;
constexpr size_t WS_MG = 1146 * MiB;
constexpr size_t WS_X1 = 1178 * MiB;
constexpr size_t WS_H2 = 1242 * MiB;
constexpr size_t WS_AE = 1274 * MiB, WS_APOS = 1275 * MiB, WS_AGATE = 1276 * MiB, WS_ASLOT = 1277 * MiB;
constexpr size_t WS_HIST = WS_ASLOT + 512 * 1024;
constexpr size_t WS_XG = 1278 * MiB;
constexpr size_t WS_ACT = 1438 * MiB;
constexpr size_t WS_Y = 1598 * MiB;
constexpr size_t WS_END = 1758 * MiB;
constexpr int CW_CNT = 64;
constexpr int CW_TS = 256;
constexpr int CW_BAR = 4096;

constexpr int RING_BYTES = 131072;
constexpr int LDSCTL_OFF = RING_BYTES, MISC_OFF = LDSCTL_OFF + 320, TAB_OFF = LDSCTL_OFF + 1024;
constexpr int LDS_BYTES = 147456;

__device__ __forceinline__ unsigned f2bf(float f) { unsigned u = __builtin_bit_cast(unsigned, f); return (u + 0x7fffu + ((u >> 16) & 1u)) >> 16; }
__device__ __forceinline__ unsigned pk2(float lo, float hi) { return f2bf(lo) | (f2bf(hi) << 16); }
__device__ __forceinline__ float bflo(unsigned w) { return __builtin_bit_cast(float, w << 16); }
__device__ __forceinline__ float bfhi(unsigned w) { return __builtin_bit_cast(float, w & 0xffff0000u); }
__device__ __forceinline__ unsigned pk4_fp8r(float a, float b, float c, float d) { int w = __builtin_amdgcn_cvt_pk_fp8_f32(a, b, __builtin_bit_cast(int, a), false); w = __builtin_amdgcn_cvt_pk_fp8_f32(c, d, w, true); return (unsigned)w; }
__device__ __forceinline__ unsigned pk4_fp8(float a, float b, float c, float d) { int w = __builtin_amdgcn_cvt_pk_fp8_f32(a, b, 0, false); w = __builtin_amdgcn_cvt_pk_fp8_f32(c, d, w, true); return (unsigned)w; }
constexpr float S_Y = 16.0f;
constexpr float S_W = 128.0f, S_X = 16.0f, S_ACT = 4.0f;
constexpr int E8_W = 127 - 7, E8_X = 127 - 4, E8_ACT = 127 - 2;
__device__ __forceinline__ float sigm(float x) { return __builtin_amdgcn_rcpf(1.0f + __expf(-x)); }
typedef float f32x2 __attribute__((ext_vector_type(2)));
__device__ __forceinline__ f32x2 sigm2(f32x2 x) { const f32x2 s = x * (-1.44269504f); f32x2 e; e.x = __builtin_amdgcn_exp2f(s.x); e.y = __builtin_amdgcn_exp2f(s.y);
    const f32x2 d = e + 1.0f; f32x2 r; r.x = __builtin_amdgcn_rcpf(d.x); r.y = __builtin_amdgcn_rcpf(d.y); return r; }
__device__ __forceinline__ unsigned gate_u8x4(float a, float b, float c, float d) { const unsigned qa = (unsigned)fmaxf(a, 1.0f), qb = (unsigned)fmaxf(b, 1.0f), qc = (unsigned)fmaxf(c, 1.0f), qd = (unsigned)fmaxf(d, 1.0f); return qa | (qb << 8) | (qc << 16) | (qd << 24); }
__device__ __forceinline__ float ub0(unsigned w) { return (float)(w & 255u); }
__device__ __forceinline__ float ub1(unsigned w) { return (float)((w >> 8) & 255u); }
__device__ __forceinline__ float ub2(unsigned w) { return (float)((w >> 16) & 255u); }
__device__ __forceinline__ float ub3(unsigned w) { return (float)(w >> 24); }
__device__ __forceinline__ f32x2 swiglu2(f32x2 g, f32x2 u, float sc) { f32x2 gg, uu; gg.x = fminf(g.x, 7.0f); gg.y = fminf(g.y, 7.0f); uu.x = __builtin_amdgcn_fmed3f(u.x, -7.0f, 7.0f); uu.y = __builtin_amdgcn_fmed3f(u.y, -7.0f, 7.0f);
    const f32x2 s = gg * (-1.702f * 1.44269504f); f32x2 e; e.x = __builtin_amdgcn_exp2f(s.x); e.y = __builtin_amdgcn_exp2f(s.y);
    const f32x2 d = e + 1.0f; f32x2 r; r.x = __builtin_amdgcn_rcpf(d.x); r.y = __builtin_amdgcn_rcpf(d.y); return (uu * sc + sc) * (gg * r); }
__device__ __forceinline__ float wave_sum(float v) {
#pragma unroll
    for (int o = 1; o < 64; o <<= 1) v += __shfl_xor(v, o);
    return v;
}
__device__ __forceinline__ float wave_max(float v) {
#pragma unroll
    for (int o = 1; o < 64; o <<= 1) v = fmaxf(v, __shfl_xor(v, o));
    return v;
}

struct EpiProj {
    static constexpr bool PERM = true, AFTER_DRAIN = false;
    bf16_t *U, *Q; unsigned char* G; const float* bgate;
    struct Pend {}; static constexpr int NPEND = 0;
    struct Pre { f32x4 bv[2][2]; };
    __device__ __forceinline__ void preload(Pre& p, const Unit& u, int wr, int wc, int fr, int fq) const { if (u.pn >= 26) { const int c0 = (u.pn - 26) * 256 + wc * 32 + 8 * fq;
#pragma unroll
        for (int bj = 0; bj < 2; ++bj)
#pragma unroll
            for (int n = 0; n < 2; ++n) p.bv[bj][n] = *(const f32x4*)(bgate + c0 + bj * 128 + 4 * n); } }
    __device__ __forceinline__ void operator()(const f32x4 (&acc)[2][2][4][2], const Unit& u, int wr, int wc, int fr, int fq, const Pre& pre) const {
        const int row0 = u.pm * 256 + wr * 64 + fr, cl = wc * 32 + 8 * fq;
        if (u.pn < 8) {
#pragma unroll
            for (int ai = 0; ai < 2; ++ai)
#pragma unroll
                for (int m = 0; m < 4; ++m) {
                    const f32x4 a0 = acc[ai][0][m][0], a1 = acc[ai][0][m][1], g0 = acc[ai][1][m][0], g1 = acc[ai][1][m][1];
                    const f32x2 p0 = (f32x2){a0[0], a0[1]} * sigm2((f32x2){g0[0], g0[1]}), p1 = (f32x2){a0[2], a0[3]} * sigm2((f32x2){g0[2], g0[3]});
                    const f32x2 p2 = (f32x2){a1[0], a1[1]} * sigm2((f32x2){g1[0], g1[1]}), p3 = (f32x2){a1[2], a1[3]} * sigm2((f32x2){g1[2], g1[3]});
                    u32x4 w; w.x = cvt_pk(p0.x, p0.y); w.y = cvt_pk(p1.x, p1.y); w.z = cvt_pk(p2.x, p2.y); w.w = cvt_pk(p3.x, p3.y);
                    *(u32x4*)(U + (size_t)(row0 + ai * 128 + m * 16) * DC + u.pn * 128 + cl) = w; }
        } else if (u.pn < 26) {
            const int s = (u.pn - 8) / 6, pl = (u.pn - 8) % 6; bf16_t* base = Q + (size_t)s * ((WS_K - WS_Q) / 2); const float sc = (s == 0) ? QSCALE : 1.0f;
#pragma unroll
            for (int ai = 0; ai < 2; ++ai)
#pragma unroll
                for (int m = 0; m < 4; ++m) { bf16_t* rowp = base + (size_t)(row0 + ai * 128 + m * 16) * AW + pl * 256 + cl;
#pragma unroll
                    for (int bj = 0; bj < 2; ++bj) { const f32x4 v0 = acc[ai][bj][m][0] * sc, v1 = acc[ai][bj][m][1] * sc;
                        u32x4 w; w.x = cvt_pk(v0[0], v0[1]); w.y = cvt_pk(v0[2], v0[3]); w.z = cvt_pk(v1[0], v1[1]); w.w = cvt_pk(v1[2], v1[3]);
                        *(u32x4*)(rowp + bj * 128) = w; } }
        } else {
            const int c0 = (u.pn - 26) * 256 + cl;
            const f32x4 (&bv)[2][2] = pre.bv;
#pragma unroll
            for (int ai = 0; ai < 2; ++ai)
#pragma unroll
                for (int m = 0; m < 4; ++m) { unsigned char* rowp = G + (size_t)(row0 + ai * 128 + m * 16) * (2 * D) + c0;
#pragma unroll
                    for (int bj = 0; bj < 2; ++bj) { const f32x4 v0 = acc[ai][bj][m][0] + bv[bj][0], v1 = acc[ai][bj][m][1] + bv[bj][1];
                        const f32x2 s0 = sigm2((f32x2){v0[0], v0[1]}) * 255.0f + 0.5f, s1 = sigm2((f32x2){v0[2], v0[3]}) * 255.0f + 0.5f, s2 = sigm2((f32x2){v1[0], v1[1]}) * 255.0f + 0.5f, s3 = sigm2((f32x2){v1[2], v1[3]}) * 255.0f + 0.5f;
                        u32x2 w; w.x = gate_u8x4(s0.x, s0.y, s1.x, s1.y); w.y = gate_u8x4(s2.x, s2.y, s3.x, s3.y);
                        *(u32x2*)(rowp + bj * 128) = w; } }
        }
    }
};
struct EpiConvOut {
    static constexpr bool PERM = false, AFTER_DRAIN = false;
    float* M1; const bf16_t* G; const float* bco;
    struct Pre {}; __device__ __forceinline__ void preload(Pre&, const Unit&, int, int, int, int) const {}
    struct Pend {}; static constexpr int NPEND = 0;
    __device__ __forceinline__ void operator()(const f32x4 (&acc)[2][2][4][2], const Unit& u, int wr, int wc, int fr, int fq, const Pre& pre) const {
        const int row0 = u.pm * 256 + wr * 64 + fr, col0 = u.pn * 256 + wc * 32 + 4 * fq;
        f32x4 bv[2][2];
#pragma unroll
        for (int bj = 0; bj < 2; ++bj)
#pragma unroll
            for (int n = 0; n < 2; ++n) bv[bj][n] = *(const f32x4*)(bco + col0 + bj * 128 + n * 16);
#pragma unroll
        for (int ai = 0; ai < 2; ++ai)
#pragma unroll
            for (int m = 0; m < 4; ++m) { const size_t row = (size_t)(row0 + ai * 128 + m * 16);
#pragma unroll
                for (int bj = 0; bj < 2; ++bj)
#pragma unroll
                    for (int n = 0; n < 2; ++n) { const int col = col0 + bj * 128 + n * 16;
                        const u32x2 gw = *(const u32x2*)(G + row * (2 * D) + col); const f32x4 v = acc[ai][bj][m][n] + bv[bj][n];
                        f32x4 o; o[0] = bflo(gw.x) * v[0]; o[1] = bfhi(gw.x) * v[1]; o[2] = bflo(gw.y) * v[2]; o[3] = bfhi(gw.y) * v[3];
                        *(f32x4*)(M1 + row * D + col) = o; } }
    }
};
struct EpiAttnOut {
    static constexpr bool PERM = false, AFTER_DRAIN = false;
    const float* M1; const bf16_t* G; bf16_t* MG;
    struct Pre {}; __device__ __forceinline__ void preload(Pre&, const Unit&, int, int, int, int) const {}
    struct Pend {}; static constexpr int NPEND = 0;
    __device__ __forceinline__ void operator()(const f32x4 (&acc)[2][2][4][2], const Unit& u, int wr, int wc, int fr, int fq, const Pre& pre) const {
        const int row0 = u.pm * 256 + wr * 64 + fr, col0 = u.pn * 256 + wc * 32 + 4 * fq;
#pragma unroll
        for (int ai = 0; ai < 2; ++ai)
#pragma unroll
            for (int m = 0; m < 4; ++m) { const size_t row = (size_t)(row0 + ai * 128 + m * 16);
#pragma unroll
                for (int bj = 0; bj < 2; ++bj)
#pragma unroll
                    for (int n = 0; n < 2; ++n) { const int col = col0 + bj * 128 + n * 16;
                        const u32x2 gw = *(const u32x2*)(G + row * (2 * D) + D + col); const f32x4 v = acc[ai][bj][m][n]; const f32x4 m1 = *(const f32x4*)(M1 + row * D + col);
                        u32x2 w; w.x = cvt_pk(m1[0] + bflo(gw.x) * v[0], m1[1] + bfhi(gw.x) * v[1]); w.y = cvt_pk(m1[2] + bflo(gw.y) * v[2], m1[3] + bfhi(gw.y) * v[3]);
                        *(u32x2*)(MG + row * D + col) = w; } }
    }
};
struct EpiMerge {
    static constexpr bool PERM = true, AFTER_DRAIN = false;
    const unsigned char* G; const float* bco; bf16_t* MG;
    struct Pre {}; __device__ __forceinline__ void preload(Pre&, const Unit&, int, int, int, int) const {}
    struct Pend {}; static constexpr int NPEND = 0;
    __device__ __forceinline__ void mid(f32x4 (&acc)[2][2][4][2], const Unit& u, int wr, int wc, int fr, int fq) const {
        int zo = 0; asm volatile("" : "+v"(zo));
        const int row0 = u.pm * 256 + wr * 64 + fr + zo, c0 = u.pn * 256 + wc * 32 + 8 * fq + zo;
        f32x4 bv[2][2];
#pragma unroll
        for (int bj = 0; bj < 2; ++bj) { bv[bj][0] = *(const f32x4*)(bco + c0 + bj * 128); bv[bj][1] = *(const f32x4*)(bco + c0 + bj * 128 + 4); }
#pragma unroll
        for (int ai = 0; ai < 2; ++ai)
#pragma unroll
            for (int m = 0; m < 4; ++m) { const unsigned char* gp = G + (size_t)(row0 + ai * 128 + m * 16) * (2 * D) + c0;
#pragma unroll
                for (int bj = 0; bj < 2; ++bj) { const u32x2 gc = *(const u32x2*)(gp + bj * 128), ga = *(const u32x2*)(gp + bj * 128 + D);
                    f32x4 r0, r1;
                    r0[0] = ub0(gc.x) * __builtin_amdgcn_rcpf(ub0(ga.x)); r0[1] = ub1(gc.x) * __builtin_amdgcn_rcpf(ub1(ga.x)); r0[2] = ub2(gc.x) * __builtin_amdgcn_rcpf(ub2(ga.x)); r0[3] = ub3(gc.x) * __builtin_amdgcn_rcpf(ub3(ga.x));
                    r1[0] = ub0(gc.y) * __builtin_amdgcn_rcpf(ub0(ga.y)); r1[1] = ub1(gc.y) * __builtin_amdgcn_rcpf(ub1(ga.y)); r1[2] = ub2(gc.y) * __builtin_amdgcn_rcpf(ub2(ga.y)); r1[3] = ub3(gc.y) * __builtin_amdgcn_rcpf(ub3(ga.y));
                    acc[ai][bj][m][0] = (acc[ai][bj][m][0] + bv[bj][0]) * r0; acc[ai][bj][m][1] = (acc[ai][bj][m][1] + bv[bj][1]) * r1; }
                asm volatile("" : "+v"(acc[ai][0][m][0]), "+v"(acc[ai][0][m][1]), "+v"(acc[ai][1][m][0]), "+v"(acc[ai][1][m][1]));
                if (m == 3) asm volatile("" ::: "memory"); }
    }
    __device__ __forceinline__ void operator()(const f32x4 (&acc)[2][2][4][2], const Unit& u, int wr, int wc, int fr, int fq, const Pre& pre) const {
        const int row0 = u.pm * 256 + wr * 64 + fr, c0 = u.pn * 256 + wc * 32 + 8 * fq;
#pragma unroll
        for (int ai = 0; ai < 2; ++ai)
#pragma unroll
            for (int m = 0; m < 4; ++m) { const size_t row = (size_t)(row0 + ai * 128 + m * 16);
#pragma unroll
                for (int bj = 0; bj < 2; ++bj) { const u32x2 ga = *(const u32x2*)(G + row * (2 * D) + D + c0 + bj * 128); const f32x4 v0 = acc[ai][bj][m][0] * (1.0f / 255.0f), v1 = acc[ai][bj][m][1] * (1.0f / 255.0f);
                    u32x4 w; w.x = cvt_pk(v0[0] * ub0(ga.x), v0[1] * ub1(ga.x)); w.y = cvt_pk(v0[2] * ub2(ga.x), v0[3] * ub3(ga.x)); w.z = cvt_pk(v1[0] * ub0(ga.y), v1[1] * ub1(ga.y)); w.w = cvt_pk(v1[2] * ub2(ga.y), v1[3] * ub3(ga.y));
                    *(u32x4*)(MG + row * D + c0 + bj * 128) = w; } }
    }
};
struct EpiDelta {
    static constexpr bool PERM = true, AFTER_DRAIN = false;
    bf16_t* DL;
    struct Pre {}; __device__ __forceinline__ void preload(Pre&, const Unit&, int, int, int, int) const {}
    struct Pend {}; static constexpr int NPEND = 0;
    __device__ __forceinline__ void operator()(const f32x4 (&acc)[2][2][4][2], const Unit& u, int wr, int wc, int fr, int fq, const Pre& pre) const {
        const int row0 = u.pm * 256 + wr * 64 + fr, c0 = u.pn * 256 + wc * 32 + 8 * fq;
#pragma unroll
        for (int ai = 0; ai < 2; ++ai)
#pragma unroll
            for (int m = 0; m < 4; ++m) { bf16_t* rowp = DL + (size_t)(row0 + ai * 128 + m * 16) * D + c0;
#pragma unroll
                for (int bj = 0; bj < 2; ++bj) { const f32x4 v0 = acc[ai][bj][m][0], v1 = acc[ai][bj][m][1];
                    u32x4 w; w.x = cvt_pk(v0[0], v0[1]); w.y = cvt_pk(v0[2], v0[3]); w.z = cvt_pk(v1[0], v1[1]); w.w = cvt_pk(v1[2], v1[3]);
                    *(u32x4*)(rowp + bj * 128) = w; } }
    }
};
struct EpiResid {
    static constexpr bool PERM = false, AFTER_DRAIN = false;
    const float* X; float* X1;
    struct Pre {}; __device__ __forceinline__ void preload(Pre&, const Unit&, int, int, int, int) const {}
    struct Pend {}; static constexpr int NPEND = 0;
    __device__ __forceinline__ void operator()(const f32x4 (&acc)[2][2][4][2], const Unit& u, int wr, int wc, int fr, int fq, const Pre& pre) const {
        const int row0 = u.pm * 256 + wr * 64 + fr, col0 = u.pn * 256 + wc * 32 + 4 * fq;
#pragma unroll
        for (int ai = 0; ai < 2; ++ai)
#pragma unroll
            for (int m = 0; m < 4; ++m) { const size_t off = (size_t)(row0 + ai * 128 + m * 16) * D + col0;
#pragma unroll
                for (int bj = 0; bj < 2; ++bj)
#pragma unroll
                    for (int n = 0; n < 2; ++n) { const f32x4 xv = *(const f32x4*)(X + off + bj * 128 + n * 16); *(f32x4*)(X1 + off + bj * 128 + n * 16) = xv + acc[ai][bj][m][n]; } }
    }
};
struct EpiSwiGLU {
    static constexpr bool PERM = true, AFTER_DRAIN = false;
    unsigned char* ACT; const float* bin;
    struct Pend { u32x2 w[8]; }; static constexpr int NPEND = 8;
    struct Pre { f32x4 bg[2], bu[2]; };
    __device__ __forceinline__ void preload(Pre& p, const Unit& u, int wr, int wc, int fr, int fq) const { const int e = u.pn >> 4, cl = (u.pn & 15) * 128 + wc * 32 + 8 * fq;
#pragma unroll
        for (int n = 0; n < 2; ++n) { p.bg[n] = *(const f32x4*)(bin + (size_t)e * (2 * DE) + cl + 4 * n); p.bu[n] = *(const f32x4*)(bin + (size_t)e * (2 * DE) + DE + cl + 4 * n); } }
    __device__ __forceinline__ void operator()(const f32x4 (&acc)[2][2][4][2], const Unit& u, int wr, int wc, int fr, int fq, const Pre& pre) const {
        const int e = u.pn >> 4, pl = u.pn & 15;
        const int row0 = u.pm * 256 + wr * 64 + fr, cl = pl * 128 + wc * 32 + 8 * fq;
        const f32x4 (&bg)[2] = pre.bg; const f32x4 (&bu)[2] = pre.bu; (void)e;
#pragma unroll
        for (int ai = 0; ai < 2; ++ai)
#pragma unroll
            for (int m = 0; m < 4; ++m) {
                if (ai == 1 && u.half) continue;
                f32x2 o[4];
#pragma unroll
                for (int n = 0; n < 2; ++n) { const f32x4 gv = acc[ai][0][m][n] + bg[n], uv = acc[ai][1][m][n] + bu[n];
                    o[2 * n] = swiglu2((f32x2){gv[0], gv[1]}, (f32x2){uv[0], uv[1]}, S_ACT); o[2 * n + 1] = swiglu2((f32x2){gv[2], gv[3]}, (f32x2){uv[2], uv[3]}, S_ACT); }
                u32x2 w; w.x = pk4_fp8(o[0].x, o[0].y, o[1].x, o[1].y); w.y = pk4_fp8(o[2].x, o[2].y, o[3].x, o[3].y);
                *(u32x2*)(ACT + (size_t)(row0 + ai * 128 + m * 16) * DE + cl) = w; }
    }
    __device__ __forceinline__ void compute(const f32x4 (&acc)[2][2][4][2], const Unit& u, int wr, int wc, int fr, int fq, const Pre& pre, Pend& p) const {
#pragma unroll
        for (int ai = 0; ai < 2; ++ai)
#pragma unroll
            for (int m = 0; m < 4; ++m) {
                float o[8];
#pragma unroll
                for (int n = 0; n < 2; ++n) { const f32x4 gv = acc[ai][0][m][n] + pre.bg[n], uv = acc[ai][1][m][n] + pre.bu[n];
#pragma unroll
                    for (int q = 0; q < 4; ++q) { const float gg = fminf(gv[q], 7.0f), uu = fminf(fmaxf(uv[q], -7.0f), 7.0f); o[4 * n + q] = (uu + 1.0f) * (gg * sigm(1.702f * gg)); } }
                p.w[ai * 4 + m].x = pk4_fp8(o[0] * S_ACT, o[1] * S_ACT, o[2] * S_ACT, o[3] * S_ACT); p.w[ai * 4 + m].y = pk4_fp8(o[4] * S_ACT, o[5] * S_ACT, o[6] * S_ACT, o[7] * S_ACT); }
    }
    __device__ __forceinline__ void store_step(Pend& p, const Unit& pu, int it, int wr, int wc, int fr, int fq) const {
        const int ai = it >> 2, m = it & 3, cl = (pu.pn & 15) * 128 + wc * 32 + 8 * fq;
        if (it < 8 && !(ai == 1 && pu.half)) *(u32x2*)(ACT + (size_t)(pu.pm * 256 + ai * 128 + wr * 64 + m * 16 + fr) * DE + cl) = p.w[0];
#pragma unroll
        for (int q = 0; q < 7; ++q) p.w[q] = p.w[q + 1];
    }
};
template <int VAR = 0> struct EpiExpOutT {
    static constexpr bool PERM = true, AFTER_DRAIN = false;
    unsigned char* Y; const float* bout;
    struct Pend {}; static constexpr int NPEND = 0;
    struct Pre { f32x4 bv[2][2]; };
    __device__ __forceinline__ void preload(Pre& p, const Unit& u, int wr, int wc, int fr, int fq) const { const int e = u.pn >> 3, c0 = (u.pn & 7) * 256 + wc * 32 + 8 * fq;
#pragma unroll
        for (int bj = 0; bj < 2; ++bj)
#pragma unroll
            for (int n = 0; n < 2; ++n) p.bv[bj][n] = (VAR == 1) ? (f32x4){0.f, 0.f, 0.f, 0.f} : *(const f32x4*)(bout + (size_t)e * D + c0 + bj * 128 + 4 * n) * S_Y; }
    __device__ __forceinline__ void operator()(const f32x4 (&acc)[2][2][4][2], const Unit& u, int wr, int wc, int fr, int fq, const Pre& pre) const {
        const int e = u.pn >> 3, pl = u.pn & 7;
        const int row0 = u.pm * 256 + wr * 64 + fr, c0 = pl * 256 + wc * 32 + 8 * fq;
        const f32x4 (&bv)[2][2] = pre.bv; (void)e;
#pragma unroll
        for (int ai = 0; ai < 2; ++ai)
#pragma unroll
            for (int m = 0; m < 4; ++m) { if (ai == 1 && u.half) continue; unsigned char* rowp = Y + (size_t)(row0 + ai * 128 + m * 16) * D + c0;
#pragma unroll
                for (int bj = 0; bj < 2; ++bj) { const f32x4 v0 = acc[ai][bj][m][0] * S_Y + bv[bj][0], v1 = acc[ai][bj][m][1] * S_Y + bv[bj][1];
                    u32x2 w; w.x = pk4_fp8(v0[0], v0[1], v0[2], v0[3]); w.y = pk4_fp8(v1[0], v1[1], v1[2], v1[3]);
                    if (VAR == 2) asm volatile("" :: "v"(w)); else *(u32x2*)(rowp + bj * 128) = w; } }
    }
};
typedef EpiExpOutT<0> EpiExpOut;

struct EpiNull { static constexpr bool PERM = true, AFTER_DRAIN = false; struct Pend {}; static constexpr int NPEND = 0; struct Pre {}; __device__ __forceinline__ void preload(Pre&, const Unit&, int, int, int, int) const {} __device__ __forceinline__ void operator()(const f32x4 (&acc)[2][2][4][2], const Unit& u, int wr, int wc, int fr, int fq, const Pre& pre) const {} };
struct MoeOrder {
    const LAS unsigned* tab; int total, G, c;
    __device__ __forceinline__ bool next(int i, Unit& u) const {
        const int L = i * G + c; if (L >= total) return false;
        const unsigned w = tab[L];
        u.pn = __builtin_amdgcn_readfirstlane((int)(w >> 16)); u.pm = __builtin_amdgcn_readfirstlane((int)(w & 0x7fffu)); u.half = __builtin_amdgcn_readfirstlane((int)((w >> 15) & 1u)); return true;
    }
    __device__ __forceinline__ void a_ready(const Unit&) const {}
    __device__ __forceinline__ void done(const Unit&) const {}
};
__device__ __forceinline__ int moe_build_tab(LAS unsigned* tab, LAS int* myexp, const LAS int* rt0, const LAS int* cntl, int NT, int tid, int myx, int NX) {
    if (tid < NE) { const int mte = rt0[tid + 1] - rt0[tid]; int rank = 0;
        for (int q = 0; q < NE; ++q) { const int mq = rt0[q + 1] - rt0[q]; rank += (mq > mte || (mq == mte && q < tid)) ? 1 : 0; }
        const int row = rank / NX, col = rank % NX, x = (row & 1) ? (NX - 1 - col) : col;
        if (x == myx) myexp[row] = tid; }
    __syncthreads();
    const int nmy = NE / NX; int total = 0;
    for (int j = 0; j < nmy; ++j) { const int e = myexp[j]; total += (rt0[e + 1] - rt0[e]) * NT; }
    for (int L = tid; L < total; L += NWAVES * 64) { int base = 0, e = myexp[0];
        for (int j = 0; j < nmy; ++j) { const int ej = myexp[j], uj = (rt0[ej + 1] - rt0[ej]) * NT; if (L >= base + uj) { base += uj; } else { e = ej; break; } }
        const int b = rt0[e], mt = rt0[e + 1] - b, idx = L - base;
        const int pml = idx % mt; const unsigned hf = (pml == mt - 1 && cntl[e] - 256 * pml <= 128) ? 1u : 0u;
        tab[L] = ((unsigned)(e * NT + idx / mt) << 16) | (hf << 15) | (unsigned)(b + pml); }
    __syncthreads();
    return total;
}

#define XB_TMO      128
#define XB_XCNT(j)  (256  + 64 * (j))
#define XB_XSUB(j)  (1280 + 64 * (j))
#define XB_XGEN(j)  (2304 + 64 * (j))
#define XB_TOP      3328
#define XB_TOPGEN   3392
#define XCD_BAR_WORDS 3456
#define XB_SPIN_CAP (1u << 18)

__device__ __forceinline__ unsigned xb_ld(unsigned* p)              { return __hip_atomic_load(p, __ATOMIC_RELAXED, __HIP_MEMORY_SCOPE_AGENT); }
__device__ __forceinline__ unsigned xb_add(unsigned* p, unsigned v) { return __hip_atomic_fetch_add(p, v, __ATOMIC_RELAXED, __HIP_MEMORY_SCOPE_AGENT); }
__device__ __forceinline__ unsigned xb_xcc_id() { return (unsigned)__builtin_amdgcn_s_getreg((3 << 11) | 20) & 0xFu; }
#define XB_SPIN(cond, bar) do { unsigned _sp = 0; while (cond) { __builtin_amdgcn_s_sleep(1); \
    if ((++_sp & 255u) == 0u) { if (xb_ld(&(bar)[XB_TMO])) break; if (_sp > XB_SPIN_CAP) { atomicAdd(&(bar)[XB_TMO], 1u); break; } } } } while (0)

struct XcdBarrier {
    unsigned* bar; unsigned x;
    volatile LAS unsigned* st;
};

__device__ __forceinline__ XcdBarrier xcd_barrier_post(unsigned* bar, volatile LAS unsigned* st) {
    XcdBarrier b; b.bar = bar; b.x = xb_xcc_id(); b.st = st;
    if (threadIdx.x == 0) (void)xb_add(&bar[XB_XCNT(b.x)], 1u);
    return b;
}
__device__ __forceinline__ void xcd_barrier_complete(unsigned* bar, unsigned x, unsigned& nloc, unsigned& nx) {
    const unsigned G = gridDim.x * gridDim.y * gridDim.z;
    unsigned sum, cnt, mine, sp = 0u;
    for (;;) {
        sum = 0u; cnt = 0u; mine = 0u;
#pragma unroll
        for (unsigned j = 0; j < 16; ++j) { const unsigned c = xb_ld(&bar[XB_XCNT(j)]); sum += c; cnt += (c > 0u) ? 1u : 0u; mine = (j == x) ? c : mine; }
        if (sum == G) break;
        __builtin_amdgcn_s_sleep(1);
        if ((++sp & 255u) == 0u) { if (xb_ld(&bar[XB_TMO])) break; if (sp > XB_SPIN_CAP) { atomicAdd(&bar[XB_TMO], 1u); break; } }
    }
    nloc = mine > 0u ? mine : 1u; nx = cnt > 0u ? cnt : 1u;
}

__device__ __forceinline__ void xcd_barrier(const XcdBarrier& b) {
    asm volatile("s_waitcnt vmcnt(0)" ::: "memory");
    __syncthreads();
    if (threadIdx.x == 0) {
        unsigned* bar = b.bar;
        __builtin_amdgcn_s_waitcnt(0);
        unsigned nloc = b.st[0], nx = b.st[1];
        if (nloc == 0u) { xcd_barrier_complete(bar, b.x, nloc, nx); b.st[0] = nloc; b.st[1] = nx; }
        const unsigned old = xb_add(&bar[XB_XSUB(b.x)], 1u);
        const unsigned gen = old / nloc;
        if (old + 1u == (gen + 1u) * nloc) {
            __builtin_amdgcn_fence(__ATOMIC_RELEASE, "agent");
            asm volatile("s_waitcnt vmcnt(0)" ::: "memory");
            const unsigned og = xb_add(&bar[XB_TOP], 1u);
            const unsigned tg = og / nx;
            if (og + 1u == (tg + 1u) * nx) xb_add(&bar[XB_TOPGEN], 1u);
            else XB_SPIN(xb_ld(&bar[XB_TOPGEN]) == tg, bar);
            __builtin_amdgcn_fence(__ATOMIC_ACQUIRE, "agent");
            xb_add(&bar[XB_XGEN(b.x)], 1u);
            asm volatile("s_waitcnt vmcnt(0)" ::: "memory");
        } else {
            XB_SPIN(xb_ld(&bar[XB_XGEN(b.x)]) == gen, bar);
            __builtin_amdgcn_fence(__ATOMIC_ACQUIRE, "agent");
            asm volatile("s_waitcnt vmcnt(0)" ::: "memory");
        }
    }
    __syncthreads();
}

struct Frame {
    LAS unsigned char* lds; volatile LAS unsigned* MISC; gu32* ctl;
    int tid, lane, wave, vcu, G;
};
struct Args { const float* in[20]; float* out; unsigned char* ws; int ph_lo, ph_hi, li, pad; };

__device__ __forceinline__ void p0_transpose_item(const float* W, int K, int N, bf16_t* WT, int k0, int n0, int drow0, LAS float* scr, int lane) {
#pragma unroll 8
    for (int i = 0; i < 32; ++i) { const int kk = 2 * i + (lane >> 5); scr[kk * 33 + (lane & 31)] = W[(size_t)(k0 + kk) * N + n0 + (lane & 31)]; }
    LDS_WAIT(); asm volatile("" ::: "memory");
    const int c = lane & 7;
#pragma unroll
    for (int j = 0; j < 4; ++j) { const int n = (lane >> 3) + 8 * j; const LAS float* s = scr + (8 * c) * 33 + n;
        u32x4 o; o.x = pk2(s[0 * 33], s[1 * 33]); o.y = pk2(s[2 * 33], s[3 * 33]); o.z = pk2(s[4 * 33], s[5 * 33]); o.w = pk2(s[6 * 33], s[7 * 33]);
        *(GAS u32x4*)(WT + (size_t)(drow0 + n) * K + k0 + 8 * c) = o; }
    LDS_WAIT(); asm volatile("" ::: "memory");
}
__device__ __forceinline__ void p0_transpose_item_fp8(const float* W, int K, int N, unsigned char* WT, int k0, int n0, int drow0, LAS float* scr, int lane) {
#pragma unroll 8
    for (int i = 0; i < 32; ++i) { const int kk = 2 * i + (lane >> 5); scr[kk * 33 + (lane & 31)] = W[(size_t)(k0 + kk) * N + n0 + (lane & 31)]; }
    LDS_WAIT(); asm volatile("" ::: "memory");
    const int c = lane & 3;
#pragma unroll
    for (int j = 0; j < 2; ++j) { const int n = (lane >> 2) + 16 * j; const LAS float* s = scr + (16 * c) * 33 + n;
        u32x4 o; o.x = pk4_fp8(s[0 * 33] * S_W, s[1 * 33] * S_W, s[2 * 33] * S_W, s[3 * 33] * S_W); o.y = pk4_fp8(s[4 * 33] * S_W, s[5 * 33] * S_W, s[6 * 33] * S_W, s[7 * 33] * S_W);
        o.z = pk4_fp8(s[8 * 33] * S_W, s[9 * 33] * S_W, s[10 * 33] * S_W, s[11 * 33] * S_W); o.w = pk4_fp8(s[12 * 33] * S_W, s[13 * 33] * S_W, s[14 * 33] * S_W, s[15 * 33] * S_W);
        *(GAS u32x4*)(WT + (size_t)(drow0 + n) * K + k0 + 16 * c) = o; }
    LDS_WAIT(); asm volatile("" ::: "memory");
}
#ifndef MK_KGL
#define MK_KGL 3
#endif
constexpr int KGL = MK_KGL, KG = 1 << KGL, CV_K8 = 16 * KG, CV_K16 = 8 * KG, CV_N = 4 * (64 >> KGL);
template <int PMODE> __device__ __forceinline__ void cvt_task_fp8(const float* W, int N, unsigned char* WT, int K, int k0, int n0, int halfN, int lane) {
    const int n = n0 + 4 * (lane >> KGL), k = k0 + 16 * (lane & (KG - 1));
    const GAS f32x4* src = (const GAS f32x4*)(W + (size_t)k * N + n);
    f32x4 v[16];
#pragma unroll
    for (int i = 0; i < 16; ++i) v[i] = __builtin_nontemporal_load(src + (size_t)i * (N / 4));
    int dr = n;
    if (PMODE == 1 || (PMODE == 2 && n < 2 * halfN)) dr = (n < halfN) ? ((n >> 7) * 256 + (n & 127)) : (((n - halfN) >> 7) * 256 + 128 + ((n - halfN) & 127));
#pragma unroll
    for (int j = 0; j < 4; ++j) { u32x4 o;
        o.x = pk4_fp8(v[0][j] * S_W, v[1][j] * S_W, v[2][j] * S_W, v[3][j] * S_W); o.y = pk4_fp8(v[4][j] * S_W, v[5][j] * S_W, v[6][j] * S_W, v[7][j] * S_W);
        o.z = pk4_fp8(v[8][j] * S_W, v[9][j] * S_W, v[10][j] * S_W, v[11][j] * S_W); o.w = pk4_fp8(v[12][j] * S_W, v[13][j] * S_W, v[14][j] * S_W, v[15][j] * S_W);
        *(GAS u32x4*)(WT + (size_t)(dr + j) * K + k) = o; }
}
template <int PMODE> __device__ __forceinline__ void cvt_task_bf16(const float* W, int N, bf16_t* WT, int K, int k0, int n0, int halfN, int lane) {
    const int n = n0 + 4 * (lane >> KGL), k = k0 + 8 * (lane & (KG - 1));
    const GAS f32x4* src = (const GAS f32x4*)(W + (size_t)k * N + n);
    f32x4 v[8];
#pragma unroll
    for (int i = 0; i < 8; ++i) v[i] = src[(size_t)i * (N / 4)];
    int dr = n;
    if (PMODE == 1 || (PMODE == 2 && n < 2 * halfN)) dr = (n < halfN) ? ((n >> 7) * 256 + (n & 127)) : (((n - halfN) >> 7) * 256 + 128 + ((n - halfN) & 127));
#pragma unroll
    for (int j = 0; j < 4; ++j) { u32x4 o; o.x = cvt_pk(v[0][j], v[1][j]); o.y = cvt_pk(v[2][j], v[3][j]); o.z = cvt_pk(v[4][j], v[5][j]); o.w = cvt_pk(v[6][j], v[7][j]);
        *(GAS u32x4*)(WT + (size_t)(dr + j) * K + k) = o; }
}
struct CvDesc { const char* sb; unsigned rstride; unsigned char* db; };
__device__ __forceinline__ CvDesc cv_desc(int it_, const float* w_ei, const float* w_eo, unsigned char* WE1, unsigned char* WE2, int lane) {
    constexpr int CVT1 = (D / CV_K8) * (2 * DE / CV_N), CVT2 = (DE / CV_K8) * (D / CV_N), CVTE = CVT1 + CVT2;
    static_assert(D == DE, "both expert matrices have K = 2048 bytes per destination row");
    const int it = __builtin_amdgcn_readfirstlane(it_); const int e = it / CVTE, q = it % CVTE; CvDesc d;
    if (q < CVT1) { const int k0 = CV_K8 * (q / (2 * DE / CV_N)), n0 = CV_N * (q % (2 * DE / CV_N));
        const int dr0 = (n0 < DE) ? ((n0 >> 7) * 256 + (n0 & 127)) : (((n0 - DE) >> 7) * 256 + 128 + ((n0 - DE) & 127));
        d.sb = (const char*)(w_ei + (size_t)e * D * 2 * DE + (size_t)k0 * (2 * DE) + n0); d.rstride = 2 * DE * 4; d.db = WE1 + (size_t)e * 2 * DE * D + (size_t)dr0 * D + k0; }
    else { const int r = q - CVT1; const int k0 = CV_K8 * (r / (D / CV_N)), n0 = CV_N * (r % (D / CV_N));
        d.sb = (const char*)(w_eo + (size_t)e * DE * D + (size_t)k0 * D + n0); d.rstride = D * 4; d.db = WE2 + (size_t)e * D * DE + (size_t)n0 * DE + k0; }
    return d;
}
__device__ __forceinline__ void cv_load(f32x4 (&v)[16], const CvDesc& d, int lane) {
    const unsigned voff = (unsigned)(16 * (lane & (KG - 1))) * d.rstride + 16u * (unsigned)(lane >> KGL);
#pragma unroll
    for (int i = 0; i < 16; ++i) v[i] = __builtin_nontemporal_load((const GAS f32x4*)(d.sb + (size_t)i * d.rstride + voff));
}
__device__ __forceinline__ void cv_store(const f32x4 (&v)[16], const CvDesc& d, int lane) {
    const unsigned doff = (unsigned)(4 * (lane >> KGL)) * (unsigned)D + 16u * (unsigned)(lane & (KG - 1));
    f32x4 s[16];
#pragma unroll
    for (int i = 0; i < 16; ++i) { s[i] = v[i] * S_W; asm volatile("" : "+v"(s[i])); }
#pragma unroll
    for (int j = 0; j < 4; ++j) { u32x4 o;
        o.x = pk4_fp8r(s[0][j], s[1][j], s[2][j], s[3][j]); o.y = pk4_fp8r(s[4][j], s[5][j], s[6][j], s[7][j]);
        o.z = pk4_fp8r(s[8][j], s[9][j], s[10][j], s[11][j]); o.w = pk4_fp8r(s[12][j], s[13][j], s[14][j], s[15][j]);
        __builtin_nontemporal_store(o, (GAS u32x4*)(d.db + (size_t)j * D + doff)); }
}
template <bool PIPE> __device__ __forceinline__ void cv_run(int lo, int hi, int w0, int wn, const float* w_ei, const float* w_eo, unsigned char* WE1, unsigned char* WE2, int lane) {
  if constexpr (PIPE) {
    int it = lo + w0; if (it >= hi) return;
    f32x4 va[16], vb[16];
    CvDesc da = cv_desc(it, w_ei, w_eo, WE1, WE2, lane), db = da;
    cv_load(va, da, lane);
    for (;;) {
        const int it2 = it + wn; const bool h2 = it2 < hi;
        db = cv_desc(h2 ? it2 : it, w_ei, w_eo, WE1, WE2, lane); cv_load(vb, db, lane);
        cv_store(va, da, lane);
        if (!h2) break;
        const int it3 = it2 + wn; const bool h3 = it3 < hi;
        da = cv_desc(h3 ? it3 : it2, w_ei, w_eo, WE1, WE2, lane); cv_load(va, da, lane);
        cv_store(vb, db, lane);
        if (!h3) break;
        it = it3;
    }
  } else {
#if defined(MK_CV_PAIR) && MK_CV_PAIR
    for (int p = (lo >> 1) + w0; p < (hi >> 1); p += wn) { f32x4 va[16], vb[16]; const CvDesc d = cv_desc(2 * p, w_ei, w_eo, WE1, WE2, lane);
        CvDesc e = d; e.sb = d.sb + 128; e.db = d.db + (size_t)32 * D;
        cv_load(va, d, lane); cv_load(vb, e, lane); cv_store(va, d, lane); cv_store(vb, e, lane); }
#else
    for (int it = lo + w0; it < hi; it += wn) { f32x4 v[16]; const CvDesc d = cv_desc(it, w_ei, w_eo, WE1, WE2, lane); cv_load(v, d, lane); cv_store(v, d, lane); }
#endif
  }
}
__device__ __forceinline__ int paired_row(int n0, int halfN) { return (n0 < halfN) ? ((n0 >> 7) * 256 + (n0 & 127)) : (((n0 - halfN) >> 7) * 256 + 128 + ((n0 - halfN) & 127)); }

__device__ __forceinline__ void rms_row_to_bf16(const float* xrow, const float* g, bf16_t* orow, int lane) {
    const GAS f32x4* xr = (const GAS f32x4*)xrow + lane;
    f32x4 v[8]; float ss = 0.f;
#pragma unroll
    for (int j = 0; j < 8; ++j) { v[j] = xr[64 * j]; ss += (v[j][0] * v[j][0] + v[j][1] * v[j][1]) + (v[j][2] * v[j][2] + v[j][3] * v[j][3]); }
    const float rs = rsqrtf(wave_sum(ss) * (1.0f / D) + EPS);
    GAS u32x2* o8 = (GAS u32x2*)orow + lane;
#pragma unroll
    for (int j = 0; j < 8; ++j) { const f32x4 gg = ((const GAS f32x4*)g)[lane + 64 * j]; u32x2 w; w.x = pk2(v[j][0] * rs * gg[0], v[j][1] * rs * gg[1]); w.y = pk2(v[j][2] * rs * gg[2], v[j][3] * rs * gg[3]); o8[64 * j] = w; }
}

__device__ __forceinline__ void rms_row_to_fp8(const float* xrow, const float* g, unsigned char* orow, int lane) {
    const GAS f32x4* xr = (const GAS f32x4*)xrow + lane;
    f32x4 v[8]; float ss = 0.f;
#pragma unroll
    for (int j = 0; j < 8; ++j) { v[j] = xr[64 * j]; ss += (v[j][0] * v[j][0] + v[j][1] * v[j][1]) + (v[j][2] * v[j][2] + v[j][3] * v[j][3]); }
    const float rs = rsqrtf(wave_sum(ss) * (1.0f / D) + EPS) * S_X;
    GAS unsigned* o4 = (GAS unsigned*)orow + lane;
#pragma unroll
    for (int j = 0; j < 8; ++j) { const f32x4 gg = ((const GAS f32x4*)g)[lane + 64 * j]; o4[64 * j] = pk4_fp8(v[j][0] * rs * gg[0], v[j][1] * rs * gg[1], v[j][2] * rs * gg[2], v[j][3] * rs * gg[3]); }
}

__device__ __forceinline__ void conv_tile(Frame& F, int tile, const bf16_t* U, const float* cw, const float* cb, const float* lg, const float* lb, bf16_t* UC) {
    const int t0 = tile * 32, c = 2 * F.tid;
    LAS float* ys = (LAS float*)F.lds;
    f32x2 w[31];
#pragma unroll
    for (int k = 0; k < 31; ++k) w[k] = *(const f32x2*)(cw + k * DC + c);
    const f32x2 bias = *(const f32x2*)(cb + c);
#pragma unroll 1
    for (int hf = 0; hf < 2; ++hf) {
        unsigned urow[46];
#pragma unroll
        for (int p = 0; p < 46; ++p) { const int tt = t0 - 30 + 16 * hf + p; const unsigned v = *(const unsigned*)(U + (size_t)(tt < 0 ? 0 : tt) * DC + c); urow[p] = (tt < 0) ? 0u : v; }
#pragma unroll
        for (int j = 0; j < 16; ++j) {
            f32x2 a = bias;
#pragma unroll
            for (int k = 0; k < 31; ++k) a += w[k] * (f32x2){bflo(urow[j + k]), bfhi(urow[j + k])};
            *(LAS f32x2*)(ys + (16 * hf + j) * DC + c) = a;
        }
    }
    __syncthreads();
#pragma unroll 1
    for (int jj = 0; jj < 4; ++jj) {
        const int j = F.wave * 4 + jj;
        f32x4 v[4]; float s = 0.f;
#pragma unroll
        for (int q = 0; q < 4; ++q) { v[q] = *(const LAS f32x4*)(ys + j * DC + 4 * F.lane + 256 * q); s += (v[q][0] + v[q][1]) + (v[q][2] + v[q][3]); }
        const float mu = wave_sum(s) * (1.0f / DC); float qq = 0.f;
#pragma unroll
        for (int q = 0; q < 4; ++q) { v[q] = v[q] - mu; qq += (v[q][0] * v[q][0] + v[q][1] * v[q][1]) + (v[q][2] * v[q][2] + v[q][3] * v[q][3]); }
        const float rstd = rsqrtf(wave_sum(qq) * (1.0f / DC) + EPS);
#pragma unroll
        for (int q = 0; q < 4; ++q) { const int cc = 4 * F.lane + 256 * q; const f32x4 g4 = *(const f32x4*)(lg + cc), b4 = *(const f32x4*)(lb + cc);
            float y[4];
#pragma unroll
            for (int z = 0; z < 4; ++z) { const float t = v[q][z] * rstd * g4[z] + b4[z]; y[z] = t * sigm(t); }
            u32x2 o; o.x = cvt_pk(y[0], y[1]); o.y = cvt_pk(y[2], y[3]);
            *(u32x2*)(UC + (size_t)(t0 + j) * KCAT + cc) = o; }
    }
    __syncthreads();
}

__device__ __forceinline__ void attn_task(const bf16_t* __restrict__ Q, const bf16_t* __restrict__ Kb, const bf16_t* __restrict__ Vb, bf16_t* OG, float* LSE, int task, int lane) {
    const int h = task >> 8, rem = task & 255;
    const int dsh = 2 * (h >> 2), dil = 1 << dsh;
    const int r = rem & (dil - 1), mc = rem >> dsh;
    const int i = lane & 31, hh = lane >> 5;
    const int m0 = mc * 32;
    const int tq = ((m0 + i) << dsh) + r;
    const float NEG = -__builtin_inff();
    bf16x8 qf[8];
    { const bf16_t* qp = Q + (size_t)tq * AW + h * HD + 8 * hh;
#pragma unroll
      for (int s = 0; s < 8; ++s) qf[s] = *(const bf16x8*)(qp + 16 * s); }
    bf16x8 kf[3][8];
#define ATT_LDK(jt_) do { int mk_ = m0 - 128 + 32 * (jt_) + i; mk_ = mk_ < 0 ? 0 : mk_; const bf16_t* kp_ = Kb + (size_t)((mk_ << dsh) + r) * AW + h * HD + 8 * hh; \
        _Pragma("unroll") for (int s_ = 0; s_ < 8; ++s_) kf[(jt_) % 3][s_] = *(const bf16x8*)(kp_ + 16 * s_); } while (0)
    ATT_LDK(0); ATT_LDK(1);
    f32x16 sacc[5];
#pragma unroll
    for (int jt = 0; jt < 5; ++jt) {
        if (jt + 2 < 5) ATT_LDK(jt + 2);
        __builtin_amdgcn_sched_barrier(0);
        f32x16 a;
#pragma unroll
        for (int q = 0; q < 16; ++q) a[q] = 0.f;
#pragma unroll
        for (int s = 0; s < 8; ++s) a = __builtin_amdgcn_mfma_f32_32x32x16_bf16(kf[jt % 3][s], qf[s], a, 0, 0, 0);
        if (jt == 0 || jt == 4) {
#pragma unroll
            for (int q = 0; q < 16; ++q) { const int kk = (q & 3) + 8 * (q >> 2) + 4 * hh;
                if (jt == 0 && kk < i) a[q] = NEG;
                if (jt == 4 && kk > i) a[q] = NEG; } }
        sacc[jt] = a;
        __builtin_amdgcn_sched_barrier(0);
    }
#undef ATT_LDK
    if (mc < 4) {
#pragma unroll
        for (int jt = 0; jt < 4; ++jt)
#pragma unroll
            for (int q = 0; q < 16; ++q) { const int mk = m0 - 128 + 32 * jt + (q & 3) + 8 * (q >> 2) + 4 * hh; if (mk < 0) sacc[jt][q] = NEG; }
    }
    float mx = NEG;
#pragma unroll
    for (int jt = 0; jt < 5; ++jt)
#pragma unroll
        for (int q = 0; q < 16; ++q) mx = fmaxf(mx, sacc[jt][q]);
    mx = fmaxf(mx, __shfl_xor(mx, 32));
    float l = 0.f;
#pragma unroll
    for (int jt = 0; jt < 5; ++jt)
#pragma unroll
        for (int q = 0; q < 16; ++q) { const float e = __builtin_amdgcn_exp2f(sacc[jt][q] - mx); sacc[jt][q] = e; l += e; }
    l += __shfl_xor(l, 32);
    const float inv = 1.0f / l;
    if (hh == 0) LSE[(size_t)tq * NH + h] = (mx + __log2f(l)) * LN2;
    bf16x8 pf[5][2];
#pragma unroll
    for (int jt = 0; jt < 5; ++jt)
#pragma unroll
        for (int s2 = 0; s2 < 2; ++s2) { u32x4 w;
            w.x = cvt_pk(sacc[jt][8 * s2 + 0] * inv, sacc[jt][8 * s2 + 1] * inv); w.y = cvt_pk(sacc[jt][8 * s2 + 2] * inv, sacc[jt][8 * s2 + 3] * inv);
            w.z = cvt_pk(sacc[jt][8 * s2 + 4] * inv, sacc[jt][8 * s2 + 5] * inv); w.w = cvt_pk(sacc[jt][8 * s2 + 6] * inv, sacc[jt][8 * s2 + 7] * inv);
            pf[jt][s2] = __builtin_bit_cast(bf16x8, w); }
    f32x16 o[4];
#pragma unroll
    for (int z = 0; z < 4; ++z)
#pragma unroll
        for (int q = 0; q < 16; ++q) o[z][q] = 0.f;
    const bf16_t* vcol = Vb + h * HD + 2 * i;
    unsigned wa[4][8], wb[4][8];
#define ATT_LDV(st_) do { _Pragma("unroll") for (int j_ = 0; j_ < 8; ++j_) { int mk_ = m0 - 128 + 16 * (st_) + 8 * (j_ >> 2) + 4 * hh + (j_ & 3); mk_ = mk_ < 0 ? 0 : mk_; \
        const bf16_t* vp_ = vcol + (size_t)((mk_ << dsh) + r) * AW; wa[(st_) % 4][j_] = *(const unsigned*)vp_; wb[(st_) % 4][j_] = *(const unsigned*)(vp_ + 64); } } while (0)
    ATT_LDV(0); ATT_LDV(1); ATT_LDV(2);
#pragma unroll
    for (int st = 0; st < 10; ++st) {
        if (st + 3 < 10) ATT_LDV(st + 3);
        __builtin_amdgcn_sched_barrier(0);
        const unsigned (&ua)[8] = wa[st % 4]; const unsigned (&ub)[8] = wb[st % 4];
        u32x4 f0, f1, f2, f3;
        f0.x = (ua[0] & 0xffffu) | (ua[1] << 16); f0.y = (ua[2] & 0xffffu) | (ua[3] << 16); f0.z = (ua[4] & 0xffffu) | (ua[5] << 16); f0.w = (ua[6] & 0xffffu) | (ua[7] << 16);
        f1.x = (ua[0] >> 16) | (ua[1] & 0xffff0000u); f1.y = (ua[2] >> 16) | (ua[3] & 0xffff0000u); f1.z = (ua[4] >> 16) | (ua[5] & 0xffff0000u); f1.w = (ua[6] >> 16) | (ua[7] & 0xffff0000u);
        f2.x = (ub[0] & 0xffffu) | (ub[1] << 16); f2.y = (ub[2] & 0xffffu) | (ub[3] << 16); f2.z = (ub[4] & 0xffffu) | (ub[5] << 16); f2.w = (ub[6] & 0xffffu) | (ub[7] << 16);
        f3.x = (ub[0] >> 16) | (ub[1] & 0xffff0000u); f3.y = (ub[2] >> 16) | (ub[3] & 0xffff0000u); f3.z = (ub[4] >> 16) | (ub[5] & 0xffff0000u); f3.w = (ub[6] >> 16) | (ub[7] & 0xffff0000u);
        o[0] = __builtin_amdgcn_mfma_f32_32x32x16_bf16(pf[st >> 1][st & 1], __builtin_bit_cast(bf16x8, f0), o[0], 0, 0, 0);
        o[1] = __builtin_amdgcn_mfma_f32_32x32x16_bf16(pf[st >> 1][st & 1], __builtin_bit_cast(bf16x8, f1), o[1], 0, 0, 0);
        o[2] = __builtin_amdgcn_mfma_f32_32x32x16_bf16(pf[st >> 1][st & 1], __builtin_bit_cast(bf16x8, f2), o[2], 0, 0, 0);
        o[3] = __builtin_amdgcn_mfma_f32_32x32x16_bf16(pf[st >> 1][st & 1], __builtin_bit_cast(bf16x8, f3), o[3], 0, 0, 0);
        __builtin_amdgcn_sched_barrier(0);
    }
#undef ATT_LDV
#pragma unroll
    for (int q = 0; q < 16; ++q) { const int qi = (q & 3) + 8 * (q >> 2) + 4 * hh; const int tt = ((m0 + qi) << dsh) + r;
        bf16_t* op = OG + ((size_t)tt * NH + h) * HD + 2 * i;
        *(unsigned*)op = cvt_pk(o[0][q], o[1][q]); *(unsigned*)(op + 64) = cvt_pk(o[2][q], o[3][q]); }
}

__device__ __forceinline__ float tp_value(gu32* ctl, int idx) {
    const int k = idx & 15, ks = (k == 6) ? 5 : k; const unsigned st = ~__hip_atomic_load((unsigned*)(ctl + CW_TS + ks), RLX_AGENT);
    const unsigned e1 = __hip_atomic_load((unsigned*)(ctl + CW_TS + 16 + k), RLX_AGENT), e2 = __hip_atomic_load((unsigned*)(ctl + CW_TS + 32 + k), RLX_AGENT);
    if (idx >= 32) { const unsigned nx = ~__hip_atomic_load((unsigned*)(ctl + CW_TS + k + 1), RLX_AGENT); const unsigned em = (e2 != 0u && (int)(e2 - e1) > 0) ? e2 : e1; return (float)(int)(nx - em) * 0.01f; }
    return (float)(int)(((idx >= 16) ? e2 : e1) - st) * 0.01f;
}
#ifndef MK_DEFER9
#define MK_DEFER9 false
#endif
#ifndef MK_BAUX
#define MK_BAUX 0
#endif
__global__ void __launch_bounds__(NWAVES * 64, 2) mk_fwd(Args args) {
    extern __shared__ __attribute__((aligned(16))) unsigned char lds[];
    Frame F;
    F.lds = (LAS unsigned char*)lds;
    F.MISC = (volatile LAS unsigned*)(F.lds + MISC_OFF);
    F.tid = threadIdx.x; F.lane = F.tid & 63; F.wave = __builtin_amdgcn_readfirstlane(F.tid >> 6);
    F.G = gridDim.x; { const int bx = blockIdx.x; F.vcu = (F.G % 8 == 0) ? (bx % 8) * (F.G / 8) + bx / 8 : bx; }
    unsigned char* ws = args.ws;
    F.ctl = (gu32*)(ws + WS_CTL);
    for (int u = F.tid; u < (LDS_BYTES - LDSCTL_OFF) / 4; u += NWAVES * 64) ((LAS unsigned*)(F.lds + LDSCTL_OFF))[u] = 0u;
    __syncthreads();
    const bool one_launch = (args.ph_hi - args.ph_lo) > 1;
    XcdBarrier bar; bar.bar = (unsigned*)(F.ctl + CW_BAR) + args.li * XCD_BAR_WORDS; bar.x = 0; bar.st = nullptr;
    if (one_launch) bar = xcd_barrier_post((unsigned*)(F.ctl + CW_BAR) + args.li * XCD_BAR_WORDS, F.MISC + 8);
    const int lo = args.ph_lo, hi = args.ph_hi;
#ifndef MK_PHASE_MASK
#define MK_PHASE_MASK 0xfff
#endif
#define IN(k) ((((MK_PHASE_MASK) >> (k)) & 1) && lo <= (k) && (k) < hi)
#define SEAM(k) do { if (IN(k) && IN((k) + 1)) xcd_barrier(bar); } while (0)
#ifdef MK_TPROBE_A
#define TS_IN(k) do { if (IN(k) && F.tid == 0) atomicMax((unsigned*)(F.ctl + CW_TS + (k)), ~(unsigned)__builtin_amdgcn_s_memrealtime()); } while (0)
#define TS_OUT(k, cv) do { if (IN(k) && F.tid == 0) atomicMax((unsigned*)(F.ctl + CW_TS + ((cv) ? 32 : 16) + (k)), (unsigned)__builtin_amdgcn_s_memrealtime()); } while (0)
#else
#define TS_IN(k) do {} while (0)
#define TS_OUT(k, cv) do {} while (0)
#endif
#ifndef MK_REPEAT
#define MK_REPEAT (-1)
#endif
#define REPS(k) for (int rep_ = 0; rep_ < ((k) == MK_REPEAT ? 2 : 1); ++rep_)

    const float* x = args.in[0]; const float* n1g = args.in[1]; const float* w_in = args.in[2]; const float* b_gate = args.in[3];
    const float* conv_w = args.in[4]; const float* conv_b = args.in[5]; const float* ln_g = args.in[6]; const float* ln_b = args.in[7];
    const float* w_co = args.in[8]; const float* b_co = args.in[9]; const float* w_ao = args.in[10]; const float* w_out = args.in[11];
    const float* n2g = args.in[12]; const float* w_r = args.in[13]; const float* b_r = args.in[14];
    const float* w_ei = args.in[15]; const float* b_ei = args.in[16]; const float* w_eo = args.in[17]; const float* b_eo = args.in[18]; const float* nfg = args.in[19];
    bf16_t* WIN = (bf16_t*)(ws + WS_WIN); bf16_t* WCO = (bf16_t*)(ws + WS_WCO); bf16_t* WAO = (bf16_t*)(ws + WS_WAO); bf16_t* WOUT = (bf16_t*)(ws + WS_WOUT);
    unsigned char* WE1 = ws + WS_WE1; unsigned char* WE2 = ws + WS_WE2;
    bf16_t* Hb = (bf16_t*)(ws + WS_H); bf16_t* Ub = (bf16_t*)(ws + WS_U); bf16_t* Qb = (bf16_t*)(ws + WS_Q); bf16_t* Kb = (bf16_t*)(ws + WS_K); bf16_t* Vb = (bf16_t*)(ws + WS_V);
    unsigned char* Gb = ws + WS_GATE; bf16_t* UCb = (bf16_t*)(ws + WS_M1);     bf16_t* OG = (bf16_t*)(ws + WS_OG); float* LSE = (float*)(ws + WS_LSE); bf16_t* OCb = (bf16_t*)(ws + WS_M1) + DC;
    float* M1 = (float*)(ws + WS_M1); bf16_t* MGb = (bf16_t*)(ws + WS_MG); bf16_t* DLb = (bf16_t*)(ws + WS_X1);     unsigned char* H2f = ws + WS_H2;
    int* a_e = (int*)(ws + WS_AE); int* a_pos = (int*)(ws + WS_APOS); float* a_gate = (float*)(ws + WS_AGATE); int* a_slot = (int*)(ws + WS_ASLOT);
    unsigned char* XG = ws + WS_XG; unsigned char* ACT = ws + WS_ACT; unsigned char* Yb = ws + WS_Y;
    int* hist = (int*)(ws + WS_HIST);
    const int gw = F.vcu * NWAVES + F.wave, NGW = F.G * NWAVES;
#ifndef MK_NCV
#define MK_NCV 8
#endif
    const int bx = (int)blockIdx.x;
    const bool grp = (MK_NCV > 0) && (F.G % 8 == 0) && (F.G / 8 > MK_NCV);
    const int cgG = grp ? F.G - 8 * MK_NCV : F.G;
    const bool is_cv = grp && bx >= cgG;
    const int cg_vcu = grp ? (bx % 8) * (cgG / 8) + bx / 8 : F.vcu;
    const int cg_gw = cg_vcu * NWAVES + F.wave, cg_NGW = cgG * NWAVES;
    const int cv_gw = (bx - cgG) * NWAVES + F.wave, cv_NGW = 8 * MK_NCV * NWAVES;
#ifndef MK_NCV7
#define MK_NCV7 MK_NCV
#endif
    const bool grp7 = grp && (F.G / 8 > MK_NCV7);
    const int cgG7 = grp7 ? F.G - 8 * MK_NCV7 : cgG; const bool is_cv7 = grp7 ? bx >= cgG7 : is_cv;
    const int cg_vcu7 = grp7 ? (bx % 8) * (cgG7 / 8) + bx / 8 : cg_vcu;
    const int cv_gw7 = grp7 ? (bx - cgG7) * NWAVES + F.wave : cv_gw, cv_NGW7 = grp7 ? 8 * MK_NCV7 * NWAVES : cv_NGW;
    constexpr int CVT1 = (D / CV_K8) * (2 * DE / CV_N), CVT2 = (DE / CV_K8) * (D / CV_N), CVTE = CVT1 + CVT2, CVTOT = NE * CVTE;
#ifndef MK_CVSPLIT
#define MK_CVSPLIT 0, 77824, 86016, 87552, 97280
#endif
    constexpr int cvs_[5] = {MK_CVSPLIT};
    const int CV_C0 = grp ? cvs_[0] : CVTOT, CV_C1 = grp ? cvs_[1] : CVTOT, CV_C2 = grp ? cvs_[2] : CVTOT, CV_C3 = grp ? cvs_[3] : CVTOT, CV_C4 = grp ? cvs_[4] : CVTOT;
#ifndef MK_PIPE_P0
#define MK_PIPE_P0 true
#endif
#ifndef MK_PIPE_CV
#define MK_PIPE_CV false
#endif
#define CV_RUN(lo_, hi_, w0_, wn_) cv_run<MK_PIPE_CV>((lo_), (hi_), (w0_), (wn_), w_ei, w_eo, WE1, WE2, F.lane)

    TS_IN(0);
    REPS(0) if (IN(0)) {
        if (rep_) xcd_barrier(bar);
        { constexpr int NB_IN = DIN / CV_N, T_IN = (D / CV_K8) * NB_IN;
          for (int it = gw; it < T_IN; it += NGW) cvt_task_fp8<2>(w_in, DIN, (unsigned char*)WIN, D, CV_K8 * (it / NB_IN), CV_N * (it % NB_IN), 1024, F.lane); }
        cv_run<MK_PIPE_P0>(0, CV_C0, gw, NGW, w_ei, w_eo, WE1, WE2, F.lane);
        for (int m = gw; m < T; m += NGW) rms_row_to_fp8(x + (size_t)m * D, n1g, (unsigned char*)Hb + (size_t)m * D, F.lane);
    }
    TS_OUT(0, is_cv && (0 == 1 || 0 == 2 || 0 == 3 || 0 == 7 || 0 == 8));
    SEAM(0);
    TS_IN(1);
#ifndef MK_NCV1
#define MK_NCV1 18
#endif
    const bool grp1 = grp && (F.G / 8 > MK_NCV1); const int cg1G = grp1 ? F.G - 8 * MK_NCV1 : cgG; const bool is_cv1 = grp1 ? bx >= cg1G : is_cv;
    if (IN(1)) {
        if (!is_cv1) {
            pg8::Gemm g{Hb, WIN, T, DIN, D / 2}; pg8::StaticOrder S; S.init(T, DIN, cg1G, bx);
#ifdef MK_STAGGER
            if ((bx >> 3) & 1) { const unsigned long long t0_ = __builtin_amdgcn_s_memrealtime(); while (__builtin_amdgcn_s_memrealtime() - t0_ < (unsigned long long)(MK_STAGGER)) __builtin_amdgcn_s_sleep(8); }
#endif
            static_assert(WS_V - WS_K == WS_K - WS_Q, "q|k|v strides"); EpiProj E{Ub, Qb, Gb, b_gate};
            pg8::gemm_phase<EpiProj, pg8::StaticOrder, true, true, E8_W, E8_X>(F.lds, g, S, E);
#ifndef MK_PIPE_P1
#define MK_PIPE_P1 false
#endif
#ifndef MK_CVW1
#define MK_CVW1 NWAVES
#endif
        } else if (F.wave < MK_CVW1) cv_run<MK_PIPE_P1>(CV_C0, CV_C1, (bx - cg1G) * MK_CVW1 + F.wave, (F.G - cg1G) * MK_CVW1, w_ei, w_eo, WE1, WE2, F.lane);
    }
    TS_OUT(1, is_cv1);
    SEAM(1);
    TS_IN(2);
    REPS(2) if (IN(2)) {
        if (rep_) xcd_barrier(bar);
#ifndef MK_NO_CONV
        if (!is_cv) for (int tile = cg_vcu; tile < T / 32; tile += cgG) conv_tile(F, tile, Ub, conv_w, conv_b, ln_g, ln_b, UCb);
#endif
#ifndef MK_NO_ATTN
        if (!is_cv) for (int task = cg_gw; task < NH * 256; task += cg_NGW) attn_task(Qb, Kb, Vb, OG, LSE, task, F.lane);
        if (is_cv) CV_RUN(CV_C1, CV_C2, cv_gw, cv_NGW);
#endif
    }
    TS_OUT(2, is_cv && (2 == 1 || 2 == 2 || 2 == 3 || 2 == 7 || 2 == 8));
    SEAM(2);
    TS_IN(3);
#ifdef MK_EXTRA_BARRIERS
    for (int xb_ = 0; xb_ < MK_EXTRA_BARRIERS; ++xb_) xcd_barrier(bar);
#endif
    REPS(3) if (IN(3)) {
        if (rep_) xcd_barrier(bar);
        if (is_cv) CV_RUN(CV_C2, CV_C3, cv_gw, cv_NGW);
        if (!is_cv) {
            const int hg = F.lane >> 4, d0 = 8 * (F.lane & 15);
#pragma unroll 1
            for (int t0 = cg_gw; t0 < T; t0 += 2 * cg_NGW) {
                float lw[2][3]; u32x4 og[2][3]; bool ok[2];
#pragma unroll
                for (int z = 0; z < 2; ++z) { const int t = t0 + z * cg_NGW; ok[z] = t < T; const int tc = ok[z] ? t : t0;
#pragma unroll
                    for (int g = 0; g < 3; ++g) { lw[z][g] = LSE[(size_t)tc * NH + 4 * g + hg]; og[z][g] = *(const u32x4*)(OG + ((size_t)tc * NH + 4 * g + hg) * HD + d0); } }
#pragma unroll
                for (int z = 0; z < 2; ++z) { if (!ok[z]) continue; const int t = t0 + z * cg_NGW;
                    const float m = fmaxf(lw[z][0], fmaxf(lw[z][1], lw[z][2])); float w0 = __expf(lw[z][0] - m), w1 = __expf(lw[z][1] - m), w2 = __expf(lw[z][2] - m); const float inv = 1.0f / (w0 + w1 + w2); w0 *= inv; w1 *= inv; w2 *= inv;
                    const unsigned* pa = (const unsigned*)&og[z][0]; const unsigned* pb = (const unsigned*)&og[z][1]; const unsigned* pc = (const unsigned*)&og[z][2];
                    u32x4 o;
#pragma unroll
                    for (int q = 0; q < 4; ++q) { const unsigned ua = og[z][0][q], ub = og[z][1][q], uc_ = og[z][2][q];
                        o[q] = cvt_pk(bflo(ua) * w0 + bflo(ub) * w1 + bflo(uc_) * w2, bfhi(ua) * w0 + bfhi(ub) * w1 + bfhi(uc_) * w2); }
                    (void)pa; (void)pb; (void)pc;
                    *(u32x4*)(OCb + (size_t)t * KCAT + hg * HD + d0) = o; }
            }
            { constexpr int NB = D / CV_N, T_CO = (DC / CV_K16) * NB, T_AO = (AO / CV_K16) * NB, T_OUT = (D / CV_K16) * NB;
              for (int it = cg_gw; it < T_CO + T_AO + T_OUT; it += cg_NGW) { int q = it;
                  if (q < T_CO) { cvt_task_bf16<0>(w_co, D, WCO, KCAT, CV_K16 * (q / NB), CV_N * (q % NB), 0, F.lane); continue; } q -= T_CO;
                  if (q < T_AO) { cvt_task_bf16<0>(w_ao, D, WCO + DC, KCAT, CV_K16 * (q / NB), CV_N * (q % NB), 0, F.lane); continue; } q -= T_AO;
                  cvt_task_bf16<0>(w_out, D, WOUT, D, CV_K16 * (q / NB), CV_N * (q % NB), 0, F.lane); } }
        }
    }
    TS_OUT(3, is_cv && (3 == 1 || 3 == 2 || 3 == 3 || 3 == 7 || 3 == 8));
    SEAM(3);
    TS_IN(4);
    if (IN(4)) {
        pg8::Gemm g{UCb, WCO, T, D, KCAT}; pg8::StaticOrder S; S.init(T, D, F.G, (int)blockIdx.x);
        EpiMerge E{Gb, b_co, MGb};
        pg8::gemm_phase<EpiMerge, pg8::StaticOrder, false, true, 0, 0, DC / 64>(F.lds, g, S, E);
    }
    TS_OUT(4, is_cv && (4 == 1 || 4 == 2 || 4 == 3 || 4 == 7 || 4 == 8));
    SEAM(4);
    TS_IN(5);
    if (IN(6)) {
        pg8::Gemm g{MGb, WOUT, T, D, D}; pg8::StaticOrder S; S.init(T, D, F.G, (int)blockIdx.x);
        EpiDelta E{DLb};
        pg8::gemm_phase<EpiDelta, pg8::StaticOrder, false, true>(F.lds, g, S, E);
        if (MK_REPEAT == 6) {
            xcd_barrier(bar);
            pg8::Gemm g{MGb, WOUT, T, D, D}; pg8::StaticOrder S; S.init(T, D, F.G, (int)blockIdx.x);
        EpiDelta E{DLb};
        pg8::gemm_phase<EpiDelta, pg8::StaticOrder, false, true>(F.lds, g, S, E);
        }
    }
    TS_OUT(6, is_cv && (6 == 1 || 6 == 2 || 6 == 3 || 6 == 7 || 6 == 8));
    SEAM(6);
    TS_IN(7);
    REPS(7) if (IN(7)) {
        if (rep_) xcd_barrier(bar);
        LAS float* xs = (LAS float*)F.lds;
        LAS int* ue = (LAS int*)(F.lds + TAB_OFF + 256);
        f32x2 wreg[16][4];
        { const int ep = F.lane & 15, kq = F.lane >> 4;
#pragma unroll
          for (int b = 0; b < 16; ++b)
#pragma unroll
              for (int q = 0; q < 4; ++q) wreg[b][q] = *(const f32x2*)(w_r + (size_t)(256 * F.wave + 16 * b + 4 * kq + q) * NE + 2 * ep); }
        if (is_cv7) CV_RUN(CV_C3, CV_C4, cv_gw7, cv_NGW7);
        if (!is_cv7) for (int unit = cg_vcu7; unit < T / 16; unit += cgG7) {
            const int t0 = unit * 16;
#pragma unroll 1
            for (int tt = 2 * F.wave; tt < 2 * F.wave + 2; ++tt) {
                const GAS f32x4* xr = (const GAS f32x4*)(x + (size_t)(t0 + tt) * D) + F.lane; const GAS u32x2* dr = (const GAS u32x2*)(DLb + (size_t)(t0 + tt) * D) + F.lane;
                f32x4 v[8]; u32x2 dv[8]; float ss = 0.f;
#pragma unroll
                for (int j = 0; j < 8; ++j) { v[j] = xr[64 * j]; dv[j] = dr[64 * j]; }
#pragma unroll
                for (int j = 0; j < 8; ++j) { v[j][0] += bflo(dv[j].x); v[j][1] += bfhi(dv[j].x); v[j][2] += bflo(dv[j].y); v[j][3] += bfhi(dv[j].y); ss += (v[j][0] * v[j][0] + v[j][1] * v[j][1]) + (v[j][2] * v[j][2] + v[j][3] * v[j][3]); }
#pragma unroll
                for (int j = 0; j < 8; ++j) { u32x2 w; w.x = cvt_pk(v[j][0], v[j][1]); w.y = cvt_pk(v[j][2], v[j][3]); ((GAS u32x2*)(DLb + (size_t)(t0 + tt) * D) + F.lane)[64 * j] = w; }
                const float rs = rsqrtf(wave_sum(ss) * (1.0f / D) + EPS);
                GAS unsigned* o4 = (GAS unsigned*)(H2f + (size_t)(t0 + tt) * D) + F.lane;
#pragma unroll
                for (int j = 0; j < 8; ++j) { const f32x4 gg = ((const GAS f32x4*)n2g)[F.lane + 64 * j]; const f32x4 y = v[j] * rs * gg;
                    *(LAS f32x4*)(xs + tt * D + 4 * (F.lane + 64 * j)) = y; o4[64 * j] = pk4_fp8(y[0] * S_X, y[1] * S_X, y[2] * S_X, y[3] * S_X); }
            }
            __syncthreads();
            f32x2 pacc[16];
#pragma unroll
            for (int tt = 0; tt < 16; ++tt) pacc[tt] = (f32x2){0.f, 0.f};
            { const LAS float* xb = xs + 256 * F.wave + 4 * (F.lane >> 4);
#pragma unroll
              for (int b = 0; b < 16; ++b) {
#pragma unroll
                  for (int tt = 0; tt < 16; ++tt) { const f32x4 xv = *(const LAS f32x4*)(xb + tt * D + 16 * b); pacc[tt] += (wreg[b][0] * xv[0] + wreg[b][1] * xv[1]) + (wreg[b][2] * xv[2] + wreg[b][3] * xv[3]);
                      if ((tt & 7) == 7) __builtin_amdgcn_sched_barrier(0); }
              } }
#pragma unroll
            for (int tt = 0; tt < 16; ++tt) { pacc[tt][0] += __shfl_xor(pacc[tt][0], 16); pacc[tt][1] += __shfl_xor(pacc[tt][1], 16); pacc[tt][0] += __shfl_xor(pacc[tt][0], 32); pacc[tt][1] += __shfl_xor(pacc[tt][1], 32); }
            __syncthreads();
            if (F.lane < 16) {
#pragma unroll
                for (int tt = 0; tt < 16; ++tt) *(LAS f32x2*)(xs + (F.wave * 16 + tt) * 32 + 2 * F.lane) = pacc[tt];
            }
            __syncthreads();
#pragma unroll 1
            for (int tt = 2 * F.wave; tt < 2 * F.wave + 2; ++tt) {
                float lg = -__builtin_inff();
                if (F.lane < 32) { float s = b_r[F.lane];
#pragma unroll
                    for (int w = 0; w < 8; ++w) s += xs[(w * 16 + tt) * 32 + F.lane];
                    lg = s; }
                int sel_e[4]; float sel_v[4];
#pragma unroll
                for (int k = 0; k < 4; ++k) { const float m = wave_max(lg); const unsigned long long b = __ballot(lg == m); const int e = __ffsll((long long)b) - 1; sel_e[k] = e; sel_v[k] = m; if (F.lane == e) lg = -__builtin_inff(); }
                const float e1 = __expf(sel_v[1] - sel_v[0]), e2 = __expf(sel_v[2] - sel_v[0]), e3 = __expf(sel_v[3] - sel_v[0]);
                const float inv = 1.0f / (1.0f + e1 + e2 + e3);
                if (F.lane < 4) {
                    const int e = F.lane == 0 ? sel_e[0] : F.lane == 1 ? sel_e[1] : F.lane == 2 ? sel_e[2] : sel_e[3];
                    const float gt = (F.lane == 0 ? 1.0f : F.lane == 1 ? e1 : F.lane == 2 ? e2 : e3) * inv;
                    const int a = (t0 + tt) * 4 + F.lane; a_e[a] = e; a_gate[a] = gt; ue[tt * 4 + F.lane] = e;
                }
            }
            __syncthreads();
            if (F.wave == 0) {
                const int e = ue[F.lane]; int rank = 0, mycount = 0;
#pragma unroll 4
                for (int q = 0; q < NE; ++q) { const unsigned long long mq = __ballot(e == q); if (e == q) rank = __popcll(mq & ((1ull << F.lane) - 1ull)); if (F.lane == q) mycount = __popcll(mq); }
                a_pos[t0 * 4 + F.lane] = rank;
                if (F.lane < NE) hist[unit * NE + F.lane] = mycount;
            }
            __syncthreads();
        }
    }
    TS_OUT(7, is_cv && (7 == 1 || 7 == 2 || 7 == 3 || 7 == 7 || 7 == 8));
    TS_OUT(7, is_cv && (7 == 1 || 7 == 2 || 7 == 3 || 7 == 7 || 7 == 8));
    SEAM(7);
    TS_IN(8);
    LAS int* rt0 = (LAS int*)(F.lds + TAB_OFF);
    LAS int* cntl = (LAS int*)(F.lds + TAB_OFF + 512);
    LAS int* ubase = (LAS int*)(F.lds + TAB_OFF + 768);
    LAS int* myexp = (LAS int*)(F.lds + TAB_OFF + 896);
    LAS int* part = (LAS int*)(F.lds + TAB_OFF + 1024);
    if (hi > 8 && lo <= 10) {
        { const int e = F.tid & 31, p = F.tid >> 5; int hv[32]; int sacc_ = 0;
#pragma unroll
          for (int i = 0; i < 32; ++i) hv[i] = hist[(32 * p + i) * NE + e];
#pragma unroll
          for (int i = 0; i < 32; ++i) sacc_ += hv[i];
          part[p * NE + e] = sacc_;
          __syncthreads();
          if (F.tid < NE) { int c = 0;
#pragma unroll
              for (int q = 0; q < 16; ++q) c += part[q * NE + F.tid];
              cntl[F.tid] = c; }
          int pre = 0;
          for (int q = 0; q < p; ++q) pre += part[q * NE + e];
          LAS int* ubt = (LAS int*)F.lds;
#pragma unroll
          for (int i = 0; i < 32; ++i) { ubt[(32 * p + i) * NE + e] = pre; pre += hv[i]; } }
        __syncthreads();
        if (F.tid == 0) { int a = 0; for (int e = 0; e < NE; ++e) { rt0[e] = a; a += (cntl[e] + 255) >> 8; } rt0[NE] = a; }
        __syncthreads();
    }
    REPS(8) if (IN(8)) {
        if (rep_) xcd_barrier(bar);
        if (is_cv) CV_RUN(CV_C4, CVTOT, cv_gw, cv_NGW);
        if (!is_cv) for (int unit = cg_vcu; unit < T / 16; unit += cgG) {
#pragma unroll 1
            for (int j = 0; j < 8; ++j) { const int a = unit * 64 + F.wave * 8 + j; const int e = a_e[a], slot = 256 * rt0[e] + ((const LAS int*)F.lds)[unit * NE + e] + a_pos[a];
                if (F.lane == 0) a_slot[a] = slot;
                const GAS u32x4* src = (const GAS u32x4*)(H2f + (size_t)(a >> 2) * D) + F.lane; GAS u32x4* dst = (GAS u32x4*)(XG + (size_t)slot * D) + F.lane;
#pragma unroll
                for (int q = 0; q < 2; ++q) dst[64 * q] = src[64 * q]; }
        }
        if (!is_cv) for (int it = cg_gw; it < NE * 256; it += cg_NGW) { const int e = it >> 8, j = it & 255; const int row = 256 * rt0[e] + cntl[e] + j;
            if (row < 256 * rt0[e + 1]) { GAS u32x4* dst = (GAS u32x4*)(XG + (size_t)row * D) + F.lane;
#pragma unroll
                for (int j2 = 0; j2 < 2; ++j2) dst[64 * j2] = (u32x4){0u, 0u, 0u, 0u}; } }
    }
    TS_OUT(8, is_cv && (8 == 1 || 8 == 2 || 8 == 3 || 8 == 7 || 8 == 8));
    SEAM(8);
    TS_IN(9);
    if (IN(9)) {
        pg8::Gemm g{(const bf16_t*)XG, (const bf16_t*)WE1, NROWS, NE * 2 * DE, D / 2}; LAS unsigned* utab = (LAS unsigned*)(F.lds + TAB_OFF + 4096); const int NX = (F.G % 8 == 0) ? 8 : 1; const int utot = moe_build_tab(utab, myexp, rt0, cntl, 16, F.tid, (int)blockIdx.x % NX, NX); MoeOrder S{utab, utot, F.G / NX, (int)blockIdx.x / NX};
        EpiSwiGLU E{ACT, b_ei};
        pg8::gemm_phase<EpiSwiGLU, MoeOrder, true, true, E8_W, E8_X, 0, MK_BAUX, MK_DEFER9>(F.lds, g, S, E);
        if (MK_REPEAT == 9) {
            xcd_barrier(bar);
            pg8::Gemm g{(const bf16_t*)XG, (const bf16_t*)WE1, NROWS, NE * 2 * DE, D / 2}; LAS unsigned* utab = (LAS unsigned*)(F.lds + TAB_OFF + 4096); const int NX = (F.G % 8 == 0) ? 8 : 1; const int utot = moe_build_tab(utab, myexp, rt0, cntl, 16, F.tid, (int)blockIdx.x % NX, NX); MoeOrder S{utab, utot, F.G / NX, (int)blockIdx.x / NX};
        EpiSwiGLU E{ACT, b_ei};

#ifdef MK_REPEAT_NOEPI
            { EpiNull EN; pg8::gemm_phase<EpiNull, MoeOrder, true, true, E8_W, E8_X>(F.lds, g, S, EN); }
#else
            pg8::gemm_phase<EpiSwiGLU, MoeOrder, true, true, E8_W, E8_X, 0, MK_BAUX, MK_DEFER9>(F.lds, g, S, E);
#endif

        }
    }
    TS_OUT(9, is_cv && (9 == 1 || 9 == 2 || 9 == 3 || 9 == 7 || 9 == 8));
    SEAM(9);
    TS_IN(10);
    if (IN(10)) {
        pg8::Gemm g{(const bf16_t*)ACT, (const bf16_t*)WE2, NROWS, NE * D, DE / 2}; LAS unsigned* utab = (LAS unsigned*)(F.lds + TAB_OFF + 4096); const int NX = (F.G % 8 == 0) ? 8 : 1; const int utot = moe_build_tab(utab, myexp, rt0, cntl, 8, F.tid, (int)blockIdx.x % NX, NX); MoeOrder S{utab, utot, F.G / NX, (int)blockIdx.x / NX};
        EpiExpOut E{Yb, b_eo};
        pg8::gemm_phase<EpiExpOut, MoeOrder, true, true, E8_W, E8_ACT, 0, MK_BAUX>(F.lds, g, S, E);
        if (MK_REPEAT == 10) {
            xcd_barrier(bar);
            pg8::Gemm g{(const bf16_t*)ACT, (const bf16_t*)WE2, NROWS, NE * D, DE / 2}; LAS unsigned* utab = (LAS unsigned*)(F.lds + TAB_OFF + 4096); const int NX = (F.G % 8 == 0) ? 8 : 1; const int utot = moe_build_tab(utab, myexp, rt0, cntl, 8, F.tid, (int)blockIdx.x % NX, NX); MoeOrder S{utab, utot, F.G / NX, (int)blockIdx.x / NX};
        EpiExpOut E{Yb, b_eo};

#ifdef MK_REPEAT_NOEPI
            { typedef EpiExpOutT<MK_REPEAT_NOEPI> EV; EV EN{Yb, b_eo}; pg8::gemm_phase<EV, MoeOrder, true, true, E8_W, E8_ACT>(F.lds, g, S, EN); }
#else
            pg8::gemm_phase<EpiExpOut, MoeOrder, true, true, E8_W, E8_ACT, 0, MK_BAUX>(F.lds, g, S, E);
#endif

        }
    }
    TS_OUT(10, is_cv && (10 == 1 || 10 == 2 || 10 == 3 || 10 == 7 || 10 == 8));
    SEAM(10);
    TS_IN(11);
    REPS(11) if (IN(11)) {
        if (rep_) xcd_barrier(bar);
        float tp_scale = 1.0f, tp_b = 0.f;
#ifdef MK_TPROBE_A
#if defined(MK_TB)
        { int code = 0; const int tb[8] = {MK_TB};
#pragma unroll
          for (int j = 0; j < 4; ++j) if (tp_value(F.ctl, tb[2 * j]) > (float)tb[2 * j + 1]) code |= 1 << j;
          tp_scale = 1.0f + 0.25f * (float)(code + 1); tp_b = 0.f; }
#elif defined(MK_TPROBE_BITS)
        { int code = 0; const int ph[4] = {1, 2, 7, 8};
#pragma unroll
          for (int j = 0; j < 4; ++j) { const float dv = tp_value(F.ctl, 16 + ph[j]) - tp_value(F.ctl, ph[j]); if (dv > (float)(MK_TPROBE_BITS)) code |= 1 << j; }
          tp_scale = 1.0f + 0.25f * (float)(code + 1); tp_b = 0.f; }
#else
        tp_scale = 1.3f + tp_value(F.ctl, MK_TPROBE_A) * 0.001f; tp_b = 10.0f + tp_value(F.ctl, MK_TPROBE_B) * MK_TPROBE_BS;
#endif
#endif
#pragma unroll 2
        for (int t = gw; t < T; t += NGW) {
            f32x4 v[8];
#pragma unroll
            for (int j = 0; j < 8; ++j) { const u32x2 dw = ((const GAS u32x2*)(DLb + (size_t)t * D))[F.lane + 64 * j]; v[j] = (f32x4){bflo(dw.x), bfhi(dw.x), bflo(dw.y), bfhi(dw.y)}; }
#pragma unroll
            for (int k = 0; k < 4; ++k) { const int s = a_slot[t * 4 + k]; const float gt = a_gate[t * 4 + k] * (1.0f / S_Y); const GAS unsigned* yr = (const GAS unsigned*)(Yb + (size_t)s * D) + F.lane;
#pragma unroll
                for (int j = 0; j < 8; ++j) { const unsigned w = yr[64 * j]; const f32x2 lo = __builtin_amdgcn_cvt_pk_f32_fp8((int)w, false), hi = __builtin_amdgcn_cvt_pk_f32_fp8((int)w, true);
                    v[j][0] += gt * lo[0]; v[j][1] += gt * lo[1]; v[j][2] += gt * hi[0]; v[j][3] += gt * hi[1]; } }
            float ss = 0.f;
#pragma unroll
            for (int j = 0; j < 8; ++j) ss += (v[j][0] * v[j][0] + v[j][1] * v[j][1]) + (v[j][2] * v[j][2] + v[j][3] * v[j][3]);
            const float rs = rsqrtf(wave_sum(ss) * (1.0f / D) + EPS);
            GAS f32x4* o = (GAS f32x4*)(args.out + (size_t)t * D);
#pragma unroll
            for (int j = 0; j < 8; ++j) { const f32x4 gg = ((const GAS f32x4*)nfg)[F.lane + 64 * j]; o[F.lane + 64 * j] = v[j] * rs * gg * tp_scale; }
        }
#ifdef MK_TPROBE_A
        VM_WAIT(); __syncthreads();
        if (bx == 0 && F.tid == 0 && tp_b != 0.f) args.out[0] = tp_b;
#endif
    }
#undef IN
#undef SEAM
}
constexpr int N_PHASES = 12;
}

#ifndef MK_CUTS
#define MK_CUTS 0
#endif
extern "C" void kernel_launch(void* const* d_in, const int* in_sizes, int n_in, void* d_out, int out_size, void* d_ws, size_t ws_size, hipStream_t stream) {
    using namespace mk;
    static int grid = 0;
    if (grid == 0) {
        int dev = 0, cus = 0;
        if (hipGetDevice(&dev) != hipSuccess || hipDeviceGetAttribute(&cus, hipDeviceAttributeMultiprocessorCount, dev) != hipSuccess) { grid = -1; return; }
        if (hipFuncSetAttribute((const void*)mk_fwd, hipFuncAttributeMaxDynamicSharedMemorySize, LDS_BYTES) != hipSuccess) { grid = -1; return; }
        int per_cu = 0;
        if (hipOccupancyMaxActiveBlocksPerMultiprocessor(&per_cu, (const void*)mk_fwd, NWAVES * 64, LDS_BYTES) != hipSuccess || per_cu < 1) { fprintf(stderr, "kernel_launch: occupancy query says %d\n", per_cu); }
        (void)hipGetLastError();
        grid = cus;
    }
    if (grid < 0) return;
    (void)hipMemsetAsync((char*)d_ws + WS_CTL, 0, CTL_ZERO_BYTES, stream);
    Args a{};
    for (int i = 0; i < 20; ++i) a.in[i] = (const float*)d_in[i];
    a.out = (float*)d_out; a.ws = (unsigned char*)d_ws;
#if MK_CUTS == 0
    a.ph_lo = 0; a.ph_hi = N_PHASES; a.li = 0; a.pad = 0;
    hipLaunchKernelGGL(mk_fwd, dim3(grid), dim3(NWAVES * 64), LDS_BYTES, stream, a);
#else
    for (int p = 0; p < N_PHASES; ++p) { a.ph_lo = p; a.ph_hi = p + 1; a.li = 0; a.pad = 0; hipLaunchKernelGGL(mk_fwd, dim3(grid), dim3(NWAVES * 64), LDS_BYTES, stream, a); }
#endif
}
```

```cpp
#include <hip/hip_runtime.h>
#include <cstdio>
#include <cstdint>
#define MK_NCV7 10
#define MK_CVSPLIT 0, 75776, 83456, 84992, 97280
namespace pg8 {
#define PG8_LAS __attribute__((address_space(3)))
typedef unsigned short bf16_t;
typedef short bf16x8 __attribute__((ext_vector_type(8)));
typedef float f32x4 __attribute__((ext_vector_type(4)));
typedef unsigned u32x4 __attribute__((ext_vector_type(4)));
typedef int pg8_v4i __attribute__((ext_vector_type(4)));
constexpr int BM = 256, BK = 64, HALF = 128, HTB = HALF * BK * 2  , STAGE_BYTES = 8 * HTB, NXCD = 8, WGM = 8;

__host__ __device__ __forceinline__ int lds_byte(int r, int c) { const int st = (r >> 4) * 2 + (c >> 5), rr = r & 15, cc = c & 31, ob = rr * 64 + cc * 2; return st * 1024 + (ob ^ (((ob >> 9) & 1) << 5)); }
__host__ __device__ __forceinline__ void stage_rc(int b, int& R, int& C) { const int st = b / 1024, sb = b % 1024, swz = sb ^ (((sb >> 9) & 1) << 5); R = (st >> 1) * 16 + swz / 64; C = (st & 1) * 32 + (swz % 64) / 2; }
__host__ __device__ __forceinline__ int perm32(int rho) { const int n = rho >> 4, i = rho & 15; return 8 * (i >> 2) + 4 * n + (i & 3); }

struct Unit { int pm, pn, half; };
struct Gemm { const bf16_t* A; const bf16_t* Bt; int M, N, K; };

struct StaticOrder {
    int nM, nN, nwg, G, c;
    __host__ __device__ void init(int M, int N, int G_, int c_) { nM = M / BM; nN = N / BM; nwg = nM * nN; G = G_; c = c_; }
    __host__ __device__ bool next(int i, Unit& u) const {
        const long L = (long)i * G + c; if (L >= nwg) return false;
        int wgid = (int)L; { const int q = nwg / NXCD, r = nwg % NXCD, xcd = wgid % NXCD, off = wgid / NXCD; wgid = (xcd < r ? xcd * (q + 1) : r * (q + 1) + (xcd - r) * q) + off; }
        const int nig = WGM * nN, gid = wgid / nig, fm = gid * WGM, gsz = (nM - fm) < WGM ? (nM - fm) : WGM;
        u.pm = fm + ((wgid % nig) % gsz); u.pn = (wgid % nig) / gsz; u.half = 0; return true;
    }
    __device__ __forceinline__ void a_ready(const Unit&) const {}
    __device__ __forceinline__ void done(const Unit&) const {}
};

__device__ __forceinline__ unsigned cvt_pk_bf16(float lo, float hi) { unsigned r; asm volatile("v_cvt_pk_bf16_f32 %0, %1, %2" : "=v"(r) : "v"(lo), "v"(hi)); return r; }
template <class Epi, class Sched, bool ALIGN_EPI = false, bool SP2 = false, int F8W = 0, int F8X = 0, int HOOK_T = 0, int BAUX = 0, bool DEFER = false>
__device__ __forceinline__ void gemm_phase(PG8_LAS unsigned char* lds, const Gemm g, const Sched& S, const Epi& E) {
    const int tid = threadIdx.x, wid = __builtin_amdgcn_readfirstlane(tid >> 6), lane = tid & 63, wr = wid >> 2, wc = wid & 3, fr = lane & 15, fq = lane >> 4;
    const int K = g.K, nt = K / BK;
    int f8w_ = F8W, f8x_ = F8X; asm volatile("" : "+v"(f8w_), "+v"(f8x_));
    unsigned voffA[2], voffB[2];
#pragma unroll
    for (int i = 0; i < 2; ++i) { int R, C; stage_rc(tid * 16 + i * 8192, R, C); const int Rb = Epi::PERM ? ((R & ~31) + perm32(R & 31)) : R;
        voffA[i] = (unsigned)(R * K + C) * 2u; voffB[i] = (unsigned)(Rb * K + C) * 2u; }
    const size_t kstep = (size_t)(BK * 2);
    const size_t hstep = (size_t)HALF * K * 2;
    const size_t tstep = 2 * hstep;
    const unsigned ldsw = (unsigned)wid * 1024u;
    const int aoff = lds_byte(wr * 64 + fr, fq * 8), boff = lds_byte(wc * 32 + fr, fq * 8);
#define PG8_SA(b, h) (((b) * 2 + (h)) * HTB)
#define PG8_SB(b, h) ((4 + (b) * 2 + (h)) * HTB)
#define PG8_STAGE(bufoff, gbase, voff) do { _Pragma("unroll") for (int _i = 0; _i < 2; ++_i) \
        __builtin_amdgcn_global_load_lds((const unsigned*)((const char*)(gbase) + (voff)[_i]), (PG8_LAS unsigned*)(lds + (bufoff) + ldsw + _i * 8192), 16, 0, 0); } while (0)
#define PG8_STAGEB(bufoff, gbase, voff) do { _Pragma("unroll") for (int _i = 0; _i < 2; ++_i) \
        __builtin_amdgcn_global_load_lds((const unsigned*)((const char*)(gbase) + (voff)[_i]), (PG8_LAS unsigned*)(lds + (bufoff) + ldsw + _i * 8192), 16, 0, BAUX); } while (0)
#define PG8_LDA(dst, b, h) do { _Pragma("unroll") for (int m = 0; m < 4; ++m) _Pragma("unroll") for (int k = 0; k < 2; ++k) dst[m][k] = *(const PG8_LAS bf16x8*)(lds + PG8_SA(b, h) + aoff + m * 2048 + k * 1024); } while (0)
#define PG8_LDB(dst, b, h) do { _Pragma("unroll") for (int n = 0; n < 2; ++n) _Pragma("unroll") for (int k = 0; k < 2; ++k) dst[n][k] = *(const PG8_LAS bf16x8*)(lds + PG8_SB(b, h) + boff + n * 2048 + k * 1024); } while (0)
#define PG8_CAT8(lo, hi) __builtin_shufflevector(__builtin_bit_cast(pg8_v4i, lo), __builtin_bit_cast(pg8_v4i, hi), 0, 1, 2, 3, 4, 5, 6, 7)
#define PG8_MMA(ai, bj, At, Bt) do { __builtin_amdgcn_s_setprio(1); if constexpr (F8W != 0) { _Pragma("unroll") for (int m = 0; m < 4; ++m) _Pragma("unroll") for (int n = 0; n < 2; ++n) \
        asm volatile("v_mfma_scale_f32_16x16x128_f8f6f4 %0, %1, %2, %0, %3, %4 op_sel_hi:[0,0,0]" : "+v"(acc[ai][bj][m][n]) : "v"(PG8_CAT8(Bt[n][0], Bt[n][1])), "v"(PG8_CAT8(At[m][0], At[m][1])), "v"(f8w_), "v"(f8x_)); } else { \
        _Pragma("unroll") for (int m = 0; m < 4; ++m) _Pragma("unroll") for (int n = 0; n < 2; ++n) _Pragma("unroll") for (int k = 0; k < 2; ++k) \
        acc[ai][bj][m][n] = __builtin_amdgcn_mfma_f32_16x16x32_bf16(Bt[n][k], At[m][k], acc[ai][bj][m][n], 0, 0, 0); } __builtin_amdgcn_s_setprio(0); } while (0)
#define PG8_WAIT_V(n) asm volatile("s_waitcnt vmcnt(" #n ")" ::: "memory")
#define PG8_WAIT_L(n) asm volatile("s_waitcnt lgkmcnt(" #n ")" ::: "memory")
#define PG8_BAR __builtin_amdgcn_s_barrier()
#define PG8_SCHED __builtin_amdgcn_sched_barrier(0)
    Unit cur, nxt; int ui = 0;
    typename Epi::Pend pend; Unit pu = {0, 0, 0}; bool has_pend = false;
    typename Epi::Pre pre;
    if (!S.next(0, cur)) return;
    f32x4 acc[2][2][4][2];
#pragma unroll
    for (int a = 0; a < 2; ++a)
#pragma unroll
        for (int b = 0; b < 2; ++b)
#pragma unroll
            for (int m = 0; m < 4; ++m)
#pragma unroll
                for (int n = 0; n < 2; ++n) acc[a][b][m][n] = (f32x4){0.f, 0.f, 0.f, 0.f};
    bf16x8 At[4][2], B0[2][2], B1[2][2];
    const char* cA = (const char*)g.A + (size_t)cur.pm * tstep; const char* cB = (const char*)g.Bt + (size_t)cur.pn * tstep;
    S.a_ready(cur);
    if constexpr (SP2) {
        PG8_STAGEB(PG8_SB(0, 0), cB, voffB); PG8_STAGEB(PG8_SB(0, 1), cB + hstep, voffB); PG8_STAGE(PG8_SA(0, 0), cA, voffA); PG8_STAGE(PG8_SA(0, 1), cA + hstep, voffA);
        if (wr == 1) PG8_BAR;
        PG8_WAIT_V(2); PG8_BAR;
        PG8_STAGEB(PG8_SB(1, 0), cB + kstep, voffB); PG8_STAGE(PG8_SA(1, 0), cA + kstep, voffA); PG8_STAGEB(PG8_SB(1, 1), cB + hstep + kstep, voffB);
        PG8_WAIT_V(6); PG8_BAR;
    } else {
        PG8_STAGEB(PG8_SB(0, 0), cB, voffB); PG8_STAGE(PG8_SA(0, 0), cA, voffA); PG8_STAGEB(PG8_SB(0, 1), cB + hstep, voffB); PG8_STAGE(PG8_SA(0, 1), cA + hstep, voffA);
        if (wr == 1) PG8_BAR;
        PG8_WAIT_V(4); PG8_BAR;
        PG8_STAGEB(PG8_SB(1, 0), cB + kstep, voffB); PG8_STAGE(PG8_SA(1, 0), cA + kstep, voffA); PG8_STAGEB(PG8_SB(1, 1), cB + hstep + kstep, voffB);
        PG8_WAIT_V(6); PG8_BAR;
    }
    for (;;) {
        const bool has_next = S.next(ui + 1, nxt);
        const char* nA = has_next ? (const char*)g.A + (size_t)nxt.pm * tstep : cA; const char* nB = has_next ? (const char*)g.Bt + (size_t)nxt.pn * tstep : cB;
        for (int t = 0; t < nt; t += 2) {
            if constexpr (DEFER) { if (has_pend) E.store_step(pend, pu, t >> 1, wr, wc, fr, fq); }
            if constexpr (HOOK_T > 0) { if (t == HOOK_T) E.mid(acc, cur, wr, wc, fr, fq); }
            const bool last = (t == nt - 2);
            const char* a1 = cA + (size_t)(t + 1) * kstep;
            const char* a2 = last ? nA : cA + (size_t)(t + 2) * kstep; const char* b2 = last ? nB : cB + (size_t)(t + 2) * kstep;
            const char* a3 = a2 + kstep; const char* b3 = b2 + kstep;
            if (last && has_next) S.a_ready(nxt);
            if constexpr (!DEFER) { if (last) E.preload(pre, cur, wr, wc, fr, fq); }
            if constexpr (SP2) {
            PG8_LDB(B0, 0, 0); PG8_LDB(B1, 0, 1); PG8_SCHED; PG8_LDA(At, 0, 0); PG8_STAGE(PG8_SA(1, 1), a1 + hstep, voffA);
            PG8_WAIT_V(8); PG8_WAIT_L(0); PG8_BAR; PG8_MMA(0, 0, At, B0); PG8_MMA(0, 1, At, B1); PG8_BAR; PG8_SCHED;
            if (!cur.half) PG8_LDA(At, 0, 1); PG8_STAGEB(PG8_SB(0, 0), b2, voffB); PG8_STAGEB(PG8_SB(0, 1), b2 + hstep, voffB); PG8_STAGE(PG8_SA(0, 0), a2, voffA);
            PG8_WAIT_V(8); PG8_WAIT_L(0); PG8_BAR; if (!cur.half) { PG8_MMA(1, 0, At, B0); PG8_MMA(1, 1, At, B1); } PG8_BAR; PG8_SCHED;
            PG8_LDB(B0, 1, 0); PG8_LDB(B1, 1, 1); PG8_SCHED; PG8_LDA(At, 1, 0); PG8_STAGE(PG8_SA(0, 1), a2 + hstep, voffA);
            PG8_WAIT_V(8); PG8_WAIT_L(0); PG8_BAR; PG8_MMA(0, 0, At, B0); PG8_MMA(0, 1, At, B1); PG8_BAR; PG8_SCHED;
            if (!cur.half) PG8_LDA(At, 1, 1); PG8_STAGEB(PG8_SB(1, 0), b3, voffB); PG8_STAGEB(PG8_SB(1, 1), b3 + hstep, voffB); PG8_STAGE(PG8_SA(1, 0), a3, voffA);
            PG8_WAIT_V(8); PG8_WAIT_L(0); PG8_BAR; if (!cur.half) { PG8_MMA(1, 0, At, B0); PG8_MMA(1, 1, At, B1); } PG8_BAR; PG8_SCHED;
            } else {
            PG8_LDB(B0, 0, 0); PG8_SCHED; PG8_LDA(At, 0, 0); PG8_STAGE(PG8_SA(1, 1), a1 + hstep, voffA);
            PG8_WAIT_L(8); PG8_BAR; PG8_WAIT_L(0); PG8_MMA(0, 0, At, B0); PG8_BAR; PG8_SCHED;
            PG8_LDB(B1, 0, 1); PG8_STAGEB(PG8_SB(0, 0), b2, voffB);
            PG8_BAR; PG8_WAIT_L(0); PG8_MMA(0, 1, At, B1); PG8_BAR;
            PG8_LDA(At, 0, 1); PG8_STAGE(PG8_SA(0, 0), a2, voffA);
            PG8_BAR; PG8_WAIT_L(0); PG8_MMA(1, 0, At, B0); PG8_BAR; PG8_SCHED;
            PG8_STAGEB(PG8_SB(0, 1), b2 + hstep, voffB);
            PG8_WAIT_V(6); PG8_BAR; PG8_MMA(1, 1, At, B1); PG8_BAR;
            PG8_LDB(B0, 1, 0); PG8_SCHED; PG8_LDA(At, 1, 0); PG8_STAGE(PG8_SA(0, 1), a2 + hstep, voffA);
            PG8_WAIT_L(8); PG8_BAR; PG8_WAIT_L(0); PG8_MMA(0, 0, At, B0); PG8_BAR; PG8_SCHED;
            PG8_LDB(B1, 1, 1); PG8_STAGEB(PG8_SB(1, 0), b3, voffB);
            PG8_BAR; PG8_WAIT_L(0); PG8_MMA(0, 1, At, B1); PG8_BAR;
            PG8_LDA(At, 1, 1); PG8_STAGE(PG8_SA(1, 0), a3, voffA);
            PG8_BAR; PG8_WAIT_L(0); PG8_MMA(1, 0, At, B0); PG8_BAR; PG8_SCHED;
            PG8_STAGEB(PG8_SB(1, 1), b3 + hstep, voffB);
            PG8_WAIT_V(6); PG8_BAR; PG8_MMA(1, 1, At, B1); PG8_BAR;
            }
        }
        if constexpr (F8W != 0) asm volatile("s_nop 15\n\ts_nop 15" ::: "memory");
        if constexpr (ALIGN_EPI) { if (wr == 0) PG8_BAR; }
        if constexpr (DEFER) { E.preload(pre, cur, wr, wc, fr, fq); E.compute(acc, cur, wr, wc, fr, fq, pre, pend); pu = cur; has_pend = true; }
        else if constexpr (!Epi::AFTER_DRAIN) { E(acc, cur, wr, wc, fr, fq, pre); S.done(cur); }
        if (!has_next) break;
#pragma unroll
        for (int a = 0; a < 2; ++a)
#pragma unroll
            for (int b = 0; b < 2; ++b)
#pragma unroll
                for (int m = 0; m < 4; ++m)
#pragma unroll
                    for (int n = 0; n < 2; ++n) acc[a][b][m][n] = (f32x4){0.f, 0.f, 0.f, 0.f};
        cur = nxt; cA = nA; cB = nB; ++ui;
        if constexpr (ALIGN_EPI) { if (wr == 1) PG8_BAR; }
    }
    if constexpr (DEFER) { if (has_pend) { _Pragma("unroll") for (int s_ = 0; s_ < Epi::NPEND; ++s_) E.store_step(pend, pu, s_, wr, wc, fr, fq); } }
    PG8_WAIT_V(0);
    if constexpr (!ALIGN_EPI) { if (wr == 0) PG8_BAR; }
    PG8_BAR;
    if constexpr (Epi::AFTER_DRAIN) { E.fused(acc, cur, wr, wc, fr, fq, lds, wid, lane); S.done(cur); }
#undef PG8_SA
#undef PG8_SB
#undef PG8_STAGE
#undef PG8_STAGEB
#undef PG8_LDA
#undef PG8_LDB
#undef PG8_MMA
#undef PG8_CAT8
#undef PG8_WAIT_V
#undef PG8_WAIT_L
#undef PG8_BAR
#undef PG8_SCHED
}
}
#define GAS __attribute__((address_space(1)))
#define LAS __attribute__((address_space(3)))
namespace mk {
using pg8::bf16_t; using pg8::bf16x8; using pg8::f32x4; using pg8::u32x4; using pg8::Unit; using pg8::cvt_pk_bf16;
typedef float f32x16 __attribute__((ext_vector_type(16)));
typedef float f32x2 __attribute__((ext_vector_type(2)));
typedef unsigned u32x2 __attribute__((ext_vector_type(2)));
typedef GAS unsigned gu32;
typedef __bf16 bf16x2_t __attribute__((ext_vector_type(2)));
__device__ __forceinline__ unsigned cvt_pk(float lo, float hi) { f32x2 v = {lo, hi}; bf16x2_t b = __builtin_convertvector(v, bf16x2_t); return __builtin_bit_cast(unsigned, b); }
#define RLX_AGENT __ATOMIC_RELAXED, __HIP_MEMORY_SCOPE_AGENT
#define LDS_WAIT() asm volatile("s_waitcnt lgkmcnt(0)" ::: "memory")
#define VM_WAIT() asm volatile("s_waitcnt vmcnt(0)" ::: "memory")

constexpr int T = 8192, D = 2048, DIN = 10752, DC = 1024, NH = 12, HD = 128, AW = 1536, AO = 512, NE = 32, DE = 2048, TOPK = 4;
constexpr float EPS = 1e-5f;
constexpr float QSCALE = 0.12751743082459868f;
constexpr float LN2 = 0.6931471805599453f;
constexpr int MAXRT = 160, NROWS = MAXRT * 256;
constexpr int NWAVES = 8;

constexpr size_t MiB = 1u << 20;
constexpr size_t WS_CTL = 0, CTL_ZERO_BYTES = 64 * 1024;
constexpr size_t WS_WIN = 1 * MiB;
constexpr size_t WS_WCO = 43 * MiB;
constexpr size_t WS_WAO = 47 * MiB;
constexpr size_t WS_WOUT = 49 * MiB;
constexpr size_t WS_WE1 = 57 * MiB;
constexpr size_t WS_WE2 = 569 * MiB;
constexpr size_t WS_H = 825 * MiB;
constexpr size_t WS_U = 857 * MiB;
constexpr size_t WS_Q = 873 * MiB, WS_K = 897 * MiB, WS_V = 921 * MiB;
constexpr size_t WS_GATE = 945 * MiB;
constexpr size_t WS_UC = 1009 * MiB;
constexpr size_t WS_OG = 1025 * MiB;
constexpr size_t WS_LSE = 1073 * MiB;
constexpr size_t WS_OC = 1074 * MiB;
constexpr size_t WS_M1 = 1082 * MiB;
constexpr int KCAT = DC + AO;
constexpr size_t WS_MG = 1146 * MiB;
constexpr size_t WS_X1 = 1178 * MiB;
constexpr size_t WS_H2 = 1242 * MiB;
constexpr size_t WS_AE = 1274 * MiB, WS_APOS = 1275 * MiB, WS_AGATE = 1276 * MiB, WS_ASLOT = 1277 * MiB;
constexpr size_t WS_HIST = WS_ASLOT + 512 * 1024;
constexpr size_t WS_XG = 1278 * MiB;
constexpr size_t WS_ACT = 1438 * MiB;
constexpr size_t WS_Y = 1598 * MiB;
constexpr size_t WS_END = 1758 * MiB;
constexpr int CW_CNT = 64;
constexpr int CW_TS = 256;
constexpr int CW_BAR = 4096;

constexpr int RING_BYTES = 131072;
constexpr int LDSCTL_OFF = RING_BYTES, MISC_OFF = LDSCTL_OFF + 320, TAB_OFF = LDSCTL_OFF + 1024;
constexpr int LDS_BYTES = 147456;

__device__ __forceinline__ unsigned f2bf(float f) { unsigned u = __builtin_bit_cast(unsigned, f); return (u + 0x7fffu + ((u >> 16) & 1u)) >> 16; }
__device__ __forceinline__ unsigned pk2(float lo, float hi) { return f2bf(lo) | (f2bf(hi) << 16); }
__device__ __forceinline__ float bflo(unsigned w) { return __builtin_bit_cast(float, w << 16); }
__device__ __forceinline__ float bfhi(unsigned w) { return __builtin_bit_cast(float, w & 0xffff0000u); }
__device__ __forceinline__ unsigned pk4_fp8r(float a, float b, float c, float d) { int w = __builtin_amdgcn_cvt_pk_fp8_f32(a, b, __builtin_bit_cast(int, a), false); w = __builtin_amdgcn_cvt_pk_fp8_f32(c, d, w, true); return (unsigned)w; }
__device__ __forceinline__ unsigned pk4_fp8(float a, float b, float c, float d) { int w = __builtin_amdgcn_cvt_pk_fp8_f32(a, b, 0, false); w = __builtin_amdgcn_cvt_pk_fp8_f32(c, d, w, true); return (unsigned)w; }
constexpr float S_Y = 16.0f;
constexpr float S_W = 128.0f, S_X = 16.0f, S_ACT = 4.0f;
constexpr int E8_W = 127 - 7, E8_X = 127 - 4, E8_ACT = 127 - 2;
__device__ __forceinline__ float sigm(float x) { return __builtin_amdgcn_rcpf(1.0f + __expf(-x)); }
typedef float f32x2 __attribute__((ext_vector_type(2)));
__device__ __forceinline__ f32x2 sigm2(f32x2 x) { const f32x2 s = x * (-1.44269504f); f32x2 e; e.x = __builtin_amdgcn_exp2f(s.x); e.y = __builtin_amdgcn_exp2f(s.y);
    const f32x2 d = e + 1.0f; f32x2 r; r.x = __builtin_amdgcn_rcpf(d.x); r.y = __builtin_amdgcn_rcpf(d.y); return r; }
__device__ __forceinline__ unsigned gate_u8x4(float a, float b, float c, float d) { const unsigned qa = (unsigned)fmaxf(a, 1.0f), qb = (unsigned)fmaxf(b, 1.0f), qc = (unsigned)fmaxf(c, 1.0f), qd = (unsigned)fmaxf(d, 1.0f); return qa | (qb << 8) | (qc << 16) | (qd << 24); }
__device__ __forceinline__ float ub0(unsigned w) { return (float)(w & 255u); }
__device__ __forceinline__ float ub1(unsigned w) { return (float)((w >> 8) & 255u); }
__device__ __forceinline__ float ub2(unsigned w) { return (float)((w >> 16) & 255u); }
__device__ __forceinline__ float ub3(unsigned w) { return (float)(w >> 24); }
__device__ __forceinline__ f32x2 swiglu2(f32x2 g, f32x2 u, float sc) { f32x2 gg, uu; gg.x = fminf(g.x, 7.0f); gg.y = fminf(g.y, 7.0f); uu.x = __builtin_amdgcn_fmed3f(u.x, -7.0f, 7.0f); uu.y = __builtin_amdgcn_fmed3f(u.y, -7.0f, 7.0f);
    const f32x2 s = gg * (-1.702f * 1.44269504f); f32x2 e; e.x = __builtin_amdgcn_exp2f(s.x); e.y = __builtin_amdgcn_exp2f(s.y);
    const f32x2 d = e + 1.0f; f32x2 r; r.x = __builtin_amdgcn_rcpf(d.x); r.y = __builtin_amdgcn_rcpf(d.y); return (uu * sc + sc) * (gg * r); }
__device__ __forceinline__ float wave_sum(float v) {
#pragma unroll
    for (int o = 1; o < 64; o <<= 1) v += __shfl_xor(v, o);
    return v;
}
__device__ __forceinline__ float wave_max(float v) {
#pragma unroll
    for (int o = 1; o < 64; o <<= 1) v = fmaxf(v, __shfl_xor(v, o));
    return v;
}

struct EpiProj {
    static constexpr bool PERM = true, AFTER_DRAIN = false;
    bf16_t *U, *Q; unsigned char* G; const float* bgate;
    struct Pend {}; static constexpr int NPEND = 0;
    struct Pre { f32x4 bv[2][2]; };
    __device__ __forceinline__ void preload(Pre& p, const Unit& u, int wr, int wc, int fr, int fq) const { if (u.pn >= 26) { const int c0 = (u.pn - 26) * 256 + wc * 32 + 8 * fq;
#pragma unroll
        for (int bj = 0; bj < 2; ++bj)
#pragma unroll
            for (int n = 0; n < 2; ++n) p.bv[bj][n] = *(const f32x4*)(bgate + c0 + bj * 128 + 4 * n); } }
    __device__ __forceinline__ void operator()(const f32x4 (&acc)[2][2][4][2], const Unit& u, int wr, int wc, int fr, int fq, const Pre& pre) const {
        const int row0 = u.pm * 256 + wr * 64 + fr, cl = wc * 32 + 8 * fq;
        if (u.pn < 8) {
#pragma unroll
            for (int ai = 0; ai < 2; ++ai)
#pragma unroll
                for (int m = 0; m < 4; ++m) {
                    const f32x4 a0 = acc[ai][0][m][0], a1 = acc[ai][0][m][1], g0 = acc[ai][1][m][0], g1 = acc[ai][1][m][1];
                    const f32x2 p0 = (f32x2){a0[0], a0[1]} * sigm2((f32x2){g0[0], g0[1]}), p1 = (f32x2){a0[2], a0[3]} * sigm2((f32x2){g0[2], g0[3]});
                    const f32x2 p2 = (f32x2){a1[0], a1[1]} * sigm2((f32x2){g1[0], g1[1]}), p3 = (f32x2){a1[2], a1[3]} * sigm2((f32x2){g1[2], g1[3]});
                    u32x4 w; w.x = cvt_pk(p0.x, p0.y); w.y = cvt_pk(p1.x, p1.y); w.z = cvt_pk(p2.x, p2.y); w.w = cvt_pk(p3.x, p3.y);
                    *(u32x4*)(U + (size_t)(row0 + ai * 128 + m * 16) * DC + u.pn * 128 + cl) = w; }
        } else if (u.pn < 26) {
            const int s = (u.pn - 8) / 6, pl = (u.pn - 8) % 6; bf16_t* base = Q + (size_t)s * ((WS_K - WS_Q) / 2); const float sc = (s == 0) ? QSCALE : 1.0f;
#pragma unroll
            for (int ai = 0; ai < 2; ++ai)
#pragma unroll
                for (int m = 0; m < 4; ++m) { bf16_t* rowp = base + (size_t)(row0 + ai * 128 + m * 16) * AW + pl * 256 + cl;
#pragma unroll
                    for (int bj = 0; bj < 2; ++bj) { const f32x4 v0 = acc[ai][bj][m][0] * sc, v1 = acc[ai][bj][m][1] * sc;
                        u32x4 w; w.x = cvt_pk(v0[0], v0[1]); w.y = cvt_pk(v0[2], v0[3]); w.z = cvt_pk(v1[0], v1[1]); w.w = cvt_pk(v1[2], v1[3]);
                        *(u32x4*)(rowp + bj * 128) = w; } }
        } else {
            const int c0 = (u.pn - 26) * 256 + cl;
            const f32x4 (&bv)[2][2] = pre.bv;
#pragma unroll
            for (int ai = 0; ai < 2; ++ai)
#pragma unroll
                for (int m = 0; m < 4; ++m) { unsigned char* rowp = G + (size_t)(row0 + ai * 128 + m * 16) * (2 * D) + c0;
#pragma unroll
                    for (int bj = 0; bj < 2; ++bj) { const f32x4 v0 = acc[ai][bj][m][0] + bv[bj][0], v1 = acc[ai][bj][m][1] + bv[bj][1];
                        const f32x2 s0 = sigm2((f32x2){v0[0], v0[1]}) * 255.0f + 0.5f, s1 = sigm2((f32x2){v0[2], v0[3]}) * 255.0f + 0.5f, s2 = sigm2((f32x2){v1[0], v1[1]}) * 255.0f + 0.5f, s3 = sigm2((f32x2){v1[2], v1[3]}) * 255.0f + 0.5f;
                        u32x2 w; w.x = gate_u8x4(s0.x, s0.y, s1.x, s1.y); w.y = gate_u8x4(s2.x, s2.y, s3.x, s3.y);
                        *(u32x2*)(rowp + bj * 128) = w; } }
        }
    }
};
struct EpiConvOut {
    static constexpr bool PERM = false, AFTER_DRAIN = false;
    float* M1; const bf16_t* G; const float* bco;
    struct Pre {}; __device__ __forceinline__ void preload(Pre&, const Unit&, int, int, int, int) const {}
    struct Pend {}; static constexpr int NPEND = 0;
    __device__ __forceinline__ void operator()(const f32x4 (&acc)[2][2][4][2], const Unit& u, int wr, int wc, int fr, int fq, const Pre& pre) const {
        const int row0 = u.pm * 256 + wr * 64 + fr, col0 = u.pn * 256 + wc * 32 + 4 * fq;
        f32x4 bv[2][2];
#pragma unroll
        for (int bj = 0; bj < 2; ++bj)
#pragma unroll
            for (int n = 0; n < 2; ++n) bv[bj][n] = *(const f32x4*)(bco + col0 + bj * 128 + n * 16);
#pragma unroll
        for (int ai = 0; ai < 2; ++ai)
#pragma unroll
            for (int m = 0; m < 4; ++m) { const size_t row = (size_t)(row0 + ai * 128 + m * 16);
#pragma unroll
                for (int bj = 0; bj < 2; ++bj)
#pragma unroll
                    for (int n = 0; n < 2; ++n) { const int col = col0 + bj * 128 + n * 16;
                        const u32x2 gw = *(const u32x2*)(G + row * (2 * D) + col); const f32x4 v = acc[ai][bj][m][n] + bv[bj][n];
                        f32x4 o; o[0] = bflo(gw.x) * v[0]; o[1] = bfhi(gw.x) * v[1]; o[2] = bflo(gw.y) * v[2]; o[3] = bfhi(gw.y) * v[3];
                        *(f32x4*)(M1 + row * D + col) = o; } }
    }
};
struct EpiAttnOut {
    static constexpr bool PERM = false, AFTER_DRAIN = false;
    const float* M1; const bf16_t* G; bf16_t* MG;
    struct Pre {}; __device__ __forceinline__ void preload(Pre&, const Unit&, int, int, int, int) const {}
    struct Pend {}; static constexpr int NPEND = 0;
    __device__ __forceinline__ void operator()(const f32x4 (&acc)[2][2][4][2], const Unit& u, int wr, int wc, int fr, int fq, const Pre& pre) const {
        const int row0 = u.pm * 256 + wr * 64 + fr, col0 = u.pn * 256 + wc * 32 + 4 * fq;
#pragma unroll
        for (int ai = 0; ai < 2; ++ai)
#pragma unroll
            for (int m = 0; m < 4; ++m) { const size_t row = (size_t)(row0 + ai * 128 + m * 16);
#pragma unroll
                for (int bj = 0; bj < 2; ++bj)
#pragma unroll
                    for (int n = 0; n < 2; ++n) { const int col = col0 + bj * 128 + n * 16;
                        const u32x2 gw = *(const u32x2*)(G + row * (2 * D) + D + col); const f32x4 v = acc[ai][bj][m][n]; const f32x4 m1 = *(const f32x4*)(M1 + row * D + col);
                        u32x2 w; w.x = cvt_pk(m1[0] + bflo(gw.x) * v[0], m1[1] + bfhi(gw.x) * v[1]); w.y = cvt_pk(m1[2] + bflo(gw.y) * v[2], m1[3] + bfhi(gw.y) * v[3]);
                        *(u32x2*)(MG + row * D + col) = w; } }
    }
};
struct EpiMerge {
    static constexpr bool PERM = true, AFTER_DRAIN = false;
    const unsigned char* G; const float* bco; bf16_t* MG;
    struct Pre {}; __device__ __forceinline__ void preload(Pre&, const Unit&, int, int, int, int) const {}
    struct Pend {}; static constexpr int NPEND = 0;
    __device__ __forceinline__ void mid(f32x4 (&acc)[2][2][4][2], const Unit& u, int wr, int wc, int fr, int fq) const {
        int zo = 0; asm volatile("" : "+v"(zo));
        const int row0 = u.pm * 256 + wr * 64 + fr + zo, c0 = u.pn * 256 + wc * 32 + 8 * fq + zo;
        f32x4 bv[2][2];
#pragma unroll
        for (int bj = 0; bj < 2; ++bj) { bv[bj][0] = *(const f32x4*)(bco + c0 + bj * 128); bv[bj][1] = *(const f32x4*)(bco + c0 + bj * 128 + 4); }
#pragma unroll
        for (int ai = 0; ai < 2; ++ai)
#pragma unroll
            for (int m = 0; m < 4; ++m) { const unsigned char* gp = G + (size_t)(row0 + ai * 128 + m * 16) * (2 * D) + c0;
#pragma unroll
                for (int bj = 0; bj < 2; ++bj) { const u32x2 gc = *(const u32x2*)(gp + bj * 128), ga = *(const u32x2*)(gp + bj * 128 + D);
                    f32x4 r0, r1;
                    r0[0] = ub0(gc.x) * __builtin_amdgcn_rcpf(ub0(ga.x)); r0[1] = ub1(gc.x) * __builtin_amdgcn_rcpf(ub1(ga.x)); r0[2] = ub2(gc.x) * __builtin_amdgcn_rcpf(ub2(ga.x)); r0[3] = ub3(gc.x) * __builtin_amdgcn_rcpf(ub3(ga.x));
                    r1[0] = ub0(gc.y) * __builtin_amdgcn_rcpf(ub0(ga.y)); r1[1] = ub1(gc.y) * __builtin_amdgcn_rcpf(ub1(ga.y)); r1[2] = ub2(gc.y) * __builtin_amdgcn_rcpf(ub2(ga.y)); r1[3] = ub3(gc.y) * __builtin_amdgcn_rcpf(ub3(ga.y));
                    acc[ai][bj][m][0] = (acc[ai][bj][m][0] + bv[bj][0]) * r0; acc[ai][bj][m][1] = (acc[ai][bj][m][1] + bv[bj][1]) * r1; }
                asm volatile("" : "+v"(acc[ai][0][m][0]), "+v"(acc[ai][0][m][1]), "+v"(acc[ai][1][m][0]), "+v"(acc[ai][1][m][1]));
                if (m == 3) asm volatile("" ::: "memory"); }
    }
    __device__ __forceinline__ void operator()(const f32x4 (&acc)[2][2][4][2], const Unit& u, int wr, int wc, int fr, int fq, const Pre& pre) const {
        const int row0 = u.pm * 256 + wr * 64 + fr, c0 = u.pn * 256 + wc * 32 + 8 * fq;
#pragma unroll
        for (int ai = 0; ai < 2; ++ai)
#pragma unroll
            for (int m = 0; m < 4; ++m) { const size_t row = (size_t)(row0 + ai * 128 + m * 16);
#pragma unroll
                for (int bj = 0; bj < 2; ++bj) { const u32x2 ga = *(const u32x2*)(G + row * (2 * D) + D + c0 + bj * 128); const f32x4 v0 = acc[ai][bj][m][0] * (1.0f / 255.0f), v1 = acc[ai][bj][m][1] * (1.0f / 255.0f);
                    u32x4 w; w.x = cvt_pk(v0[0] * ub0(ga.x), v0[1] * ub1(ga.x)); w.y = cvt_pk(v0[2] * ub2(ga.x), v0[3] * ub3(ga.x)); w.z = cvt_pk(v1[0] * ub0(ga.y), v1[1] * ub1(ga.y)); w.w = cvt_pk(v1[2] * ub2(ga.y), v1[3] * ub3(ga.y));
                    *(u32x4*)(MG + row * D + c0 + bj * 128) = w; } }
    }
};
struct EpiDelta {
    static constexpr bool PERM = true, AFTER_DRAIN = false;
    bf16_t* DL;
    struct Pre {}; __device__ __forceinline__ void preload(Pre&, const Unit&, int, int, int, int) const {}
    struct Pend {}; static constexpr int NPEND = 0;
    __device__ __forceinline__ void operator()(const f32x4 (&acc)[2][2][4][2], const Unit& u, int wr, int wc, int fr, int fq, const Pre& pre) const {
        const int row0 = u.pm * 256 + wr * 64 + fr, c0 = u.pn * 256 + wc * 32 + 8 * fq;
#pragma unroll
        for (int ai = 0; ai < 2; ++ai)
#pragma unroll
            for (int m = 0; m < 4; ++m) { bf16_t* rowp = DL + (size_t)(row0 + ai * 128 + m * 16) * D + c0;
#pragma unroll
                for (int bj = 0; bj < 2; ++bj) { const f32x4 v0 = acc[ai][bj][m][0], v1 = acc[ai][bj][m][1];
                    u32x4 w; w.x = cvt_pk(v0[0], v0[1]); w.y = cvt_pk(v0[2], v0[3]); w.z = cvt_pk(v1[0], v1[1]); w.w = cvt_pk(v1[2], v1[3]);
                    *(u32x4*)(rowp + bj * 128) = w; } }
    }
};
struct EpiResid {
    static constexpr bool PERM = false, AFTER_DRAIN = false;
    const float* X; float* X1;
    struct Pre {}; __device__ __forceinline__ void preload(Pre&, const Unit&, int, int, int, int) const {}
    struct Pend {}; static constexpr int NPEND = 0;
    __device__ __forceinline__ void operator()(const f32x4 (&acc)[2][2][4][2], const Unit& u, int wr, int wc, int fr, int fq, const Pre& pre) const {
        const int row0 = u.pm * 256 + wr * 64 + fr, col0 = u.pn * 256 + wc * 32 + 4 * fq;
#pragma unroll
        for (int ai = 0; ai < 2; ++ai)
#pragma unroll
            for (int m = 0; m < 4; ++m) { const size_t off = (size_t)(row0 + ai * 128 + m * 16) * D + col0;
#pragma unroll
                for (int bj = 0; bj < 2; ++bj)
#pragma unroll
                    for (int n = 0; n < 2; ++n) { const f32x4 xv = *(const f32x4*)(X + off + bj * 128 + n * 16); *(f32x4*)(X1 + off + bj * 128 + n * 16) = xv + acc[ai][bj][m][n]; } }
    }
};
struct EpiSwiGLU {
    static constexpr bool PERM = true, AFTER_DRAIN = false;
    unsigned char* ACT; const float* bin;
    struct Pend { u32x2 w[8]; }; static constexpr int NPEND = 8;
    struct Pre { f32x4 bg[2], bu[2]; };
    __device__ __forceinline__ void preload(Pre& p, const Unit& u, int wr, int wc, int fr, int fq) const { const int e = u.pn >> 4, cl = (u.pn & 15) * 128 + wc * 32 + 8 * fq;
#pragma unroll
        for (int n = 0; n < 2; ++n) { p.bg[n] = *(const f32x4*)(bin + (size_t)e * (2 * DE) + cl + 4 * n); p.bu[n] = *(const f32x4*)(bin + (size_t)e * (2 * DE) + DE + cl + 4 * n); } }
    __device__ __forceinline__ void operator()(const f32x4 (&acc)[2][2][4][2], const Unit& u, int wr, int wc, int fr, int fq, const Pre& pre) const {
        const int e = u.pn >> 4, pl = u.pn & 15;
        const int row0 = u.pm * 256 + wr * 64 + fr, cl = pl * 128 + wc * 32 + 8 * fq;
        const f32x4 (&bg)[2] = pre.bg; const f32x4 (&bu)[2] = pre.bu; (void)e;
#pragma unroll
        for (int ai = 0; ai < 2; ++ai)
#pragma unroll
            for (int m = 0; m < 4; ++m) {
                if (ai == 1 && u.half) continue;
                f32x2 o[4];
#pragma unroll
                for (int n = 0; n < 2; ++n) { const f32x4 gv = acc[ai][0][m][n] + bg[n], uv = acc[ai][1][m][n] + bu[n];
                    o[2 * n] = swiglu2((f32x2){gv[0], gv[1]}, (f32x2){uv[0], uv[1]}, S_ACT); o[2 * n + 1] = swiglu2((f32x2){gv[2], gv[3]}, (f32x2){uv[2], uv[3]}, S_ACT); }
                u32x2 w; w.x = pk4_fp8(o[0].x, o[0].y, o[1].x, o[1].y); w.y = pk4_fp8(o[2].x, o[2].y, o[3].x, o[3].y);
                *(u32x2*)(ACT + (size_t)(row0 + ai * 128 + m * 16) * DE + cl) = w; }
    }
    __device__ __forceinline__ void compute(const f32x4 (&acc)[2][2][4][2], const Unit& u, int wr, int wc, int fr, int fq, const Pre& pre, Pend& p) const {
#pragma unroll
        for (int ai = 0; ai < 2; ++ai)
#pragma unroll
            for (int m = 0; m < 4; ++m) {
                float o[8];
#pragma unroll
                for (int n = 0; n < 2; ++n) { const f32x4 gv = acc[ai][0][m][n] + pre.bg[n], uv = acc[ai][1][m][n] + pre.bu[n];
#pragma unroll
                    for (int q = 0; q < 4; ++q) { const float gg = fminf(gv[q], 7.0f), uu = fminf(fmaxf(uv[q], -7.0f), 7.0f); o[4 * n + q] = (uu + 1.0f) * (gg * sigm(1.702f * gg)); } }
                p.w[ai * 4 + m].x = pk4_fp8(o[0] * S_ACT, o[1] * S_ACT, o[2] * S_ACT, o[3] * S_ACT); p.w[ai * 4 + m].y = pk4_fp8(o[4] * S_ACT, o[5] * S_ACT, o[6] * S_ACT, o[7] * S_ACT); }
    }
    __device__ __forceinline__ void store_step(Pend& p, const Unit& pu, int it, int wr, int wc, int fr, int fq) const {
        const int ai = it >> 2, m = it & 3, cl = (pu.pn & 15) * 128 + wc * 32 + 8 * fq;
        if (it < 8 && !(ai == 1 && pu.half)) *(u32x2*)(ACT + (size_t)(pu.pm * 256 + ai * 128 + wr * 64 + m * 16 + fr) * DE + cl) = p.w[0];
#pragma unroll
        for (int q = 0; q < 7; ++q) p.w[q] = p.w[q + 1];
    }
};
template <int VAR = 0> struct EpiExpOutT {
    static constexpr bool PERM = true, AFTER_DRAIN = false;
    unsigned char* Y; const float* bout;
    struct Pend {}; static constexpr int NPEND = 0;
    struct Pre { f32x4 bv[2][2]; };
    __device__ __forceinline__ void preload(Pre& p, const Unit& u, int wr, int wc, int fr, int fq) const { const int e = u.pn >> 3, c0 = (u.pn & 7) * 256 + wc * 32 + 8 * fq;
#pragma unroll
        for (int bj = 0; bj < 2; ++bj)
#pragma unroll
            for (int n = 0; n < 2; ++n) p.bv[bj][n] = (VAR == 1) ? (f32x4){0.f, 0.f, 0.f, 0.f} : *(const f32x4*)(bout + (size_t)e * D + c0 + bj * 128 + 4 * n) * S_Y; }
    __device__ __forceinline__ void operator()(const f32x4 (&acc)[2][2][4][2], const Unit& u, int wr, int wc, int fr, int fq, const Pre& pre) const {
        const int e = u.pn >> 3, pl = u.pn & 7;
        const int row0 = u.pm * 256 + wr * 64 + fr, c0 = pl * 256 + wc * 32 + 8 * fq;
        const f32x4 (&bv)[2][2] = pre.bv; (void)e;
#pragma unroll
        for (int ai = 0; ai < 2; ++ai)
#pragma unroll
            for (int m = 0; m < 4; ++m) { if (ai == 1 && u.half) continue; unsigned char* rowp = Y + (size_t)(row0 + ai * 128 + m * 16) * D + c0;
#pragma unroll
                for (int bj = 0; bj < 2; ++bj) { const f32x4 v0 = acc[ai][bj][m][0] * S_Y + bv[bj][0], v1 = acc[ai][bj][m][1] * S_Y + bv[bj][1];
                    u32x2 w; w.x = pk4_fp8(v0[0], v0[1], v0[2], v0[3]); w.y = pk4_fp8(v1[0], v1[1], v1[2], v1[3]);
                    if (VAR == 2) asm volatile("" :: "v"(w)); else *(u32x2*)(rowp + bj * 128) = w; } }
    }
};
typedef EpiExpOutT<0> EpiExpOut;

struct EpiNull { static constexpr bool PERM = true, AFTER_DRAIN = false; struct Pend {}; static constexpr int NPEND = 0; struct Pre {}; __device__ __forceinline__ void preload(Pre&, const Unit&, int, int, int, int) const {} __device__ __forceinline__ void operator()(const f32x4 (&acc)[2][2][4][2], const Unit& u, int wr, int wc, int fr, int fq, const Pre& pre) const {} };
struct MoeOrder {
    const LAS unsigned* tab; int total, G, c;
    __device__ __forceinline__ bool next(int i, Unit& u) const {
        const int L = i * G + c; if (L >= total) return false;
        const unsigned w = tab[L];
        u.pn = __builtin_amdgcn_readfirstlane((int)(w >> 16)); u.pm = __builtin_amdgcn_readfirstlane((int)(w & 0x7fffu)); u.half = __builtin_amdgcn_readfirstlane((int)((w >> 15) & 1u)); return true;
    }
    __device__ __forceinline__ void a_ready(const Unit&) const {}
    __device__ __forceinline__ void done(const Unit&) const {}
};
__device__ __forceinline__ int moe_build_tab(LAS unsigned* tab, LAS int* myexp, const LAS int* rt0, const LAS int* cntl, int NT, int tid, int myx, int NX) {
    if (tid < NE) { const int mte = rt0[tid + 1] - rt0[tid]; int rank = 0;
        for (int q = 0; q < NE; ++q) { const int mq = rt0[q + 1] - rt0[q]; rank += (mq > mte || (mq == mte && q < tid)) ? 1 : 0; }
        const int row = rank / NX, col = rank % NX, x = (row & 1) ? (NX - 1 - col) : col;
        if (x == myx) myexp[row] = tid; }
    __syncthreads();
    const int nmy = NE / NX; int total = 0;
    for (int j = 0; j < nmy; ++j) { const int e = myexp[j]; total += (rt0[e + 1] - rt0[e]) * NT; }
    for (int L = tid; L < total; L += NWAVES * 64) { int base = 0, e = myexp[0];
        for (int j = 0; j < nmy; ++j) { const int ej = myexp[j], uj = (rt0[ej + 1] - rt0[ej]) * NT; if (L >= base + uj) { base += uj; } else { e = ej; break; } }
        const int b = rt0[e], mt = rt0[e + 1] - b, idx = L - base;
        const int pml = idx % mt; const unsigned hf = (pml == mt - 1 && cntl[e] - 256 * pml <= 128) ? 1u : 0u;
        tab[L] = ((unsigned)(e * NT + idx / mt) << 16) | (hf << 15) | (unsigned)(b + pml); }
    __syncthreads();
    return total;
}

#define XB_TMO      128
#define XB_XCNT(j)  (256  + 64 * (j))
#define XB_XSUB(j)  (1280 + 64 * (j))
#define XB_XGEN(j)  (2304 + 64 * (j))
#define XB_TOP      3328
#define XB_TOPGEN   3392
#define XCD_BAR_WORDS 3456
#define XB_SPIN_CAP (1u << 18)

__device__ __forceinline__ unsigned xb_ld(unsigned* p)              { return __hip_atomic_load(p, __ATOMIC_RELAXED, __HIP_MEMORY_SCOPE_AGENT); }
__device__ __forceinline__ unsigned xb_add(unsigned* p, unsigned v) { return __hip_atomic_fetch_add(p, v, __ATOMIC_RELAXED, __HIP_MEMORY_SCOPE_AGENT); }
__device__ __forceinline__ unsigned xb_xcc_id() { return (unsigned)__builtin_amdgcn_s_getreg((3 << 11) | 20) & 0xFu; }
#define XB_SPIN(cond, bar) do { unsigned _sp = 0; while (cond) { __builtin_amdgcn_s_sleep(1); \
    if ((++_sp & 255u) == 0u) { if (xb_ld(&(bar)[XB_TMO])) break; if (_sp > XB_SPIN_CAP) { atomicAdd(&(bar)[XB_TMO], 1u); break; } } } } while (0)

struct XcdBarrier {
    unsigned* bar; unsigned x;
    volatile LAS unsigned* st;
};

__device__ __forceinline__ XcdBarrier xcd_barrier_post(unsigned* bar, volatile LAS unsigned* st) {
    XcdBarrier b; b.bar = bar; b.x = xb_xcc_id(); b.st = st;
    if (threadIdx.x == 0) (void)xb_add(&bar[XB_XCNT(b.x)], 1u);
    return b;
}
__device__ __forceinline__ void xcd_barrier_complete(unsigned* bar, unsigned x, unsigned& nloc, unsigned& nx) {
    const unsigned G = gridDim.x * gridDim.y * gridDim.z;
    unsigned sum, cnt, mine, sp = 0u;
    for (;;) {
        sum = 0u; cnt = 0u; mine = 0u;
#pragma unroll
        for (unsigned j = 0; j < 16; ++j) { const unsigned c = xb_ld(&bar[XB_XCNT(j)]); sum += c; cnt += (c > 0u) ? 1u : 0u; mine = (j == x) ? c : mine; }
        if (sum == G) break;
        __builtin_amdgcn_s_sleep(1);
        if ((++sp & 255u) == 0u) { if (xb_ld(&bar[XB_TMO])) break; if (sp > XB_SPIN_CAP) { atomicAdd(&bar[XB_TMO], 1u); break; } }
    }
    nloc = mine > 0u ? mine : 1u; nx = cnt > 0u ? cnt : 1u;
}

__device__ __forceinline__ void xcd_barrier(const XcdBarrier& b) {
    asm volatile("s_waitcnt vmcnt(0)" ::: "memory");
    __syncthreads();
    if (threadIdx.x == 0) {
        unsigned* bar = b.bar;
        __builtin_amdgcn_s_waitcnt(0);
        unsigned nloc = b.st[0], nx = b.st[1];
        if (nloc == 0u) { xcd_barrier_complete(bar, b.x, nloc, nx); b.st[0] = nloc; b.st[1] = nx; }
        const unsigned old = xb_add(&bar[XB_XSUB(b.x)], 1u);
        const unsigned gen = old / nloc;
        if (old + 1u == (gen + 1u) * nloc) {
            __builtin_amdgcn_fence(__ATOMIC_RELEASE, "agent");
            asm volatile("s_waitcnt vmcnt(0)" ::: "memory");
            const unsigned og = xb_add(&bar[XB_TOP], 1u);
            const unsigned tg = og / nx;
            if (og + 1u == (tg + 1u) * nx) xb_add(&bar[XB_TOPGEN], 1u);
            else XB_SPIN(xb_ld(&bar[XB_TOPGEN]) == tg, bar);
            __builtin_amdgcn_fence(__ATOMIC_ACQUIRE, "agent");
            xb_add(&bar[XB_XGEN(b.x)], 1u);
            asm volatile("s_waitcnt vmcnt(0)" ::: "memory");
        } else {
            XB_SPIN(xb_ld(&bar[XB_XGEN(b.x)]) == gen, bar);
            __builtin_amdgcn_fence(__ATOMIC_ACQUIRE, "agent");
            asm volatile("s_waitcnt vmcnt(0)" ::: "memory");
        }
    }
    __syncthreads();
}

struct Frame {
    LAS unsigned char* lds; volatile LAS unsigned* MISC; gu32* ctl;
    int tid, lane, wave, vcu, G;
};
struct Args { const float* in[20]; float* out; unsigned char* ws; int ph_lo, ph_hi, li, pad; };

__device__ __forceinline__ void p0_transpose_item(const float* W, int K, int N, bf16_t* WT, int k0, int n0, int drow0, LAS float* scr, int lane) {
#pragma unroll 8
    for (int i = 0; i < 32; ++i) { const int kk = 2 * i + (lane >> 5); scr[kk * 33 + (lane & 31)] = W[(size_t)(k0 + kk) * N + n0 + (lane & 31)]; }
    LDS_WAIT(); asm volatile("" ::: "memory");
    const int c = lane & 7;
#pragma unroll
    for (int j = 0; j < 4; ++j) { const int n = (lane >> 3) + 8 * j; const LAS float* s = scr + (8 * c) * 33 + n;
        u32x4 o; o.x = pk2(s[0 * 33], s[1 * 33]); o.y = pk2(s[2 * 33], s[3 * 33]); o.z = pk2(s[4 * 33], s[5 * 33]); o.w = pk2(s[6 * 33], s[7 * 33]);
        *(GAS u32x4*)(WT + (size_t)(drow0 + n) * K + k0 + 8 * c) = o; }
    LDS_WAIT(); asm volatile("" ::: "memory");
}
__device__ __forceinline__ void p0_transpose_item_fp8(const float* W, int K, int N, unsigned char* WT, int k0, int n0, int drow0, LAS float* scr, int lane) {
#pragma unroll 8
    for (int i = 0; i < 32; ++i) { const int kk = 2 * i + (lane >> 5); scr[kk * 33 + (lane & 31)] = W[(size_t)(k0 + kk) * N + n0 + (lane & 31)]; }
    LDS_WAIT(); asm volatile("" ::: "memory");
    const int c = lane & 3;
#pragma unroll
    for (int j = 0; j < 2; ++j) { const int n = (lane >> 2) + 16 * j; const LAS float* s = scr + (16 * c) * 33 + n;
        u32x4 o; o.x = pk4_fp8(s[0 * 33] * S_W, s[1 * 33] * S_W, s[2 * 33] * S_W, s[3 * 33] * S_W); o.y = pk4_fp8(s[4 * 33] * S_W, s[5 * 33] * S_W, s[6 * 33] * S_W, s[7 * 33] * S_W);
        o.z = pk4_fp8(s[8 * 33] * S_W, s[9 * 33] * S_W, s[10 * 33] * S_W, s[11 * 33] * S_W); o.w = pk4_fp8(s[12 * 33] * S_W, s[13 * 33] * S_W, s[14 * 33] * S_W, s[15 * 33] * S_W);
        *(GAS u32x4*)(WT + (size_t)(drow0 + n) * K + k0 + 16 * c) = o; }
    LDS_WAIT(); asm volatile("" ::: "memory");
}
#ifndef MK_KGL
#define MK_KGL 3
#endif
constexpr int KGL = MK_KGL, KG = 1 << KGL, CV_K8 = 16 * KG, CV_K16 = 8 * KG, CV_N = 4 * (64 >> KGL);
template <int PMODE> __device__ __forceinline__ void cvt_task_fp8(const float* W, int N, unsigned char* WT, int K, int k0, int n0, int halfN, int lane) {
    const int n = n0 + 4 * (lane >> KGL), k = k0 + 16 * (lane & (KG - 1));
    const GAS f32x4* src = (const GAS f32x4*)(W + (size_t)k * N + n);
    f32x4 v[16];
#pragma unroll
    for (int i = 0; i < 16; ++i) v[i] = __builtin_nontemporal_load(src + (size_t)i * (N / 4));
    int dr = n;
    if (PMODE == 1 || (PMODE == 2 && n < 2 * halfN)) dr = (n < halfN) ? ((n >> 7) * 256 + (n & 127)) : (((n - halfN) >> 7) * 256 + 128 + ((n - halfN) & 127));
#pragma unroll
    for (int j = 0; j < 4; ++j) { u32x4 o;
        o.x = pk4_fp8(v[0][j] * S_W, v[1][j] * S_W, v[2][j] * S_W, v[3][j] * S_W); o.y = pk4_fp8(v[4][j] * S_W, v[5][j] * S_W, v[6][j] * S_W, v[7][j] * S_W);
        o.z = pk4_fp8(v[8][j] * S_W, v[9][j] * S_W, v[10][j] * S_W, v[11][j] * S_W); o.w = pk4_fp8(v[12][j] * S_W, v[13][j] * S_W, v[14][j] * S_W, v[15][j] * S_W);
        *(GAS u32x4*)(WT + (size_t)(dr + j) * K + k) = o; }
}
template <int PMODE> __device__ __forceinline__ void cvt_task_bf16(const float* W, int N, bf16_t* WT, int K, int k0, int n0, int halfN, int lane) {
    const int n = n0 + 4 * (lane >> KGL), k = k0 + 8 * (lane & (KG - 1));
    const GAS f32x4* src = (const GAS f32x4*)(W + (size_t)k * N + n);
    f32x4 v[8];
#pragma unroll
    for (int i = 0; i < 8; ++i) v[i] = src[(size_t)i * (N / 4)];
    int dr = n;
    if (PMODE == 1 || (PMODE == 2 && n < 2 * halfN)) dr = (n < halfN) ? ((n >> 7) * 256 + (n & 127)) : (((n - halfN) >> 7) * 256 + 128 + ((n - halfN) & 127));
#pragma unroll
    for (int j = 0; j < 4; ++j) { u32x4 o; o.x = cvt_pk(v[0][j], v[1][j]); o.y = cvt_pk(v[2][j], v[3][j]); o.z = cvt_pk(v[4][j], v[5][j]); o.w = cvt_pk(v[6][j], v[7][j]);
        *(GAS u32x4*)(WT + (size_t)(dr + j) * K + k) = o; }
}
struct CvDesc { const char* sb; unsigned rstride; unsigned char* db; };
__device__ __forceinline__ CvDesc cv_desc(int it_, const float* w_ei, const float* w_eo, unsigned char* WE1, unsigned char* WE2, int lane) {
    constexpr int CVT1 = (D / CV_K8) * (2 * DE / CV_N), CVT2 = (DE / CV_K8) * (D / CV_N), CVTE = CVT1 + CVT2;
    static_assert(D == DE, "both expert matrices have K = 2048 bytes per destination row");
    const int it = __builtin_amdgcn_readfirstlane(it_); const int e = it / CVTE, q = it % CVTE; CvDesc d;
    if (q < CVT1) { const int k0 = CV_K8 * (q / (2 * DE / CV_N)), n0 = CV_N * (q % (2 * DE / CV_N));
        const int dr0 = (n0 < DE) ? ((n0 >> 7) * 256 + (n0 & 127)) : (((n0 - DE) >> 7) * 256 + 128 + ((n0 - DE) & 127));
        d.sb = (const char*)(w_ei + (size_t)e * D * 2 * DE + (size_t)k0 * (2 * DE) + n0); d.rstride = 2 * DE * 4; d.db = WE1 + (size_t)e * 2 * DE * D + (size_t)dr0 * D + k0; }
    else { const int r = q - CVT1; const int k0 = CV_K8 * (r / (D / CV_N)), n0 = CV_N * (r % (D / CV_N));
        d.sb = (const char*)(w_eo + (size_t)e * DE * D + (size_t)k0 * D + n0); d.rstride = D * 4; d.db = WE2 + (size_t)e * D * DE + (size_t)n0 * DE + k0; }
    return d;
}
__device__ __forceinline__ void cv_load(f32x4 (&v)[16], const CvDesc& d, int lane) {
    const unsigned voff = (unsigned)(16 * (lane & (KG - 1))) * d.rstride + 16u * (unsigned)(lane >> KGL);
#pragma unroll
    for (int i = 0; i < 16; ++i) v[i] = __builtin_nontemporal_load((const GAS f32x4*)(d.sb + (size_t)i * d.rstride + voff));
}
__device__ __forceinline__ void cv_store(const f32x4 (&v)[16], const CvDesc& d, int lane) {
    const unsigned doff = (unsigned)(4 * (lane >> KGL)) * (unsigned)D + 16u * (unsigned)(lane & (KG - 1));
    f32x4 s[16];
#pragma unroll
    for (int i = 0; i < 16; ++i) { s[i] = v[i] * S_W; asm volatile("" : "+v"(s[i])); }
#pragma unroll
    for (int j = 0; j < 4; ++j) { u32x4 o;
        o.x = pk4_fp8r(s[0][j], s[1][j], s[2][j], s[3][j]); o.y = pk4_fp8r(s[4][j], s[5][j], s[6][j], s[7][j]);
        o.z = pk4_fp8r(s[8][j], s[9][j], s[10][j], s[11][j]); o.w = pk4_fp8r(s[12][j], s[13][j], s[14][j], s[15][j]);
        __builtin_nontemporal_store(o, (GAS u32x4*)(d.db + (size_t)j * D + doff)); }
}
template <bool PIPE> __device__ __forceinline__ void cv_run(int lo, int hi, int w0, int wn, const float* w_ei, const float* w_eo, unsigned char* WE1, unsigned char* WE2, int lane) {
  if constexpr (PIPE) {
    int it = lo + w0; if (it >= hi) return;
    f32x4 va[16], vb[16];
    CvDesc da = cv_desc(it, w_ei, w_eo, WE1, WE2, lane), db = da;
    cv_load(va, da, lane);
    for (;;) {
        const int it2 = it + wn; const bool h2 = it2 < hi;
        db = cv_desc(h2 ? it2 : it, w_ei, w_eo, WE1, WE2, lane); cv_load(vb, db, lane);
        cv_store(va, da, lane);
        if (!h2) break;
        const int it3 = it2 + wn; const bool h3 = it3 < hi;
        da = cv_desc(h3 ? it3 : it2, w_ei, w_eo, WE1, WE2, lane); cv_load(va, da, lane);
        cv_store(vb, db, lane);
        if (!h3) break;
        it = it3;
    }
  } else {
#if defined(MK_CV_PAIR) && MK_CV_PAIR
    for (int p = (lo >> 1) + w0; p < (hi >> 1); p += wn) { f32x4 va[16], vb[16]; const CvDesc d = cv_desc(2 * p, w_ei, w_eo, WE1, WE2, lane);
        CvDesc e = d; e.sb = d.sb + 128; e.db = d.db + (size_t)32 * D;
        cv_load(va, d, lane); cv_load(vb, e, lane); cv_store(va, d, lane); cv_store(vb, e, lane); }
#else
    for (int it = lo + w0; it < hi; it += wn) { f32x4 v[16]; const CvDesc d = cv_desc(it, w_ei, w_eo, WE1, WE2, lane); cv_load(v, d, lane); cv_store(v, d, lane); }
#endif
  }
}
__device__ __forceinline__ int paired_row(int n0, int halfN) { return (n0 < halfN) ? ((n0 >> 7) * 256 + (n0 & 127)) : (((n0 - halfN) >> 7) * 256 + 128 + ((n0 - halfN) & 127)); }

__device__ __forceinline__ void rms_row_to_bf16(const float* xrow, const float* g, bf16_t* orow, int lane) {
    const GAS f32x4* xr = (const GAS f32x4*)xrow + lane;
    f32x4 v[8]; float ss = 0.f;
#pragma unroll
    for (int j = 0; j < 8; ++j) { v[j] = xr[64 * j]; ss += (v[j][0] * v[j][0] + v[j][1] * v[j][1]) + (v[j][2] * v[j][2] + v[j][3] * v[j][3]); }
    const float rs = rsqrtf(wave_sum(ss) * (1.0f / D) + EPS);
    GAS u32x2* o8 = (GAS u32x2*)orow + lane;
#pragma unroll
    for (int j = 0; j < 8; ++j) { const f32x4 gg = ((const GAS f32x4*)g)[lane + 64 * j]; u32x2 w; w.x = pk2(v[j][0] * rs * gg[0], v[j][1] * rs * gg[1]); w.y = pk2(v[j][2] * rs * gg[2], v[j][3] * rs * gg[3]); o8[64 * j] = w; }
}

__device__ __forceinline__ void rms_row_to_fp8(const float* xrow, const float* g, unsigned char* orow, int lane) {
    const GAS f32x4* xr = (const GAS f32x4*)xrow + lane;
    f32x4 v[8]; float ss = 0.f;
#pragma unroll
    for (int j = 0; j < 8; ++j) { v[j] = xr[64 * j]; ss += (v[j][0] * v[j][0] + v[j][1] * v[j][1]) + (v[j][2] * v[j][2] + v[j][3] * v[j][3]); }
    const float rs = rsqrtf(wave_sum(ss) * (1.0f / D) + EPS) * S_X;
    GAS unsigned* o4 = (GAS unsigned*)orow + lane;
#pragma unroll
    for (int j = 0; j < 8; ++j) { const f32x4 gg = ((const GAS f32x4*)g)[lane + 64 * j]; o4[64 * j] = pk4_fp8(v[j][0] * rs * gg[0], v[j][1] * rs * gg[1], v[j][2] * rs * gg[2], v[j][3] * rs * gg[3]); }
}

__device__ __forceinline__ void conv_tile(Frame& F, int tile, const bf16_t* U, const float* cw, const float* cb, const float* lg, const float* lb, bf16_t* UC) {
    const int t0 = tile * 32, c = 2 * F.tid;
    LAS float* ys = (LAS float*)F.lds;
    f32x2 w[31];
#pragma unroll
    for (int k = 0; k < 31; ++k) w[k] = *(const f32x2*)(cw + k * DC + c);
    const f32x2 bias = *(const f32x2*)(cb + c);
#pragma unroll 1
    for (int hf = 0; hf < 2; ++hf) {
        unsigned urow[46];
#pragma unroll
        for (int p = 0; p < 46; ++p) { const int tt = t0 - 30 + 16 * hf + p; const unsigned v = *(const unsigned*)(U + (size_t)(tt < 0 ? 0 : tt) * DC + c); urow[p] = (tt < 0) ? 0u : v; }
#pragma unroll
        for (int j = 0; j < 16; ++j) {
            f32x2 a = bias;
#pragma unroll
            for (int k = 0; k < 31; ++k) a += w[k] * (f32x2){bflo(urow[j + k]), bfhi(urow[j + k])};
            *(LAS f32x2*)(ys + (16 * hf + j) * DC + c) = a;
        }
    }
    __syncthreads();
#pragma unroll 1
    for (int jj = 0; jj < 4; ++jj) {
        const int j = F.wave * 4 + jj;
        f32x4 v[4]; float s = 0.f;
#pragma unroll
        for (int q = 0; q < 4; ++q) { v[q] = *(const LAS f32x4*)(ys + j * DC + 4 * F.lane + 256 * q); s += (v[q][0] + v[q][1]) + (v[q][2] + v[q][3]); }
        const float mu = wave_sum(s) * (1.0f / DC); float qq = 0.f;
#pragma unroll
        for (int q = 0; q < 4; ++q) { v[q] = v[q] - mu; qq += (v[q][0] * v[q][0] + v[q][1] * v[q][1]) + (v[q][2] * v[q][2] + v[q][3] * v[q][3]); }
        const float rstd = rsqrtf(wave_sum(qq) * (1.0f / DC) + EPS);
#pragma unroll
        for (int q = 0; q < 4; ++q) { const int cc = 4 * F.lane + 256 * q; const f32x4 g4 = *(const f32x4*)(lg + cc), b4 = *(const f32x4*)(lb + cc);
            float y[4];
#pragma unroll
            for (int z = 0; z < 4; ++z) { const float t = v[q][z] * rstd * g4[z] + b4[z]; y[z] = t * sigm(t); }
            u32x2 o; o.x = cvt_pk(y[0], y[1]); o.y = cvt_pk(y[2], y[3]);
            *(u32x2*)(UC + (size_t)(t0 + j) * KCAT + cc) = o; }
    }
    __syncthreads();
}

__device__ __forceinline__ void attn_task(const bf16_t* __restrict__ Q, const bf16_t* __restrict__ Kb, const bf16_t* __restrict__ Vb, bf16_t* OG, float* LSE, int task, int lane) {
    const int h = task >> 8, rem = task & 255;
    const int dsh = 2 * (h >> 2), dil = 1 << dsh;
    const int r = rem & (dil - 1), mc = rem >> dsh;
    const int i = lane & 31, hh = lane >> 5;
    const int m0 = mc * 32;
    const int tq = ((m0 + i) << dsh) + r;
    const float NEG = -__builtin_inff();
    bf16x8 qf[8];
    { const bf16_t* qp = Q + (size_t)tq * AW + h * HD + 8 * hh;
#pragma unroll
      for (int s = 0; s < 8; ++s) qf[s] = *(const bf16x8*)(qp + 16 * s); }
    bf16x8 kf[3][8];
#define ATT_LDK(jt_) do { int mk_ = m0 - 128 + 32 * (jt_) + i; mk_ = mk_ < 0 ? 0 : mk_; const bf16_t* kp_ = Kb + (size_t)((mk_ << dsh) + r) * AW + h * HD + 8 * hh; \
        _Pragma("unroll") for (int s_ = 0; s_ < 8; ++s_) kf[(jt_) % 3][s_] = *(const bf16x8*)(kp_ + 16 * s_); } while (0)
    ATT_LDK(0); ATT_LDK(1);
    f32x16 sacc[5];
#pragma unroll
    for (int jt = 0; jt < 5; ++jt) {
        if (jt + 2 < 5) ATT_LDK(jt + 2);
        __builtin_amdgcn_sched_barrier(0);
        f32x16 a;
#pragma unroll
        for (int q = 0; q < 16; ++q) a[q] = 0.f;
#pragma unroll
        for (int s = 0; s < 8; ++s) a = __builtin_amdgcn_mfma_f32_32x32x16_bf16(kf[jt % 3][s], qf[s], a, 0, 0, 0);
        if (jt == 0 || jt == 4) {
#pragma unroll
            for (int q = 0; q < 16; ++q) { const int kk = (q & 3) + 8 * (q >> 2) + 4 * hh;
                if (jt == 0 && kk < i) a[q] = NEG;
                if (jt == 4 && kk > i) a[q] = NEG; } }
        sacc[jt] = a;
        __builtin_amdgcn_sched_barrier(0);
    }
#undef ATT_LDK
    if (mc < 4) {
#pragma unroll
        for (int jt = 0; jt < 4; ++jt)
#pragma unroll
            for (int q = 0; q < 16; ++q) { const int mk = m0 - 128 + 32 * jt + (q & 3) + 8 * (q >> 2) + 4 * hh; if (mk < 0) sacc[jt][q] = NEG; }
    }
    float mx = NEG;
#pragma unroll
    for (int jt = 0; jt < 5; ++jt)
#pragma unroll
        for (int q = 0; q < 16; ++q) mx = fmaxf(mx, sacc[jt][q]);
    mx = fmaxf(mx, __shfl_xor(mx, 32));
    float l = 0.f;
#pragma unroll
    for (int jt = 0; jt < 5; ++jt)
#pragma unroll
        for (int q = 0; q < 16; ++q) { const float e = __builtin_amdgcn_exp2f(sacc[jt][q] - mx); sacc[jt][q] = e; l += e; }
    l += __shfl_xor(l, 32);
    const float inv = 1.0f / l;
    if (hh == 0) LSE[(size_t)tq * NH + h] = (mx + __log2f(l)) * LN2;
    bf16x8 pf[5][2];
#pragma unroll
    for (int jt = 0; jt < 5; ++jt)
#pragma unroll
        for (int s2 = 0; s2 < 2; ++s2) { u32x4 w;
            w.x = cvt_pk(sacc[jt][8 * s2 + 0] * inv, sacc[jt][8 * s2 + 1] * inv); w.y = cvt_pk(sacc[jt][8 * s2 + 2] * inv, sacc[jt][8 * s2 + 3] * inv);
            w.z = cvt_pk(sacc[jt][8 * s2 + 4] * inv, sacc[jt][8 * s2 + 5] * inv); w.w = cvt_pk(sacc[jt][8 * s2 + 6] * inv, sacc[jt][8 * s2 + 7] * inv);
            pf[jt][s2] = __builtin_bit_cast(bf16x8, w); }
    f32x16 o[4];
#pragma unroll
    for (int z = 0; z < 4; ++z)
#pragma unroll
        for (int q = 0; q < 16; ++q) o[z][q] = 0.f;
    const bf16_t* vcol = Vb + h * HD + 2 * i;
    unsigned wa[4][8], wb[4][8];
#define ATT_LDV(st_) do { _Pragma("unroll") for (int j_ = 0; j_ < 8; ++j_) { int mk_ = m0 - 128 + 16 * (st_) + 8 * (j_ >> 2) + 4 * hh + (j_ & 3); mk_ = mk_ < 0 ? 0 : mk_; \
        const bf16_t* vp_ = vcol + (size_t)((mk_ << dsh) + r) * AW; wa[(st_) % 4][j_] = *(const unsigned*)vp_; wb[(st_) % 4][j_] = *(const unsigned*)(vp_ + 64); } } while (0)
    ATT_LDV(0); ATT_LDV(1); ATT_LDV(2);
#pragma unroll
    for (int st = 0; st < 10; ++st) {
        if (st + 3 < 10) ATT_LDV(st + 3);
        __builtin_amdgcn_sched_barrier(0);
        const unsigned (&ua)[8] = wa[st % 4]; const unsigned (&ub)[8] = wb[st % 4];
        u32x4 f0, f1, f2, f3;
        f0.x = (ua[0] & 0xffffu) | (ua[1] << 16); f0.y = (ua[2] & 0xffffu) | (ua[3] << 16); f0.z = (ua[4] & 0xffffu) | (ua[5] << 16); f0.w = (ua[6] & 0xffffu) | (ua[7] << 16);
        f1.x = (ua[0] >> 16) | (ua[1] & 0xffff0000u); f1.y = (ua[2] >> 16) | (ua[3] & 0xffff0000u); f1.z = (ua[4] >> 16) | (ua[5] & 0xffff0000u); f1.w = (ua[6] >> 16) | (ua[7] & 0xffff0000u);
        f2.x = (ub[0] & 0xffffu) | (ub[1] << 16); f2.y = (ub[2] & 0xffffu) | (ub[3] << 16); f2.z = (ub[4] & 0xffffu) | (ub[5] << 16); f2.w = (ub[6] & 0xffffu) | (ub[7] << 16);
        f3.x = (ub[0] >> 16) | (ub[1] & 0xffff0000u); f3.y = (ub[2] >> 16) | (ub[3] & 0xffff0000u); f3.z = (ub[4] >> 16) | (ub[5] & 0xffff0000u); f3.w = (ub[6] >> 16) | (ub[7] & 0xffff0000u);
        o[0] = __builtin_amdgcn_mfma_f32_32x32x16_bf16(pf[st >> 1][st & 1], __builtin_bit_cast(bf16x8, f0), o[0], 0, 0, 0);
        o[1] = __builtin_amdgcn_mfma_f32_32x32x16_bf16(pf[st >> 1][st & 1], __builtin_bit_cast(bf16x8, f1), o[1], 0, 0, 0);
        o[2] = __builtin_amdgcn_mfma_f32_32x32x16_bf16(pf[st >> 1][st & 1], __builtin_bit_cast(bf16x8, f2), o[2], 0, 0, 0);
        o[3] = __builtin_amdgcn_mfma_f32_32x32x16_bf16(pf[st >> 1][st & 1], __builtin_bit_cast(bf16x8, f3), o[3], 0, 0, 0);
        __builtin_amdgcn_sched_barrier(0);
    }
#undef ATT_LDV
#pragma unroll
    for (int q = 0; q < 16; ++q) { const int qi = (q & 3) + 8 * (q >> 2) + 4 * hh; const int tt = ((m0 + qi) << dsh) + r;
        bf16_t* op = OG + ((size_t)tt * NH + h) * HD + 2 * i;
        *(unsigned*)op = cvt_pk(o[0][q], o[1][q]); *(unsigned*)(op + 64) = cvt_pk(o[2][q], o[3][q]); }
}

__device__ __forceinline__ float tp_value(gu32* ctl, int idx) {
    const int k = idx & 15, ks = (k == 6) ? 5 : k; const unsigned st = ~__hip_atomic_load((unsigned*)(ctl + CW_TS + ks), RLX_AGENT);
    const unsigned e1 = __hip_atomic_load((unsigned*)(ctl + CW_TS + 16 + k), RLX_AGENT), e2 = __hip_atomic_load((unsigned*)(ctl + CW_TS + 32 + k), RLX_AGENT);
    if (idx >= 32) { const unsigned nx = ~__hip_atomic_load((unsigned*)(ctl + CW_TS + k + 1), RLX_AGENT); const unsigned em = (e2 != 0u && (int)(e2 - e1) > 0) ? e2 : e1; return (float)(int)(nx - em) * 0.01f; }
    return (float)(int)(((idx >= 16) ? e2 : e1) - st) * 0.01f;
}
#ifndef MK_DEFER9
#define MK_DEFER9 false
#endif
#ifndef MK_BAUX
#define MK_BAUX 0
#endif
__global__ void __launch_bounds__(NWAVES * 64, 2) mk_fwd(Args args) {
    extern __shared__ __attribute__((aligned(16))) unsigned char lds[];
    Frame F;
    F.lds = (LAS unsigned char*)lds;
    F.MISC = (volatile LAS unsigned*)(F.lds + MISC_OFF);
    F.tid = threadIdx.x; F.lane = F.tid & 63; F.wave = __builtin_amdgcn_readfirstlane(F.tid >> 6);
    F.G = gridDim.x; { const int bx = blockIdx.x; F.vcu = (F.G % 8 == 0) ? (bx % 8) * (F.G / 8) + bx / 8 : bx; }
    unsigned char* ws = args.ws;
    F.ctl = (gu32*)(ws + WS_CTL);
    for (int u = F.tid; u < (LDS_BYTES - LDSCTL_OFF) / 4; u += NWAVES * 64) ((LAS unsigned*)(F.lds + LDSCTL_OFF))[u] = 0u;
    __syncthreads();
    const bool one_launch = (args.ph_hi - args.ph_lo) > 1;
    XcdBarrier bar; bar.bar = (unsigned*)(F.ctl + CW_BAR) + args.li * XCD_BAR_WORDS; bar.x = 0; bar.st = nullptr;
    if (one_launch) bar = xcd_barrier_post((unsigned*)(F.ctl + CW_BAR) + args.li * XCD_BAR_WORDS, F.MISC + 8);
    const int lo = args.ph_lo, hi = args.ph_hi;
#ifndef MK_PHASE_MASK
#define MK_PHASE_MASK 0xfff
#endif
#define IN(k) ((((MK_PHASE_MASK) >> (k)) & 1) && lo <= (k) && (k) < hi)
#define SEAM(k) do { if (IN(k) && IN((k) + 1)) xcd_barrier(bar); } while (0)
#ifdef MK_TPROBE_A
#define TS_IN(k) do { if (IN(k) && F.tid == 0) atomicMax((unsigned*)(F.ctl + CW_TS + (k)), ~(unsigned)__builtin_amdgcn_s_memrealtime()); } while (0)
#define TS_OUT(k, cv) do { if (IN(k) && F.tid == 0) atomicMax((unsigned*)(F.ctl + CW_TS + ((cv) ? 32 : 16) + (k)), (unsigned)__builtin_amdgcn_s_memrealtime()); } while (0)
#else
#define TS_IN(k) do {} while (0)
#define TS_OUT(k, cv) do {} while (0)
#endif
#ifndef MK_REPEAT
#define MK_REPEAT (-1)
#endif
#define REPS(k) for (int rep_ = 0; rep_ < ((k) == MK_REPEAT ? 2 : 1); ++rep_)

    const float* x = args.in[0]; const float* n1g = args.in[1]; const float* w_in = args.in[2]; const float* b_gate = args.in[3];
    const float* conv_w = args.in[4]; const float* conv_b = args.in[5]; const float* ln_g = args.in[6]; const float* ln_b = args.in[7];
    const float* w_co = args.in[8]; const float* b_co = args.in[9]; const float* w_ao = args.in[10]; const float* w_out = args.in[11];
    const float* n2g = args.in[12]; const float* w_r = args.in[13]; const float* b_r = args.in[14];
    const float* w_ei = args.in[15]; const float* b_ei = args.in[16]; const float* w_eo = args.in[17]; const float* b_eo = args.in[18]; const float* nfg = args.in[19];
    bf16_t* WIN = (bf16_t*)(ws + WS_WIN); bf16_t* WCO = (bf16_t*)(ws + WS_WCO); bf16_t* WAO = (bf16_t*)(ws + WS_WAO); bf16_t* WOUT = (bf16_t*)(ws + WS_WOUT);
    unsigned char* WE1 = ws + WS_WE1; unsigned char* WE2 = ws + WS_WE2;
    bf16_t* Hb = (bf16_t*)(ws + WS_H); bf16_t* Ub = (bf16_t*)(ws + WS_U); bf16_t* Qb = (bf16_t*)(ws + WS_Q); bf16_t* Kb = (bf16_t*)(ws + WS_K); bf16_t* Vb = (bf16_t*)(ws + WS_V);
    unsigned char* Gb = ws + WS_GATE; bf16_t* UCb = (bf16_t*)(ws + WS_M1);     bf16_t* OG = (bf16_t*)(ws + WS_OG); float* LSE = (float*)(ws + WS_LSE); bf16_t* OCb = (bf16_t*)(ws + WS_M1) + DC;
    float* M1 = (float*)(ws + WS_M1); bf16_t* MGb = (bf16_t*)(ws + WS_MG); bf16_t* DLb = (bf16_t*)(ws + WS_X1);     unsigned char* H2f = ws + WS_H2;
    int* a_e = (int*)(ws + WS_AE); int* a_pos = (int*)(ws + WS_APOS); float* a_gate = (float*)(ws + WS_AGATE); int* a_slot = (int*)(ws + WS_ASLOT);
    unsigned char* XG = ws + WS_XG; unsigned char* ACT = ws + WS_ACT; unsigned char* Yb = ws + WS_Y;
    int* hist = (int*)(ws + WS_HIST);
    const int gw = F.vcu * NWAVES + F.wave, NGW = F.G * NWAVES;
#ifndef MK_NCV
#define MK_NCV 8
#endif
    const int bx = (int)blockIdx.x;
    const bool grp = (MK_NCV > 0) && (F.G % 8 == 0) && (F.G / 8 > MK_NCV);
    const int cgG = grp ? F.G - 8 * MK_NCV : F.G;
    const bool is_cv = grp && bx >= cgG;
    const int cg_vcu = grp ? (bx % 8) * (cgG / 8) + bx / 8 : F.vcu;
    const int cg_gw = cg_vcu * NWAVES + F.wave, cg_NGW = cgG * NWAVES;
    const int cv_gw = (bx - cgG) * NWAVES + F.wave, cv_NGW = 8 * MK_NCV * NWAVES;
#ifndef MK_NCV7
#define MK_NCV7 MK_NCV
#endif
    const bool grp7 = grp && (F.G / 8 > MK_NCV7);
    const int cgG7 = grp7 ? F.G - 8 * MK_NCV7 : cgG; const bool is_cv7 = grp7 ? bx >= cgG7 : is_cv;
    const int cg_vcu7 = grp7 ? (bx % 8) * (cgG7 / 8) + bx / 8 : cg_vcu;
    const int cv_gw7 = grp7 ? (bx - cgG7) * NWAVES + F.wave : cv_gw, cv_NGW7 = grp7 ? 8 * MK_NCV7 * NWAVES : cv_NGW;
    constexpr int CVT1 = (D / CV_K8) * (2 * DE / CV_N), CVT2 = (DE / CV_K8) * (D / CV_N), CVTE = CVT1 + CVT2, CVTOT = NE * CVTE;
#ifndef MK_CVSPLIT
#define MK_CVSPLIT 0, 77824, 86016, 87552, 97280
#endif
    constexpr int cvs_[5] = {MK_CVSPLIT};
    const int CV_C0 = grp ? cvs_[0] : CVTOT, CV_C1 = grp ? cvs_[1] : CVTOT, CV_C2 = grp ? cvs_[2] : CVTOT, CV_C3 = grp ? cvs_[3] : CVTOT, CV_C4 = grp ? cvs_[4] : CVTOT;
#ifndef MK_PIPE_P0
#define MK_PIPE_P0 true
#endif
#ifndef MK_PIPE_CV
#define MK_PIPE_CV false
#endif
#define CV_RUN(lo_, hi_, w0_, wn_) cv_run<MK_PIPE_CV>((lo_), (hi_), (w0_), (wn_), w_ei, w_eo, WE1, WE2, F.lane)

    TS_IN(0);
    REPS(0) if (IN(0)) {
        if (rep_) xcd_barrier(bar);
        { constexpr int NB_IN = DIN / CV_N, T_IN = (D / CV_K8) * NB_IN;
          for (int it = gw; it < T_IN; it += NGW) cvt_task_fp8<2>(w_in, DIN, (unsigned char*)WIN, D, CV_K8 * (it / NB_IN), CV_N * (it % NB_IN), 1024, F.lane); }
        cv_run<MK_PIPE_P0>(0, CV_C0, gw, NGW, w_ei, w_eo, WE1, WE2, F.lane);
        for (int m = gw; m < T; m += NGW) rms_row_to_fp8(x + (size_t)m * D, n1g, (unsigned char*)Hb + (size_t)m * D, F.lane);
    }
    TS_OUT(0, is_cv && (0 == 1 || 0 == 2 || 0 == 3 || 0 == 7 || 0 == 8));
    SEAM(0);
    TS_IN(1);
#ifndef MK_NCV1
#define MK_NCV1 18
#endif
    const bool grp1 = grp && (F.G / 8 > MK_NCV1); const int cg1G = grp1 ? F.G - 8 * MK_NCV1 : cgG; const bool is_cv1 = grp1 ? bx >= cg1G : is_cv;
    if (IN(1)) {
        if (!is_cv1) {
            pg8::Gemm g{Hb, WIN, T, DIN, D / 2}; pg8::StaticOrder S; S.init(T, DIN, cg1G, bx);
#ifdef MK_STAGGER
            if ((bx >> 3) & 1) { const unsigned long long t0_ = __builtin_amdgcn_s_memrealtime(); while (__builtin_amdgcn_s_memrealtime() - t0_ < (unsigned long long)(MK_STAGGER)) __builtin_amdgcn_s_sleep(8); }
#endif
            static_assert(WS_V - WS_K == WS_K - WS_Q, "q|k|v strides"); EpiProj E{Ub, Qb, Gb, b_gate};
            pg8::gemm_phase<EpiProj, pg8::StaticOrder, true, true, E8_W, E8_X>(F.lds, g, S, E);
#ifndef MK_PIPE_P1
#define MK_PIPE_P1 false
#endif
#ifndef MK_CVW1
#define MK_CVW1 NWAVES
#endif
        } else if (F.wave < MK_CVW1) cv_run<MK_PIPE_P1>(CV_C0, CV_C1, (bx - cg1G) * MK_CVW1 + F.wave, (F.G - cg1G) * MK_CVW1, w_ei, w_eo, WE1, WE2, F.lane);
    }
    TS_OUT(1, is_cv1);
    SEAM(1);
    TS_IN(2);
    REPS(2) if (IN(2)) {
        if (rep_) xcd_barrier(bar);
#ifndef MK_NO_CONV
        if (!is_cv) for (int tile = cg_vcu; tile < T / 32; tile += cgG) conv_tile(F, tile, Ub, conv_w, conv_b, ln_g, ln_b, UCb);
#endif
#ifndef MK_NO_ATTN
        if (!is_cv) for (int task = cg_gw; task < NH * 256; task += cg_NGW) attn_task(Qb, Kb, Vb, OG, LSE, task, F.lane);
        if (is_cv) CV_RUN(CV_C1, CV_C2, cv_gw, cv_NGW);
#endif
    }
    TS_OUT(2, is_cv && (2 == 1 || 2 == 2 || 2 == 3 || 2 == 7 || 2 == 8));
    SEAM(2);
    TS_IN(3);
#ifdef MK_EXTRA_BARRIERS
    for (int xb_ = 0; xb_ < MK_EXTRA_BARRIERS; ++xb_) xcd_barrier(bar);
#endif
    REPS(3) if (IN(3)) {
        if (rep_) xcd_barrier(bar);
        if (is_cv) CV_RUN(CV_C2, CV_C3, cv_gw, cv_NGW);
        if (!is_cv) {
            const int hg = F.lane >> 4, d0 = 8 * (F.lane & 15);
#pragma unroll 1
            for (int t0 = cg_gw; t0 < T; t0 += 2 * cg_NGW) {
                float lw[2][3]; u32x4 og[2][3]; bool ok[2];
#pragma unroll
                for (int z = 0; z < 2; ++z) { const int t = t0 + z * cg_NGW; ok[z] = t < T; const int tc = ok[z] ? t : t0;
#pragma unroll
                    for (int g = 0; g < 3; ++g) { lw[z][g] = LSE[(size_t)tc * NH + 4 * g + hg]; og[z][g] = *(const u32x4*)(OG + ((size_t)tc * NH + 4 * g + hg) * HD + d0); } }
#pragma unroll
                for (int z = 0; z < 2; ++z) { if (!ok[z]) continue; const int t = t0 + z * cg_NGW;
                    const float m = fmaxf(lw[z][0], fmaxf(lw[z][1], lw[z][2])); float w0 = __expf(lw[z][0] - m), w1 = __expf(lw[z][1] - m), w2 = __expf(lw[z][2] - m); const float inv = 1.0f / (w0 + w1 + w2); w0 *= inv; w1 *= inv; w2 *= inv;
                    const unsigned* pa = (const unsigned*)&og[z][0]; const unsigned* pb = (const unsigned*)&og[z][1]; const unsigned* pc = (const unsigned*)&og[z][2];
                    u32x4 o;
#pragma unroll
                    for (int q = 0; q < 4; ++q) { const unsigned ua = og[z][0][q], ub = og[z][1][q], uc_ = og[z][2][q];
                        o[q] = cvt_pk(bflo(ua) * w0 + bflo(ub) * w1 + bflo(uc_) * w2, bfhi(ua) * w0 + bfhi(ub) * w1 + bfhi(uc_) * w2); }
                    (void)pa; (void)pb; (void)pc;
                    *(u32x4*)(OCb + (size_t)t * KCAT + hg * HD + d0) = o; }
            }
            { constexpr int NB = D / CV_N, T_CO = (DC / CV_K16) * NB, T_AO = (AO / CV_K16) * NB, T_OUT = (D / CV_K16) * NB;
              for (int it = cg_gw; it < T_CO + T_AO + T_OUT; it += cg_NGW) { int q = it;
                  if (q < T_CO) { cvt_task_bf16<0>(w_co, D, WCO, KCAT, CV_K16 * (q / NB), CV_N * (q % NB), 0, F.lane); continue; } q -= T_CO;
                  if (q < T_AO) { cvt_task_bf16<0>(w_ao, D, WCO + DC, KCAT, CV_K16 * (q / NB), CV_N * (q % NB), 0, F.lane); continue; } q -= T_AO;
                  cvt_task_bf16<0>(w_out, D, WOUT, D, CV_K16 * (q / NB), CV_N * (q % NB), 0, F.lane); } }
        }
    }
    TS_OUT(3, is_cv && (3 == 1 || 3 == 2 || 3 == 3 || 3 == 7 || 3 == 8));
    SEAM(3);
    TS_IN(4);
    if (IN(4)) {
        pg8::Gemm g{UCb, WCO, T, D, KCAT}; pg8::StaticOrder S; S.init(T, D, F.G, (int)blockIdx.x);
        EpiMerge E{Gb, b_co, MGb};
        pg8::gemm_phase<EpiMerge, pg8::StaticOrder, false, true, 0, 0, DC / 64>(F.lds, g, S, E);
    }
    TS_OUT(4, is_cv && (4 == 1 || 4 == 2 || 4 == 3 || 4 == 7 || 4 == 8));
    SEAM(4);
    TS_IN(5);
    if (IN(6)) {
        pg8::Gemm g{MGb, WOUT, T, D, D}; pg8::StaticOrder S; S.init(T, D, F.G, (int)blockIdx.x);
        EpiDelta E{DLb};
        pg8::gemm_phase<EpiDelta, pg8::StaticOrder, false, true>(F.lds, g, S, E);
        if (MK_REPEAT == 6) {
            xcd_barrier(bar);
            pg8::Gemm g{MGb, WOUT, T, D, D}; pg8::StaticOrder S; S.init(T, D, F.G, (int)blockIdx.x);
        EpiDelta E{DLb};
        pg8::gemm_phase<EpiDelta, pg8::StaticOrder, false, true>(F.lds, g, S, E);
        }
    }
    TS_OUT(6, is_cv && (6 == 1 || 6 == 2 || 6 == 3 || 6 == 7 || 6 == 8));
    SEAM(6);
    TS_IN(7);
    REPS(7) if (IN(7)) {
        if (rep_) xcd_barrier(bar);
        LAS float* xs = (LAS float*)F.lds;
        LAS int* ue = (LAS int*)(F.lds + TAB_OFF + 256);
        f32x2 wreg[16][4];
        { const int ep = F.lane & 15, kq = F.lane >> 4;
#pragma unroll
          for (int b = 0; b < 16; ++b)
#pragma unroll
              for (int q = 0; q < 4; ++q) wreg[b][q] = *(const f32x2*)(w_r + (size_t)(256 * F.wave + 16 * b + 4 * kq + q) * NE + 2 * ep); }
        if (is_cv7) CV_RUN(CV_C3, CV_C4, cv_gw7, cv_NGW7);
        if (!is_cv7) for (int unit = cg_vcu7; unit < T / 16; unit += cgG7) {
            const int t0 = unit * 16;
#pragma unroll 1
            for (int tt = 2 * F.wave; tt < 2 * F.wave + 2; ++tt) {
                const GAS f32x4* xr = (const GAS f32x4*)(x + (size_t)(t0 + tt) * D) + F.lane; const GAS u32x2* dr = (const GAS u32x2*)(DLb + (size_t)(t0 + tt) * D) + F.lane;
                f32x4 v[8]; u32x2 dv[8]; float ss = 0.f;
#pragma unroll
                for (int j = 0; j < 8; ++j) { v[j] = xr[64 * j]; dv[j] = dr[64 * j]; }
#pragma unroll
                for (int j = 0; j < 8; ++j) { v[j][0] += bflo(dv[j].x); v[j][1] += bfhi(dv[j].x); v[j][2] += bflo(dv[j].y); v[j][3] += bfhi(dv[j].y); ss += (v[j][0] * v[j][0] + v[j][1] * v[j][1]) + (v[j][2] * v[j][2] + v[j][3] * v[j][3]); }
#pragma unroll
                for (int j = 0; j < 8; ++j) { u32x2 w; w.x = cvt_pk(v[j][0], v[j][1]); w.y = cvt_pk(v[j][2], v[j][3]); ((GAS u32x2*)(DLb + (size_t)(t0 + tt) * D) + F.lane)[64 * j] = w; }
                const float rs = rsqrtf(wave_sum(ss) * (1.0f / D) + EPS);
                GAS unsigned* o4 = (GAS unsigned*)(H2f + (size_t)(t0 + tt) * D) + F.lane;
#pragma unroll
                for (int j = 0; j < 8; ++j) { const f32x4 gg = ((const GAS f32x4*)n2g)[F.lane + 64 * j]; const f32x4 y = v[j] * rs * gg;
                    *(LAS f32x4*)(xs + tt * D + 4 * (F.lane + 64 * j)) = y; o4[64 * j] = pk4_fp8(y[0] * S_X, y[1] * S_X, y[2] * S_X, y[3] * S_X); }
            }
            __syncthreads();
            f32x2 pacc[16];
#pragma unroll
            for (int tt = 0; tt < 16; ++tt) pacc[tt] = (f32x2){0.f, 0.f};
            { const LAS float* xb = xs + 256 * F.wave + 4 * (F.lane >> 4);
#pragma unroll
              for (int b = 0; b < 16; ++b) {
#pragma unroll
                  for (int tt = 0; tt < 16; ++tt) { const f32x4 xv = *(const LAS f32x4*)(xb + tt * D + 16 * b); pacc[tt] += (wreg[b][0] * xv[0] + wreg[b][1] * xv[1]) + (wreg[b][2] * xv[2] + wreg[b][3] * xv[3]);
                      if ((tt & 7) == 7) __builtin_amdgcn_sched_barrier(0); }
              } }
#pragma unroll
            for (int tt = 0; tt < 16; ++tt) { pacc[tt][0] += __shfl_xor(pacc[tt][0], 16); pacc[tt][1] += __shfl_xor(pacc[tt][1], 16); pacc[tt][0] += __shfl_xor(pacc[tt][0], 32); pacc[tt][1] += __shfl_xor(pacc[tt][1], 32); }
            __syncthreads();
            if (F.lane < 16) {
#pragma unroll
                for (int tt = 0; tt < 16; ++tt) *(LAS f32x2*)(xs + (F.wave * 16 + tt) * 32 + 2 * F.lane) = pacc[tt];
            }
            __syncthreads();
#pragma unroll 1
            for (int tt = 2 * F.wave; tt < 2 * F.wave + 2; ++tt) {
                float lg = -__builtin_inff();
                if (F.lane < 32) { float s = b_r[F.lane];
#pragma unroll
                    for (int w = 0; w < 8; ++w) s += xs[(w * 16 + tt) * 32 + F.lane];
                    lg = s; }
                int sel_e[4]; float sel_v[4];
#pragma unroll
                for (int k = 0; k < 4; ++k) { const float m = wave_max(lg); const unsigned long long b = __ballot(lg == m); const int e = __ffsll((long long)b) - 1; sel_e[k] = e; sel_v[k] = m; if (F.lane == e) lg = -__builtin_inff(); }
                const float e1 = __expf(sel_v[1] - sel_v[0]), e2 = __expf(sel_v[2] - sel_v[0]), e3 = __expf(sel_v[3] - sel_v[0]);
                const float inv = 1.0f / (1.0f + e1 + e2 + e3);
                if (F.lane < 4) {
                    const int e = F.lane == 0 ? sel_e[0] : F.lane == 1 ? sel_e[1] : F.lane == 2 ? sel_e[2] : sel_e[3];
                    const float gt = (F.lane == 0 ? 1.0f : F.lane == 1 ? e1 : F.lane == 2 ? e2 : e3) * inv;
                    const int a = (t0 + tt) * 4 + F.lane; a_e[a] = e; a_gate[a] = gt; ue[tt * 4 + F.lane] = e;
                }
            }
            __syncthreads();
            if (F.wave == 0) {
                const int e = ue[F.lane]; int rank = 0, mycount = 0;
#pragma unroll 4
                for (int q = 0; q < NE; ++q) { const unsigned long long mq = __ballot(e == q); if (e == q) rank = __popcll(mq & ((1ull << F.lane) - 1ull)); if (F.lane == q) mycount = __popcll(mq); }
                a_pos[t0 * 4 + F.lane] = rank;
                if (F.lane < NE) hist[unit * NE + F.lane] = mycount;
            }
            __syncthreads();
        }
    }
    TS_OUT(7, is_cv && (7 == 1 || 7 == 2 || 7 == 3 || 7 == 7 || 7 == 8));
    TS_OUT(7, is_cv && (7 == 1 || 7 == 2 || 7 == 3 || 7 == 7 || 7 == 8));
    SEAM(7);
    TS_IN(8);
    LAS int* rt0 = (LAS int*)(F.lds + TAB_OFF);
    LAS int* cntl = (LAS int*)(F.lds + TAB_OFF + 512);
    LAS int* ubase = (LAS int*)(F.lds + TAB_OFF + 768);
    LAS int* myexp = (LAS int*)(F.lds + TAB_OFF + 896);
    LAS int* part = (LAS int*)(F.lds + TAB_OFF + 1024);
    if (hi > 8 && lo <= 10) {
        { const int e = F.tid & 31, p = F.tid >> 5; int hv[32]; int sacc_ = 0;
#pragma unroll
          for (int i = 0; i < 32; ++i) hv[i] = hist[(32 * p + i) * NE + e];
#pragma unroll
          for (int i = 0; i < 32; ++i) sacc_ += hv[i];
          part[p * NE + e] = sacc_;
          __syncthreads();
          if (F.tid < NE) { int c = 0;
#pragma unroll
              for (int q = 0; q < 16; ++q) c += part[q * NE + F.tid];
              cntl[F.tid] = c; }
          int pre = 0;
          for (int q = 0; q < p; ++q) pre += part[q * NE + e];
          LAS int* ubt = (LAS int*)F.lds;
#pragma unroll
          for (int i = 0; i < 32; ++i) { ubt[(32 * p + i) * NE + e] = pre; pre += hv[i]; } }
        __syncthreads();
        if (F.tid == 0) { int a = 0; for (int e = 0; e < NE; ++e) { rt0[e] = a; a += (cntl[e] + 255) >> 8; } rt0[NE] = a; }
        __syncthreads();
    }
    REPS(8) if (IN(8)) {
        if (rep_) xcd_barrier(bar);
        if (is_cv) CV_RUN(CV_C4, CVTOT, cv_gw, cv_NGW);
        if (!is_cv) for (int unit = cg_vcu; unit < T / 16; unit += cgG) {
#pragma unroll 1
            for (int j = 0; j < 8; ++j) { const int a = unit * 64 + F.wave * 8 + j; const int e = a_e[a], slot = 256 * rt0[e] + ((const LAS int*)F.lds)[unit * NE + e] + a_pos[a];
                if (F.lane == 0) a_slot[a] = slot;
                const GAS u32x4* src = (const GAS u32x4*)(H2f + (size_t)(a >> 2) * D) + F.lane; GAS u32x4* dst = (GAS u32x4*)(XG + (size_t)slot * D) + F.lane;
#pragma unroll
                for (int q = 0; q < 2; ++q) dst[64 * q] = src[64 * q]; }
        }
        if (!is_cv) for (int it = cg_gw; it < NE * 256; it += cg_NGW) { const int e = it >> 8, j = it & 255; const int row = 256 * rt0[e] + cntl[e] + j;
            if (row < 256 * rt0[e + 1]) { GAS u32x4* dst = (GAS u32x4*)(XG + (size_t)row * D) + F.lane;
#pragma unroll
                for (int j2 = 0; j2 < 2; ++j2) dst[64 * j2] = (u32x4){0u, 0u, 0u, 0u}; } }
    }
    TS_OUT(8, is_cv && (8 == 1 || 8 == 2 || 8 == 3 || 8 == 7 || 8 == 8));
    SEAM(8);
    TS_IN(9);
    if (IN(9)) {
        pg8::Gemm g{(const bf16_t*)XG, (const bf16_t*)WE1, NROWS, NE * 2 * DE, D / 2}; LAS unsigned* utab = (LAS unsigned*)(F.lds + TAB_OFF + 4096); const int NX = (F.G % 8 == 0) ? 8 : 1; const int utot = moe_build_tab(utab, myexp, rt0, cntl, 16, F.tid, (int)blockIdx.x % NX, NX); MoeOrder S{utab, utot, F.G / NX, (int)blockIdx.x / NX};
        EpiSwiGLU E{ACT, b_ei};
        pg8::gemm_phase<EpiSwiGLU, MoeOrder, true, true, E8_W, E8_X, 0, MK_BAUX, MK_DEFER9>(F.lds, g, S, E);
        if (MK_REPEAT == 9) {
            xcd_barrier(bar);
            pg8::Gemm g{(const bf16_t*)XG, (const bf16_t*)WE1, NROWS, NE * 2 * DE, D / 2}; LAS unsigned* utab = (LAS unsigned*)(F.lds + TAB_OFF + 4096); const int NX = (F.G % 8 == 0) ? 8 : 1; const int utot = moe_build_tab(utab, myexp, rt0, cntl, 16, F.tid, (int)blockIdx.x % NX, NX); MoeOrder S{utab, utot, F.G / NX, (int)blockIdx.x / NX};
        EpiSwiGLU E{ACT, b_ei};

#ifdef MK_REPEAT_NOEPI
            { EpiNull EN; pg8::gemm_phase<EpiNull, MoeOrder, true, true, E8_W, E8_X>(F.lds, g, S, EN); }
#else
            pg8::gemm_phase<EpiSwiGLU, MoeOrder, true, true, E8_W, E8_X, 0, MK_BAUX, MK_DEFER9>(F.lds, g, S, E);
#endif

        }
    }
    TS_OUT(9, is_cv && (9 == 1 || 9 == 2 || 9 == 3 || 9 == 7 || 9 == 8));
    SEAM(9);
    TS_IN(10);
    if (IN(10)) {
        pg8::Gemm g{(const bf16_t*)ACT, (const bf16_t*)WE2, NROWS, NE * D, DE / 2}; LAS unsigned* utab = (LAS unsigned*)(F.lds + TAB_OFF + 4096); const int NX = (F.G % 8 == 0) ? 8 : 1; const int utot = moe_build_tab(utab, myexp, rt0, cntl, 8, F.tid, (int)blockIdx.x % NX, NX); MoeOrder S{utab, utot, F.G / NX, (int)blockIdx.x / NX};
        EpiExpOut E{Yb, b_eo};
        pg8::gemm_phase<EpiExpOut, MoeOrder, true, true, E8_W, E8_ACT, 0, MK_BAUX>(F.lds, g, S, E);
        if (MK_REPEAT == 10) {
            xcd_barrier(bar);
            pg8::Gemm g{(const bf16_t*)ACT, (const bf16_t*)WE2, NROWS, NE * D, DE / 2}; LAS unsigned* utab = (LAS unsigned*)(F.lds + TAB_OFF + 4096); const int NX = (F.G % 8 == 0) ? 8 : 1; const int utot = moe_build_tab(utab, myexp, rt0, cntl, 8, F.tid, (int)blockIdx.x % NX, NX); MoeOrder S{utab, utot, F.G / NX, (int)blockIdx.x / NX};
        EpiExpOut E{Yb, b_eo};

#ifdef MK_REPEAT_NOEPI
            { typedef EpiExpOutT<MK_REPEAT_NOEPI> EV; EV EN{Yb, b_eo}; pg8::gemm_phase<EV, MoeOrder, true, true, E8_W, E8_ACT>(F.lds, g, S, EN); }
#else
            pg8::gemm_phase<EpiExpOut, MoeOrder, true, true, E8_W, E8_ACT, 0, MK_BAUX>(F.lds, g, S, E);
#endif

        }
    }
    TS_OUT(10, is_cv && (10 == 1 || 10 == 2 || 10 == 3 || 10 == 7 || 10 == 8));
    SEAM(10);
    TS_IN(11);
    REPS(11) if (IN(11)) {
        if (rep_) xcd_barrier(bar);
        float tp_scale = 1.0f, tp_b = 0.f;
#ifdef MK_TPROBE_A
#if defined(MK_TB)
        { int code = 0; const int tb[8] = {MK_TB};
#pragma unroll
          for (int j = 0; j < 4; ++j) if (tp_value(F.ctl, tb[2 * j]) > (float)tb[2 * j + 1]) code |= 1 << j;
          tp_scale = 1.0f + 0.25f * (float)(code + 1); tp_b = 0.f; }
#elif defined(MK_TPROBE_BITS)
        { int code = 0; const int ph[4] = {1, 2, 7, 8};
#pragma unroll
          for (int j = 0; j < 4; ++j) { const float dv = tp_value(F.ctl, 16 + ph[j]) - tp_value(F.ctl, ph[j]); if (dv > (float)(MK_TPROBE_BITS)) code |= 1 << j; }
          tp_scale = 1.0f + 0.25f * (float)(code + 1); tp_b = 0.f; }
#else
        tp_scale = 1.3f + tp_value(F.ctl, MK_TPROBE_A) * 0.001f; tp_b = 10.0f + tp_value(F.ctl, MK_TPROBE_B) * MK_TPROBE_BS;
#endif
#endif
#pragma unroll 2
        for (int t = gw; t < T; t += NGW) {
            f32x4 v[8];
#pragma unroll
            for (int j = 0; j < 8; ++j) { const u32x2 dw = ((const GAS u32x2*)(DLb + (size_t)t * D))[F.lane + 64 * j]; v[j] = (f32x4){bflo(dw.x), bfhi(dw.x), bflo(dw.y), bfhi(dw.y)}; }
#pragma unroll
            for (int k = 0; k < 4; ++k) { const int s = a_slot[t * 4 + k]; const float gt = a_gate[t * 4 + k] * (1.0f / S_Y); const GAS unsigned* yr = (const GAS unsigned*)(Yb + (size_t)s * D) + F.lane;
#pragma unroll
                for (int j = 0; j < 8; ++j) { const unsigned w = yr[64 * j]; const f32x2 lo = __builtin_amdgcn_cvt_pk_f32_fp8((int)w, false), hi = __builtin_amdgcn_cvt_pk_f32_fp8((int)w, true);
                    v[j][0] += gt * lo[0]; v[j][1] += gt * lo[1]; v[j][2] += gt * hi[0]; v[j][3] += gt * hi[1]; } }
            float ss = 0.f;
#pragma unroll
            for (int j = 0; j < 8; ++j) ss += (v[j][0] * v[j][0] + v[j][1] * v[j][1]) + (v[j][2] * v[j][2] + v[j][3] * v[j][3]);
            const float rs = rsqrtf(wave_sum(ss) * (1.0f / D) + EPS);
            GAS f32x4* o = (GAS f32x4*)(args.out + (size_t)t * D);
#pragma unroll
            for (int j = 0; j < 8; ++j) { const f32x4 gg = ((const GAS f32x4*)nfg)[F.lane + 64 * j]; o[F.lane + 64 * j] = v[j] * rs * gg * tp_scale; }
        }
#ifdef MK_TPROBE_A
        VM_WAIT(); __syncthreads();
        if (bx == 0 && F.tid == 0 && tp_b != 0.f) args.out[0] = tp_b;
#endif
    }
#undef IN
#undef SEAM
}
constexpr int N_PHASES = 12;
}

#ifndef MK_CUTS
#define MK_CUTS 0
#endif
extern "C" void kernel_launch(void* const* d_in, const int* in_sizes, int n_in, void* d_out, int out_size, void* d_ws, size_t ws_size, hipStream_t stream) {
    using namespace mk;
    static int grid = 0;
    if (grid == 0) {
        int dev = 0, cus = 0;
        if (hipGetDevice(&dev) != hipSuccess || hipDeviceGetAttribute(&cus, hipDeviceAttributeMultiprocessorCount, dev) != hipSuccess) { grid = -1; return; }
        if (hipFuncSetAttribute((const void*)mk_fwd, hipFuncAttributeMaxDynamicSharedMemorySize, LDS_BYTES) != hipSuccess) { grid = -1; return; }
        int per_cu = 0;
        if (hipOccupancyMaxActiveBlocksPerMultiprocessor(&per_cu, (const void*)mk_fwd, NWAVES * 64, LDS_BYTES) != hipSuccess || per_cu < 1) { fprintf(stderr, "kernel_launch: occupancy query says %d\n", per_cu); }
        (void)hipGetLastError();
        grid = cus;
    }
    if (grid < 0) return;
    (void)hipMemsetAsync((char*)d_ws + WS_CTL, 0, CTL_ZERO_BYTES, stream);
    Args a{};
    for (int i = 0; i < 20; ++i) a.in[i] = (const float*)d_in[i];
    a.out = (float*)d_out; a.ws = (unsigned char*)d_ws;
#if MK_CUTS == 0
    a.ph_lo = 0; a.ph_hi = N_PHASES; a.li = 0; a.pad = 0;
    hipLaunchKernelGGL(mk_fwd, dim3(grid), dim3(NWAVES * 64), LDS_BYTES, stream, a);
#else
    for (int p = 0; p < N_PHASES; ++p) { a.ph_lo = p; a.ph_hi = p + 1; a.li = 0; a.pad = 0; hipLaunchKernelGGL(mk_fwd, dim3(grid), dim3(NWAVES * 64), LDS_BYTES, stream, a); }
#endif
}
```
